# Optimizing an MI355X kernel written in HIP

```python
import math
import jax, jax.numpy as jnp
from jax import lax
import numpy as np

D_MODEL = 1024
BATCH = 4
SEQ = 4096
DEPTH = 4
DEC_BATCH = 16
DEC_SEQ = 2048
PAST_LEN = 128

N_EVEN = (DEPTH + 1) // 2
N_ODD = DEPTH // 2
D_A = D_MODEL // 2
HEAD_A = 128
H_A = D_A // HEAD_A
CHUNK_A = 32
D_B = D_MODEL // 2
HEAD_B = 128
H_B = D_B // HEAD_B
CHUNK_B = 128
ROPE_BASE = 10000.0
D_MIX_EVEN = D_A + D_B
D_IN_EVEN = 5 * D_A + 4 * D_B
HEAD_C = 64
H_C = D_MODEL // HEAD_C
LORA_W = 64
LORA_A = 64
LORA_G = 128
LNX_EPS = 64e-5
MEM_LEN = 256
H_CA = 4
HEAD_CA = D_MODEL // H_CA
D_CA = H_CA * HEAD_CA
N_EXPERTS = 16
D_EXPERT = 2048
CAP_FACTOR = 2
DN_ALPHA = (2.0 * DEPTH) ** 0.25
DN_BETA = (8.0 * DEPTH) ** -0.25
LN_EPS = 1e-5

kernel_name = "hybrid_hgrn2_retnet_rwkv7_ec_moe_encoder"


def _layer_norm(x, w, b):
    xf = x.astype(jnp.float32)
    mu = jnp.mean(xf, -1, keepdims=True)
    var = jnp.mean(jnp.square(xf - mu), -1, keepdims=True)
    return ((xf - mu) * lax.rsqrt(var + LN_EPS) * w + b).astype(x.dtype)


def _head_norm(o, gain, bias, eps, center):
    of = o.astype(jnp.float32)
    if center:
        of = of - jnp.mean(of, -1, keepdims=True)
    of = of * lax.rsqrt(jnp.mean(jnp.square(of), -1, keepdims=True) + eps)
    of = of.reshape(of.shape[:-2] + (-1,)) * gain
    if bias is not None:
        of = of + bias
    return of


def _rotary(t, pos):
    d = t.shape[-1]
    theta = 1.0 / jnp.power(ROPE_BASE, jnp.linspace(0.0, 1.0, d // 2, dtype=jnp.float32))
    ang = pos[:, None] * theta[None, :]
    cos = jnp.cos(ang)[None, :, None, :]
    sin = jnp.sin(ang)[None, :, None, :]
    tf = t.astype(jnp.float32)
    t1, t2 = tf[..., 0::2], tf[..., 1::2]
    out = jnp.stack([t1 * cos - t2 * sin, t2 * cos + t1 * sin], -1).reshape(t.shape)
    return out.astype(t.dtype)


def _bidir(fwd, bwd):
    return jnp.stack([fwd, jnp.flip(bwd, axis=1)])


def _merge(o):
    return o[0] + jnp.flip(o[1], axis=1)


def _to_chunks(t, L):
    N, B, T, H, d = t.shape
    return t.reshape(N, B, T // L, L, H, d).transpose(2, 0, 1, 4, 3, 5)


def _from_chunks(t):
    nC, N, B, H, L, d = t.shape
    return t.transpose(1, 2, 0, 4, 3, 5).reshape(N, B, nC * L, H, d)


def _hgrn2_chunkwise(q, k, v, log_f):
    N, B, T, H, dk = q.shape
    dv = v.shape[-1]
    causal = jnp.tri(CHUNK_A, dtype=bool)

    def step(S, inp):
        qc, kc, vc, lfc = [t.astype(jnp.float32) for t in inp]
        b = jnp.cumsum(lfc, axis=-2)
        diff = b[..., :, None, :] - b[..., None, :, :]
        decay = jnp.exp(jnp.where(causal[:, :, None], diff, -jnp.inf))
        scores = jnp.einsum('nbhtsk,nbhsk->nbhts', decay * qc[..., :, None, :], kc)
        o = jnp.einsum('nbhts,nbhsv->nbhtv', scores, vc) + \
            jnp.einsum('nbhtk,nbhkv->nbhtv', qc * jnp.exp(b), S)
        b_last = b[..., -1:, :]
        S = jnp.exp(b_last[..., 0, :])[..., None] * S + \
            jnp.einsum('nbhsk,nbhsv->nbhkv', kc * jnp.exp(b_last - b), vc)
        return S, o

    S0 = jnp.zeros((N, B, H, dk, dv), jnp.float32)
    xs = (_to_chunks(q, CHUNK_A), _to_chunks(k, CHUNK_A), _to_chunks(v, CHUNK_A), _to_chunks(log_f, CHUNK_A))
    _, o = lax.scan(step, S0, xs)
    return _from_chunks(o).astype(v.dtype)


def _retention_chunkwise(q, k, v, log_gamma, intra_mask):
    N, B, T, H, dk = q.shape
    dv = v.shape[-1]
    pos = jnp.arange(CHUNK_B, dtype=jnp.float32)
    lg = log_gamma.astype(jnp.float32)
    dist = jnp.maximum(pos[:, None] - pos[None, :], 0.0)
    d_intra = jnp.where(intra_mask[:, None], jnp.exp(lg[:, None, None] * dist), 0.0)
    q_decay = jnp.exp(lg[:, None] * (pos + 1.0))[:, :, None]
    k_decay = jnp.exp(lg[:, None] * (CHUNK_B - 1.0 - pos))[:, :, None]
    chunk_decay = jnp.exp(lg * CHUNK_B)[:, None, None]

    def step(R, inp):
        qc, kc, vc = [t.astype(jnp.float32) for t in inp]
        scores = jnp.einsum('nbhtk,nbhsk->nbhts', qc, kc) * d_intra[:, None]
        o = jnp.einsum('nbhts,nbhsv->nbhtv', scores, vc) + \
            jnp.einsum('nbhtk,nbhkv->nbhtv', qc * q_decay, R)
        R = chunk_decay * R + jnp.einsum('nbhsk,nbhsv->nbhkv', kc * k_decay, vc)
        return R, o

    R0 = jnp.zeros((N, B, H, dk, dv), jnp.float32)
    xs = (_to_chunks(q, CHUNK_B), _to_chunks(k, CHUNK_B), _to_chunks(v, CHUNK_B))
    _, o = lax.scan(step, R0, xs)
    return _from_chunks(o).astype(v.dtype)


def _even_mixer(x, w_in, lb, norm_a, norm_b, w_out):
    Bn, T, _ = x.shape
    cuts = [D_A * i for i in range(1, 6)] + [5 * D_A + D_B * j for j in range(1, 4)]
    a_q, a_i, a_ff, a_fb, a_g, b_q, b_k, b_v, b_g = jnp.split(x @ w_in, cuts, axis=-1)

    heads_a = lambda t: t.reshape(t.shape[:-1] + (H_A, HEAD_A))
    z = jnp.stack([a_ff, a_fb]).astype(jnp.float32)
    lbf = lb.astype(jnp.float32)[:, None, None, :]
    log_f = jnp.logaddexp(jnp.log(lbf), jnp.log1p(-lbf) + jax.nn.log_sigmoid(z))
    k_in = (1.0 - lbf) * jax.nn.sigmoid(-z)
    q_in = jax.nn.silu(a_q)
    o_a = _hgrn2_chunkwise(heads_a(_bidir(q_in, q_in)), heads_a(_bidir(k_in[0], k_in[1])),
                           heads_a(_bidir(a_i, a_i)), heads_a(_bidir(log_f[0], log_f[1])))
    o_a = _head_norm(_merge(o_a), norm_a, None, 1e-6, False) * jax.nn.silu(a_g)

    heads_b = lambda t: t.reshape(t.shape[:-1] + (H_B, HEAD_B))
    pos = jnp.arange(T, dtype=jnp.float32)
    qb = _rotary(heads_b(b_q), pos)
    kb = _rotary(heads_b(b_k), pos) * (HEAD_B ** -0.5)
    vb = heads_b(b_v)
    log_gamma = jnp.log1p(-jnp.power(2.0, -5.0 - jnp.arange(H_B, dtype=jnp.float32)))
    mask = jnp.stack([jnp.tri(CHUNK_B, dtype=bool), jnp.tri(CHUNK_B, k=-1, dtype=bool)])
    o_b = _retention_chunkwise(_bidir(qb, qb), _bidir(kb, kb), _bidir(vb, vb), log_gamma, mask)
    o_b = _head_norm(_merge(o_b), norm_b, None, 1e-6, True) * jax.nn.silu(b_g)

    y = jnp.concatenate([o_a, o_b.astype(o_a.dtype)], -1) @ w_out
    return y.astype(x.dtype)


def _odd_mixer(x, mu, w_rkv, w0, w1, w2, a0, a1, a2, g1, g2, k_k, k_a, r_k, lnx_w, lnx_b, w_out):
    Bn, T, D = x.shape
    zero = jnp.zeros_like(x[:, :1])
    x_prev = jnp.concatenate([zero, x[:, :-1]], 1)
    x_next = jnp.concatenate([x[:, 1:], zero], 1)
    xx = 0.5 * (x_prev + x_next) - x
    xm = x[None] + xx[None] * mu[:, None, None, :]
    rkv = jnp.einsum('pbtd,pde->pbte', xm[:3], w_rkv)
    r, k, v = rkv[0], rkv[1], rkv[2]
    xw, xa, xg = xm[3], xm[4], xm[5]
    lora_w = jnp.einsum('nbtl,nld->nbtd', jnp.tanh(jnp.einsum('btd,ndl->nbtl', xw, w1)), w2)
    w_log = -jax.nn.softplus(-(w0[:, None, None, :] + lora_w).astype(jnp.float32)) - 0.5
    decay = jnp.exp(-jnp.exp(w_log))
    a = jax.nn.sigmoid((a0[:, None, None, :] + jnp.einsum('nbtl,nld->nbtd', jnp.einsum('btd,ndl->nbtl', xa, a1), a2)).astype(jnp.float32))
    g = jax.nn.sigmoid(xg @ g1) @ g2

    heads = lambda t: t.reshape(t.shape[:-1] + (H_C, HEAD_C))
    kk = heads(k * k_k).astype(jnp.float32)
    kk = kk / jnp.maximum(jnp.sqrt(jnp.sum(jnp.square(kk), -1, keepdims=True)), 1e-12)
    a_h = heads(a)
    k_dir = heads(k).astype(jnp.float32)[None] * (1.0 + (a_h - 1.0) * heads(k_a))
    decay_h = heads(decay)
    r_h, v_h = heads(r), heads(v)
    tm = lambda t: jnp.moveaxis(t, 1, 0).astype(jnp.float32)
    r_s, v_s, kk_s = tm(r_h), tm(v_h), tm(kk)

    def run(n, reverse):
        def step(S, inp):
            r_t, w_t, k_t, v_t, kk_t, b_t = inp
            sa = jnp.einsum('bhvk,bhk->bhv', S, kk_t)
            S = S * w_t[:, :, None, :] - sa[..., None] * b_t[:, :, None, :] + v_t[..., None] * k_t[:, :, None, :]
            return S, jnp.einsum('bhvk,bhk->bhv', S, r_t)
        S0 = jnp.zeros((Bn, H_C, HEAD_C, HEAD_C), jnp.float32)
        xs = (r_s, tm(decay_h[n]), tm(k_dir[n]), v_s, kk_s, tm(kk * a_h[n]))
        _, ys = lax.scan(step, S0, xs, reverse=reverse)
        return ys

    o = jnp.moveaxis(run(0, False) + run(1, True), 0, 1)
    o = _head_norm(o, lnx_w, lnx_b, LNX_EPS, True)
    bonus = jnp.sum(r_h[None].astype(jnp.float32) * k_dir * heads(r_k), -1, keepdims=True) * v_h[None]
    bonus = (bonus[0] + bonus[1]).reshape(Bn, T, D)
    y = ((o + bonus) * g) @ w_out
    return y.astype(x.dtype)


def _cross_attn(x, mem, w_q, w_kv, w_out):
    Bn, T, _ = x.shape
    M = mem.shape[1]
    q = (x @ w_q).reshape(Bn, T, H_CA, HEAD_CA)
    kv = (mem @ w_kv).reshape(Bn, M, 2, H_CA, HEAD_CA)
    s = jnp.einsum('bthd,bmhd->bhtm', q, kv[:, :, 0]).astype(jnp.float32) * (HEAD_CA ** -0.5)
    p = jax.nn.softmax(s, axis=-1).astype(x.dtype)
    o = jnp.einsum('bhtm,bmhd->bthd', p, kv[:, :, 1]).reshape(Bn, T, D_CA)
    return (o @ w_out).astype(x.dtype)


def _expert_choice_ffn(x, w_router, w_in, w_out):
    Bn, T, D = x.shape
    n = Bn * T
    cap = (CAP_FACTOR * n) // N_EXPERTS
    xt = x.reshape(n, D)
    aff = jax.nn.softmax((xt @ w_router).astype(jnp.float32), axis=-1)
    gate, idx = lax.top_k(aff.T, cap)
    xe = xt[idx]
    h_gate, h_up = jnp.split(jnp.einsum('ecd,edf->ecf', xe, w_in), 2, axis=-1)
    ye = jnp.einsum('ecf,efd->ecd', jax.nn.silu(h_gate) * h_up, w_out) * gate[..., None].astype(x.dtype)
    y = jnp.zeros_like(xt).at[idx.reshape(-1)].add(ye.reshape(-1, D).astype(xt.dtype))
    return y.reshape(Bn, T, D)


def _trunk(x, mem, p):
    p_lb = jax.nn.softmax(p['ev_lb_logits'].astype(jnp.float32), axis=1)
    lb_all = jnp.clip(jnp.cumsum(p_lb, axis=1) - p_lb[:, :1], 0.0, 1.0)
    for layer in range(DEPTH):
        j = layer // 2
        if layer % 2 == 0:
            h = _even_mixer(x, p['ev_w_in'][j], lb_all[:, j], p['ev_norm_a'][j], p['ev_norm_b'][j], p['ev_w_out'][j])
        else:
            h = _odd_mixer(x, p['od_mu'][j], p['od_w_rkv'][j], p['od_w0'][j], p['od_w1'][j], p['od_w2'][j],
                           p['od_a0'][j], p['od_a1'][j], p['od_a2'][j], p['od_g1'][j], p['od_g2'][j],
                           p['od_k_k'][j], p['od_k_a'][j], p['od_r_k'][j], p['od_lnx_w'][j], p['od_lnx_b'][j],
                           p['od_w_out'][j])
        x = _layer_norm(DN_ALPHA * x + h, p['ln_w'][layer, 0], p['ln_b'][layer, 0])
        h = _cross_attn(x, mem, p['ca_w_q'][layer], p['ca_w_kv'][layer], p['ca_w_out'][layer])
        x = _layer_norm(DN_ALPHA * x + h, p['ln_w'][layer, 1], p['ln_b'][layer, 1])
        h = _expert_choice_ffn(x, p['moe_router'][layer], p['moe_w_in'][layer], p['moe_w_out'][layer])
        x = _layer_norm(DN_ALPHA * x + h, p['ln_w'][layer, 2], p['ln_b'][layer, 2])
    return x


def setup_inputs(seed: int = 0) -> dict:
    key = jax.random.key(seed)
    k = jax.random.split(key, 33)
    D = D_MODEL
    nrm = lambda i, shape, scale: jax.random.normal(k[i], shape, jnp.float32) * scale
    uni = lambda i, shape, lo, hi: jax.random.uniform(k[i], shape, jnp.float32, lo, hi)
    return {
        'x_prompt': nrm(0, (BATCH, SEQ, D), 1.0),
        'x_sample': nrm(1, (DEC_BATCH, DEC_SEQ, D), 1.0),
        'mem_prompt': nrm(2, (BATCH, MEM_LEN, D), 1.0),
        'mem_sample': nrm(3, (DEC_BATCH, MEM_LEN, D), 1.0),
        'ev_w_in': nrm(4, (N_EVEN, D, D_IN_EVEN), D ** -0.5),
        'ev_lb_logits': nrm(5, (2, N_EVEN, D_A), 0.5),
        'ev_norm_a': 1.0 + nrm(6, (N_EVEN, D_A), 0.02),
        'ev_norm_b': 1.0 + nrm(7, (N_EVEN, D_B), 0.02),
        'ev_w_out': nrm(8, (N_EVEN, D_MIX_EVEN, D), D_MIX_EVEN ** -0.5 * DN_BETA),
        'od_mu': uni(9, (N_ODD, 6, D), 0.0, 1.0),
        'od_w_rkv': nrm(10, (N_ODD, 3, D, D), D ** -0.5),
        'od_w0': uni(11, (N_ODD, 2, D), -4.0, -0.5),
        'od_w1': nrm(12, (N_ODD, 2, D, LORA_W), D ** -0.5),
        'od_w2': nrm(13, (N_ODD, 2, LORA_W, D), 0.1 * LORA_W ** -0.5),
        'od_a0': nrm(14, (N_ODD, 2, D), 0.1),
        'od_a1': nrm(15, (N_ODD, 2, D, LORA_A), D ** -0.5),
        'od_a2': nrm(16, (N_ODD, 2, LORA_A, D), 0.1 * LORA_A ** -0.5),
        'od_g1': nrm(17, (N_ODD, D, LORA_G), D ** -0.5),
        'od_g2': nrm(18, (N_ODD, LORA_G, D), LORA_G ** -0.5),
        'od_k_k': 0.85 + nrm(19, (N_ODD, D), 0.02),
        'od_k_a': 1.0 + nrm(20, (N_ODD, D), 0.02),
        'od_r_k': nrm(21, (N_ODD, D), 0.1),
        'od_lnx_w': 1.0 + nrm(22, (N_ODD, D), 0.02),
        'od_lnx_b': nrm(23, (N_ODD, D), 0.02),
        'od_w_out': nrm(24, (N_ODD, D, D), D ** -0.5 * DN_BETA),
        'ca_w_q': nrm(25, (DEPTH, D, D_CA), D ** -0.5),
        'ca_w_kv': nrm(26, (DEPTH, D, 2 * D_CA), D ** -0.5),
        'ca_w_out': nrm(27, (DEPTH, D_CA, D), D_CA ** -0.5 * DN_BETA),
        'moe_router': nrm(28, (DEPTH, D, N_EXPERTS), D ** -0.5),
        'moe_w_in': nrm(29, (DEPTH, N_EXPERTS, D, 2 * D_EXPERT), D ** -0.5),
        'moe_w_out': nrm(30, (DEPTH, N_EXPERTS, D_EXPERT, D), D_EXPERT ** -0.5 * DN_BETA),
        'ln_w': 1.0 + nrm(31, (DEPTH, 3, D), 0.02),
        'ln_b': nrm(32, (DEPTH, 3, D), 0.02),
    }


def reference(x_prompt, x_sample, mem_prompt, mem_sample, ev_w_in, ev_lb_logits, ev_norm_a, ev_norm_b, ev_w_out,
              od_mu, od_w_rkv, od_w0, od_w1, od_w2, od_a0, od_a1, od_a2, od_g1, od_g2, od_k_k, od_k_a, od_r_k,
              od_lnx_w, od_lnx_b, od_w_out, ca_w_q, ca_w_kv, ca_w_out, moe_router, moe_w_in, moe_w_out, ln_w, ln_b):
    params = dict(ev_w_in=ev_w_in, ev_lb_logits=ev_lb_logits, ev_norm_a=ev_norm_a, ev_norm_b=ev_norm_b,
                  ev_w_out=ev_w_out, od_mu=od_mu, od_w_rkv=od_w_rkv, od_w0=od_w0, od_w1=od_w1, od_w2=od_w2,
                  od_a0=od_a0, od_a1=od_a1, od_a2=od_a2, od_g1=od_g1, od_g2=od_g2, od_k_k=od_k_k,
                  od_k_a=od_k_a, od_r_k=od_r_k, od_lnx_w=od_lnx_w, od_lnx_b=od_lnx_b, od_w_out=od_w_out,
                  ca_w_q=ca_w_q, ca_w_kv=ca_w_kv, ca_w_out=ca_w_out, moe_router=moe_router,
                  moe_w_in=moe_w_in, moe_w_out=moe_w_out, ln_w=ln_w, ln_b=ln_b)
    y_prompt = _trunk(x_prompt, mem_prompt, params)
    y_sample = _trunk(x_sample, mem_sample, params)
    return (y_prompt, y_sample)
```

```cpp
#include <hip/hip_runtime.h>
#include <cstdio>
#include <cstdint>

#ifndef MOE_FP8
#define MOE_FP8 1
#endif
#ifndef RESID_BF16
#define RESID_BF16 1
#endif
#ifndef Z_BF16
#define Z_BF16 1
#endif
#ifndef SCAN_CHUNKED
#define SCAN_CHUNKED 1
#endif
#ifndef MOE_GATHER_FUSED
#define MOE_GATHER_FUSED 1
#endif
#ifndef MK_PER_PHASE
#define MK_PER_PHASE 0
#endif

#define GAS __attribute__((address_space(1)))
#define LAS __attribute__((address_space(3)))
typedef unsigned short bf16;
typedef unsigned char uchar;
typedef unsigned u32x4 __attribute__((ext_vector_type(4)));
typedef int i32x4 __attribute__((ext_vector_type(4)));
typedef unsigned u32x2 __attribute__((ext_vector_type(2)));
typedef float f32x4 __attribute__((ext_vector_type(4)));
typedef float f32x2 __attribute__((ext_vector_type(2)));
typedef short bf16x8 __attribute__((ext_vector_type(8)));
typedef int v4i_t __attribute__((ext_vector_type(4)));
typedef int v8i_t __attribute__((ext_vector_type(8)));

constexpr int D = 1024, NP = 16384, NS = 32768, NTOK = NP + NS;
constexpr int NSEQ = 20, NCHUNK = NTOK / 64;
constexpr int DIN = 4608;
constexpr int NSLOT = 2 * NTOK;
constexpr float DN_ALPHA = 1.6817928305074292f;
constexpr float LN_EPS = 1e-5f;
constexpr int NWAVES = 8;

constexpr size_t MiB = 1u << 20;
constexpr size_t WS_CTL = 0, CTL_ZERO_BYTES = 1 * MiB;
constexpr size_t WS_GPH = 1 * MiB;
constexpr size_t WS_GPT = 1 * MiB + 65536;
constexpr size_t WS_ROT = 2 * MiB;
constexpr size_t WS_W_EIN = 4 * MiB;
constexpr size_t SZ_W_EIN = (size_t)2 * DIN * D * 2;
constexpr size_t WS_W_EOUT = WS_W_EIN + SZ_W_EIN;
constexpr size_t WS_W_RKV = WS_W_EOUT + (size_t)2 * D * D * 2;
constexpr size_t WS_W_L1 = WS_W_RKV + (size_t)6 * D * D * 2;
constexpr size_t WS_W_L2W = WS_W_L1 + (size_t)6 * 256 * D * 2;
constexpr size_t WS_W_L2A = WS_W_L2W + (size_t)2 * 2048 * 256 * 2;
constexpr size_t WS_W_L2G = WS_W_L2A + (size_t)2 * 2048 * 256 * 2;
constexpr size_t WS_W_OOUT = WS_W_L2G + (size_t)2 * 1024 * 256 * 2;
constexpr size_t WS_W_CQ = WS_W_OOUT + (size_t)2 * D * D * 2;
constexpr size_t WS_W_CKV = WS_W_CQ + (size_t)4 * D * D * 2;
constexpr size_t WS_W_CO = WS_W_CKV + (size_t)4 * 2048 * D * 2;
constexpr size_t WS_W_MIN = WS_W_CO + (size_t)4 * D * D * 2;
constexpr size_t WS_W_MOUT = WS_W_MIN + (size_t)64 * 4096 * D * 2;
constexpr size_t WS_MEMB = WS_W_MOUT + (size_t)64 * D * 2048 * 2;
constexpr size_t WS_KMEM = WS_MEMB + (size_t)5120 * D * 2;
constexpr size_t WS_VT = WS_KMEM + (size_t)4 * 5120 * D * 2;
constexpr size_t WS_X32 = WS_VT + (size_t)4 * 20 * 1024 * 256 * 2;
constexpr size_t WS_Z32 = WS_X32 + (size_t)NTOK * D * 4;
constexpr size_t WS_XB = WS_Z32 + (size_t)NTOK * D * 4;
constexpr size_t WS_AFF = WS_XB + (size_t)NTOK * D * 2;
constexpr size_t WS_IDX = WS_AFF + (size_t)16 * NTOK * 4;
constexpr size_t WS_GATE = WS_IDX + (size_t)NSLOT * 4;
constexpr size_t WS_INV = WS_GATE + (size_t)NSLOT * 4;
constexpr size_t WS_ARENA = WS_INV + (size_t)NTOK * 16 * 4;
static_assert(MOE_FP8 == 1 && RESID_BF16 == 1, "the folded cross-attention operands live in the halves of the MoE weight regions that fp8 leaves free and in the unused f32 residual buffer");
constexpr size_t WS_MQ = WS_W_MIN + (size_t)64 * 4096 * D;
constexpr size_t WS_WQN = WS_W_MOUT + (size_t)64 * D * 2048;
constexpr size_t WS_VW = WS_X32;
constexpr size_t WS_VMEM = WS_VT;
constexpr size_t AR_PROJ = WS_ARENA;
constexpr size_t AR_ST = AR_PROJ + (size_t)NTOK * DIN * 2;
constexpr size_t AR_DEC = AR_ST + (size_t)4 * NCHUNK * 4 * 16384 * 4;
constexpr size_t AR_OME = AR_DEC + (size_t)4 * NCHUNK * 4 * 128 * 4;
constexpr size_t AR_EVEN_END = AR_OME + (size_t)NTOK * D * 2;
constexpr size_t AR_XM = WS_ARENA;
constexpr size_t AR_H1 = AR_XM + (size_t)6 * NTOK * D * 2;
constexpr size_t AR_SCN = WS_ARENA;
constexpr size_t AR_RKV = AR_SCN + (size_t)NTOK * 16 * 1280;
constexpr size_t AR_LW = AR_RKV + (size_t)2 * NTOK * D * 2;
constexpr size_t AR_LA = AR_LW + (size_t)NTOK * 2048 * 2;
constexpr size_t AR_V = AR_LA + (size_t)NTOK * 2048 * 2;
constexpr size_t AR_GG = AR_V + (size_t)NTOK * D * 2;
constexpr size_t AR_YF = AR_GG + (size_t)NTOK * D * 2;
constexpr size_t AR_YB = AR_YF + (size_t)NTOK * D * 2;
constexpr size_t AR_CB = AR_YB + (size_t)NTOK * D * 2;
constexpr size_t AR_OMO = AR_CB + (size_t)NTOK * 16 * 4;
constexpr size_t CH_KK = 0, CH_RR = 2048, CH_NBT = 4096, CH_KT = 6144, CH_MAT = 8192, CH_G = 10240, CH_REC = 10496;
constexpr size_t AR_CH0 = AR_OMO + (size_t)NTOK * D * 2;
constexpr size_t AR_CH1 = AR_SCN;
constexpr size_t CH_BYTES = (size_t)(NTOK / 16) * 16 * CH_REC;
static_assert(AR_CH1 + CH_BYTES <= AR_RKV, "direction-1 chunk records fit in the SCN area");
constexpr size_t AR_ODD_END = AR_CH0 + CH_BYTES;
static_assert(AR_ODD_END < ((size_t)1 << 32), "32-bit buffer offsets");
static_assert(AR_H1 + (size_t)NTOK * 768 * 2 <= AR_RKV, "XM+H1 inside the SCN overlay region");
constexpr size_t AR_Q = WS_ARENA;
constexpr size_t AR_P = AR_Q + (size_t)NTOK * D * 2;
constexpr size_t AR_O = AR_P + (size_t)NTOK * D * 2;
constexpr size_t AR_XE = WS_ARENA;
constexpr size_t AR_HACT = AR_XE + (size_t)NSLOT * D * 2;
constexpr size_t AR_YE = AR_HACT + (size_t)NSLOT * 2048 * 2;
constexpr size_t AR_MOE_END = AR_YE + (size_t)NSLOT * D * 2;
constexpr size_t WS_END = AR_ODD_END > AR_EVEN_END ? (AR_ODD_END > AR_MOE_END ? AR_ODD_END : AR_MOE_END) : (AR_EVEN_END > AR_MOE_END ? AR_EVEN_END : AR_MOE_END);

constexpr int CW_BAR = 4096;

constexpr int RING_BYTES = 131072;
constexpr int XLDS_OFF = RING_BYTES;
constexpr int MISC_OFF = RING_BYTES + 8192;
constexpr int LDS_BYTES = 163840;

__device__ __forceinline__ float bf2f(unsigned short b) { return __uint_as_float(((unsigned)b) << 16); }
__device__ __forceinline__ float bflo(unsigned w) { return __uint_as_float(w << 16); }
__device__ __forceinline__ float bfhi(unsigned w) { return __uint_as_float(w & 0xffff0000u); }
__device__ __forceinline__ unsigned f2bf(float f) { unsigned u = __float_as_uint(f); return (u + 0x7fffu + ((u >> 16) & 1u)) >> 16; }
__device__ __forceinline__ unsigned short f2bf_hw(float f) { const f32x2 v = {f, 0.f}; typedef __bf16 bfx2_ __attribute__((ext_vector_type(2))); const bfx2_ b = __builtin_convertvector(v, bfx2_); return (unsigned short)__builtin_bit_cast(unsigned, b); }
typedef __bf16 bf16x2_t __attribute__((ext_vector_type(2)));
__device__ __forceinline__ unsigned pk2(float lo, float hi) { const f32x2 v = {lo, hi}; const bf16x2_t b = __builtin_convertvector(v, bf16x2_t); return __builtin_bit_cast(unsigned, b); }
__device__ __forceinline__ unsigned pk4_fp8(float a, float b, float c, float d) { int r = __builtin_amdgcn_cvt_pk_fp8_f32(a, b, 0, false); r = __builtin_amdgcn_cvt_pk_fp8_f32(c, d, r, true); return (unsigned)r; }
__device__ __forceinline__ int uni(int v) { return __builtin_amdgcn_readfirstlane(v); }
__device__ __forceinline__ int lane_id_hw() { return (int)__builtin_amdgcn_mbcnt_hi(~0u, __builtin_amdgcn_mbcnt_lo(~0u, 0u)); }
#define opaque_tid() opaque_tid_(wave_sgpr_)
__device__ __forceinline__ int opaque_tid_(int wave_s) { int l; asm volatile("v_mbcnt_lo_u32_b32 %0, -1, 0\n\tv_mbcnt_hi_u32_b32 %0, -1, %0" : "=v"(l)); return wave_s * 64 + l; }
__device__ __forceinline__ int opaque_bx() { int b = blockIdx.x; asm volatile("" : "+s"(b)); return b; }
__device__ __forceinline__ unsigned char* opaque_ptr(unsigned char* p) { GAS unsigned char* g = (GAS unsigned char*)p; asm volatile("" : "+s"(g)); return (unsigned char*)g; }
template <class T> __device__ __forceinline__ T* uniptr(T* p) { unsigned long long v = (unsigned long long)p; unsigned lo = (unsigned)uni((int)(unsigned)v), hi = (unsigned)uni((int)(unsigned)(v >> 32)); return (T*)(((unsigned long long)hi << 32) | lo); }
typedef unsigned u32x2v_ __attribute__((ext_vector_type(2)));
#ifndef SAFE_SHFL
#define SAFE_SHFL 1
#endif
#if SAFE_SHFL
__device__ __forceinline__ float shx(float v, int o, int lane) { return __builtin_bit_cast(float, __builtin_amdgcn_ds_bpermute((lane ^ o) << 2, __builtin_bit_cast(int, v))); }
#define xor16_sum(v) xor16_sum_((v), lane)
#define xor32_sum(v) xor32_sum_((v), lane)
#define xor16_max(v) xor16_max_((v), lane)
#define xor32_max(v) xor32_max_((v), lane)
#define wave_sum(v) wave_sum_((v), lane)
__device__ __forceinline__ float xor16_sum_(float v, int lane) { return v + shx(v, 16, lane); }
__device__ __forceinline__ float xor32_sum_(float v, int lane) { return v + shx(v, 32, lane); }
__device__ __forceinline__ float xor16_max_(float v, int lane) { return fmaxf(v, shx(v, 16, lane)); }
__device__ __forceinline__ float xor32_max_(float v, int lane) { return fmaxf(v, shx(v, 32, lane)); }
__device__ __forceinline__ float wave_sum_(float v, int lane) {
#pragma unroll
    for (int o = 1; o < 64; o <<= 1) v += shx(v, o, lane);
    return v;
}
#else
__device__ __forceinline__ float xor16_sum(float v) { const unsigned x = __builtin_bit_cast(unsigned, v); const u32x2v_ r = __builtin_amdgcn_permlane16_swap(x, x, false, false); return __builtin_bit_cast(float, r.x) + __builtin_bit_cast(float, r.y); }
__device__ __forceinline__ float xor32_sum(float v) { const unsigned x = __builtin_bit_cast(unsigned, v); const u32x2v_ r = __builtin_amdgcn_permlane32_swap(x, x, false, false); return __builtin_bit_cast(float, r.x) + __builtin_bit_cast(float, r.y); }
__device__ __forceinline__ float xor16_max(float v) { const unsigned x = __builtin_bit_cast(unsigned, v); const u32x2v_ r = __builtin_amdgcn_permlane16_swap(x, x, false, false); return fmaxf(__builtin_bit_cast(float, r.x), __builtin_bit_cast(float, r.y)); }
__device__ __forceinline__ float xor32_max(float v) { const unsigned x = __builtin_bit_cast(unsigned, v); const u32x2v_ r = __builtin_amdgcn_permlane32_swap(x, x, false, false); return fmaxf(__builtin_bit_cast(float, r.x), __builtin_bit_cast(float, r.y)); }
__device__ __forceinline__ float wave_sum(float v) {
    v += __builtin_bit_cast(float, __builtin_amdgcn_mov_dpp(__builtin_bit_cast(int, v), 0xB1, 0xF, 0xF, true));
    v += __builtin_bit_cast(float, __builtin_amdgcn_mov_dpp(__builtin_bit_cast(int, v), 0x4E, 0xF, 0xF, true));
    v += __builtin_bit_cast(float, __builtin_amdgcn_mov_dpp(__builtin_bit_cast(int, v), 0x141, 0xF, 0xF, true));
    v += __builtin_bit_cast(float, __builtin_amdgcn_mov_dpp(__builtin_bit_cast(int, v), 0x140, 0xF, 0xF, true));
    return xor32_sum(xor16_sum(v));
}
#endif
__device__ __forceinline__ float quad_sum(float v) {
    v += __builtin_bit_cast(float, __builtin_amdgcn_mov_dpp(__builtin_bit_cast(int, v), 0xB1, 0xF, 0xF, true));
    v += __builtin_bit_cast(float, __builtin_amdgcn_mov_dpp(__builtin_bit_cast(int, v), 0x4E, 0xF, 0xF, true));
    return v;
}
__device__ __forceinline__ float exp_(float x) { return __builtin_amdgcn_exp2f(x * 1.4426950408889634f); }
__device__ __forceinline__ float log_(float x) { return __builtin_amdgcn_logf(x) * 0.6931471805599453f; }
__device__ __forceinline__ float sigmoidf_(float x) { return __builtin_amdgcn_rcpf(1.f + exp_(-x)); }
__device__ __forceinline__ float siluf_(float x) { return x * __builtin_amdgcn_rcpf(1.f + exp_(-x)); }
__device__ __forceinline__ float tanhf_(float x) { return 1.f - 2.f * __builtin_amdgcn_rcpf(exp_(2.f * x) + 1.f); }
#define LDS_WAIT() asm volatile("s_waitcnt lgkmcnt(0)" ::: "memory")
#define VM_WAIT() asm volatile("s_waitcnt vmcnt(0)" ::: "memory")

__device__ __forceinline__ int row_pos(int r) { return r < NP ? (r & 4095) : ((r - NP) & 2047); }
__device__ __forceinline__ int row_T(int r) { return r < NP ? 4096 : 2048; }
__device__ __forceinline__ int seq_row0(int s) { return s < 4 ? s * 4096 : NP + (s - 4) * 2048; }
__device__ __forceinline__ int seq_T(int s) { return s < 4 ? 4096 : 2048; }

#define XB_TMO      128
#define XB_XCNT(j)  (256  + 64 * (j))
#define XB_XSUB(j)  (1280 + 64 * (j))
#define XB_XGEN(j)  (2304 + 64 * (j))
#define XB_TOP      3328
#define XB_TOPGEN   3392
#define XCD_BAR_WORDS 3456
#define XB_SPIN_CAP (1u << 22)

__device__ __forceinline__ unsigned xb_ld(unsigned* p)              { return __hip_atomic_load(p, __ATOMIC_RELAXED, __HIP_MEMORY_SCOPE_AGENT); }
__device__ __forceinline__ unsigned xb_add(unsigned* p, unsigned v) { return __hip_atomic_fetch_add(p, v, __ATOMIC_RELAXED, __HIP_MEMORY_SCOPE_AGENT); }
__device__ __forceinline__ unsigned xb_xcc_id() { return (unsigned)__builtin_amdgcn_s_getreg((3 << 11) | 20) & 0xFu; }
#define XB_SPIN(cond, bar) do { unsigned _sp = 0; while (cond) { __builtin_amdgcn_s_sleep(1); \
    if ((++_sp & 255u) == 0u) { if (xb_ld(&(bar)[XB_TMO])) break; if (_sp > XB_SPIN_CAP) { atomicAdd(&(bar)[XB_TMO], 1u); break; } } } } while (0)

struct XcdBarrier { unsigned* bar; unsigned x; volatile LAS unsigned* st; };

__device__ __forceinline__ XcdBarrier xcd_barrier_post(unsigned* bar, volatile LAS unsigned* st) {
    XcdBarrier b; b.bar = bar; b.x = xb_xcc_id(); b.st = st;
    if (threadIdx.x == 0) (void)xb_add(&bar[XB_XCNT(b.x)], 1u);
    return b;
}
__device__ __forceinline__ void xcd_barrier_complete(unsigned* bar, unsigned x, unsigned& nloc, unsigned& nx) {
    const unsigned G = gridDim.x * gridDim.y * gridDim.z;
    unsigned sum, cnt, mine, sp = 0u;
    for (;;) {
        sum = 0u; cnt = 0u; mine = 0u;
#pragma unroll
        for (unsigned j = 0; j < 16; ++j) { const unsigned c = xb_ld(&bar[XB_XCNT(j)]); sum += c; cnt += (c > 0u) ? 1u : 0u; mine = (j == x) ? c : mine; }
        if (sum == G) break;
        __builtin_amdgcn_s_sleep(1);
        if ((++sp & 255u) == 0u) { if (xb_ld(&bar[XB_TMO])) break; if (sp > XB_SPIN_CAP) { atomicAdd(&bar[XB_TMO], 1u); break; } }
    }
    nloc = mine > 0u ? mine : 1u; nx = cnt > 0u ? cnt : 1u;
}
__device__ __forceinline__ void xcd_barrier(const XcdBarrier& b, bool is_t0) {
    asm volatile("s_waitcnt vmcnt(0)" ::: "memory");
    __syncthreads();
    if (is_t0) {
        GAS unsigned* barg_ = (GAS unsigned*)b.bar; asm volatile("" : "+s"(barg_)); unsigned* bar = (unsigned*)barg_;
        __builtin_amdgcn_s_waitcnt(0);
        unsigned nloc = b.st[0], nx = b.st[1];
        if (nloc == 0u) { xcd_barrier_complete(bar, b.x, nloc, nx); b.st[0] = nloc; b.st[1] = nx; }
        const unsigned old = xb_add(&bar[XB_XSUB(b.x)], 1u);
        const unsigned gen = old / nloc;
        if (old + 1u == (gen + 1u) * nloc) {
            __builtin_amdgcn_fence(__ATOMIC_RELEASE, "agent");
            asm volatile("s_waitcnt vmcnt(0)" ::: "memory");
            const unsigned og = xb_add(&bar[XB_TOP], 1u);
            const unsigned tg = og / nx;
            if (og + 1u == (tg + 1u) * nx) xb_add(&bar[XB_TOPGEN], 1u);
            else XB_SPIN(xb_ld(&bar[XB_TOPGEN]) == tg, bar);
            __builtin_amdgcn_fence(__ATOMIC_ACQUIRE, "agent");
            xb_add(&bar[XB_XGEN(b.x)], 1u);
            asm volatile("s_waitcnt vmcnt(0)" ::: "memory");
        } else {
            XB_SPIN(xb_ld(&bar[XB_XGEN(b.x)]) == gen, bar);
            __builtin_amdgcn_fence(__ATOMIC_ACQUIRE, "agent");
            asm volatile("s_waitcnt vmcnt(0)" ::: "memory");
        }
    }
    __syncthreads();
}

enum { EPI_BF16 = 0, EPI_RESID = 1, EPI_SWIGLU = 2, EPI_ROWSCALE = 3, EPI_SOFTMAX = 4 };
struct GP { const bf16* A; const bf16* B; void* C; const void* aux; int mt, nt, ustart, ldc, epi; float scale; int pad0, pad1; };
struct GPhase { int first, count, K, lda, ldb, total, cntA, szA, szB, pad0, pad1, pad2, pad3, pad4, pad5, pad6; };
static_assert(sizeof(GP) == 64 && sizeof(GPhase) == 64, "table layout");

namespace pg8 {
constexpr int BM = 256, BK = 64, HALF = 128, HTB = HALF * BK * 2, STAGE_BYTES = 8 * HTB, NXCD = 8, WGM = 16;
__host__ __device__ __forceinline__ int lds_byte(int r, int c) { const int st = (r >> 4) * 2 + (c >> 5), rr = r & 15, cc = c & 31, ob = rr * 64 + cc * 2; return st * 1024 + (ob ^ (((ob >> 9) & 1) << 5)); }
__host__ __device__ __forceinline__ void stage_rc(int b, int& R, int& C) { const int st = b / 1024, sb = b % 1024, swz = sb ^ (((sb >> 9) & 1) << 5); R = (st >> 1) * 16 + swz / 64; C = (st & 1) * 32 + (swz % 64) / 2; }
__host__ __device__ __forceinline__ int perm32(int rho) { const int n = rho >> 4, i = rho & 15; return 8 * (i >> 2) + 4 * n + (i & 3); }
struct Unit { int pm, pn, p; };
#define CAS __attribute__((address_space(4)))
__device__ __forceinline__ int cld32(const void* p) { return *(const CAS int*)p; }
__device__ __forceinline__ unsigned long long cld64(const void* p) { return *(const CAS unsigned long long*)p; }

struct TableOrder {
    const GP* tab; int nprob, total, G, c, cntA, szA, szB;
    __device__ __forceinline__ bool next(int i, Unit& u) const {
        const long L = (long)i * G + c; if (L >= total) return false;
        const int La = cntA * szA; int p, l;
        if ((int)L < La) { p = (int)L / szA; l = (int)L - p * szA; } else { const int q_ = ((int)L - La) / szB; p = cntA + q_; l = (int)L - La - q_ * szB; }
        const int nM = cld32(&tab[p].mt), nN = cld32(&tab[p].nt), nwg = nM * nN;
        int wgid = l; { const int q = nwg / NXCD, r = nwg % NXCD, xcd = wgid % NXCD, off = wgid / NXCD; wgid = (xcd < r ? xcd * (q + 1) : r * (q + 1) + (xcd - r) * q) + off; }
        const int nig = WGM * nN, gid = wgid / nig, fm = gid * WGM, gsz = (nM - fm) < WGM ? (nM - fm) : WGM;
        u.pm = fm + ((wgid % nig) % gsz); u.pn = (wgid % nig) / gsz; u.p = p; return true;
    }
};

template <int KIND, bool FP8> __device__ __forceinline__ void epilogue(const GP* Pp, f32x4 (&acc)[2][2][4][2], const Unit& u, int wr, int wc, int fr, int fq, LAS uchar* xlds) {
    const int epi = cld32(&Pp->epi), kind = KIND, act = epi >> 8, ldc = cld32(&Pp->ldc);
    const int row0 = u.pm * BM + wr * 64 + fr, colL = wc * 32 + 8 * fq, lane = fq * 16 + fr; (void)lane;
    if constexpr (KIND == EPI_BF16) {
        GAS bf16* C = (GAS bf16*)cld64(&Pp->C);
#pragma unroll
        for (int ai = 0; ai < 2; ++ai)
#pragma unroll
            for (int m = 0; m < 4; ++m) { GAS bf16* rowp = C + (size_t)(row0 + ai * HALF + m * 16) * ldc + u.pn * BM + colL;
#pragma unroll
                for (int bj = 0; bj < 2; ++bj) { f32x4 v0 = acc[ai][bj][m][0], v1 = acc[ai][bj][m][1];
                    if (act == 1) {
#pragma unroll
                        for (int j = 0; j < 4; ++j) { v0[j] = tanhf_(v0[j]); v1[j] = tanhf_(v1[j]); } }
                    else if (act == 2) {
#pragma unroll
                        for (int j = 0; j < 4; ++j) { v0[j] = sigmoidf_(v0[j]); v1[j] = sigmoidf_(v1[j]); } }
                    u32x4 w; w.x = pk2(v0[0], v0[1]); w.y = pk2(v0[2], v0[3]); w.z = pk2(v1[0], v1[1]); w.w = pk2(v1[2], v1[3]);
                    *(GAS u32x4*)(rowp + bj * HALF) = w; } }
    } else if constexpr (KIND == EPI_RESID) {
        GAS float* Z = (GAS float*)cld64(&Pp->C);
#if RESID_BF16
        const GAS bf16* X = (const GAS bf16*)cld64(&Pp->aux);
        u32x4 xwa[2][4][2];
#pragma unroll
        for (int ai = 0; ai < 2; ++ai)
#pragma unroll
            for (int m = 0; m < 4; ++m) { const size_t off = (size_t)(row0 + ai * HALF + m * 16) * ldc + u.pn * BM + colL;
#pragma unroll
                for (int bj = 0; bj < 2; ++bj) xwa[ai][m][bj] = *(const GAS u32x4*)(X + off + bj * HALF); }
#pragma unroll
        for (int ai = 0; ai < 2; ++ai)
#pragma unroll
            for (int m = 0; m < 4; ++m) { const size_t off = (size_t)(row0 + ai * HALF + m * 16) * ldc + u.pn * BM + colL;
#pragma unroll
                for (int bj = 0; bj < 2; ++bj) { const u32x4 xw = xwa[ai][m][bj];
                    const f32x4 x0 = (f32x4){bflo(xw.x), bfhi(xw.x), bflo(xw.y), bfhi(xw.y)}, x1 = (f32x4){bflo(xw.z), bfhi(xw.z), bflo(xw.w), bfhi(xw.w)};
                    const f32x4 z0 = x0 * DN_ALPHA + acc[ai][bj][m][0], z1 = x1 * DN_ALPHA + acc[ai][bj][m][1];
#if Z_BF16
                    u32x4 zw; zw.x = pk2(z0[0], z0[1]); zw.y = pk2(z0[2], z0[3]); zw.z = pk2(z1[0], z1[1]); zw.w = pk2(z1[2], z1[3]);
                    *(GAS u32x4*)((GAS bf16*)Z + off + bj * HALF) = zw;
#else
                    *(GAS f32x4*)(Z + off + bj * HALF) = z0; *(GAS f32x4*)(Z + off + bj * HALF + 4) = z1;
#endif
                    } }
#else
        const GAS float* X = (const GAS float*)cld64(&Pp->aux);
#pragma unroll
        for (int ai = 0; ai < 2; ++ai)
#pragma unroll
            for (int m = 0; m < 4; ++m) { const size_t off = (size_t)(row0 + ai * HALF + m * 16) * ldc + u.pn * BM + colL;
#pragma unroll
                for (int bj = 0; bj < 2; ++bj)
#pragma unroll
                    for (int n = 0; n < 2; ++n) { const f32x4 x = *(const GAS f32x4*)(X + off + bj * HALF + 4 * n); *(GAS f32x4*)(Z + off + bj * HALF + 4 * n) = x * DN_ALPHA + acc[ai][bj][m][n]; } }
#endif
    } else if constexpr (KIND == EPI_SWIGLU) {
        if constexpr (FP8) {
            GAS uchar* C = (GAS uchar*)cld64(&Pp->C);
#pragma unroll
            for (int ai = 0; ai < 2; ++ai)
#pragma unroll
                for (int m = 0; m < 4; ++m) { GAS uchar* rowp = C + (size_t)(row0 + ai * HALF + m * 16) * ldc + u.pn * HALF + colL;
                    float h[8];
#pragma unroll
                    for (int n = 0; n < 2; ++n)
#pragma unroll
                        for (int p = 0; p < 2; ++p) {
                            const f32x2 g2 = (f32x2){acc[ai][0][m][n][2 * p], acc[ai][0][m][n][2 * p + 1]}, u2 = (f32x2){acc[ai][1][m][n][2 * p], acc[ai][1][m][n][2 * p + 1]};
                            const f32x2 ea = g2 * (-1.4426950408889634f / 32.f);
                            f32x2 e2; e2.x = __builtin_amdgcn_exp2f(ea.x); e2.y = __builtin_amdgcn_exp2f(ea.y);
                            const f32x2 a2 = e2 + 1.f;
                            f32x2 r2; r2.x = __builtin_amdgcn_rcpf(a2.x); r2.y = __builtin_amdgcn_rcpf(a2.y);
                            f32x2 h2 = (g2 * u2) * r2; h2 = h2 * (1.f / 128.f);
                            asm volatile("" : "+v"(h2));
                            h[4 * n + 2 * p] = h2.x; h[4 * n + 2 * p + 1] = h2.y; }
                    u32x2 w; w.x = pk4_fp8(h[0], h[1], h[2], h[3]); w.y = pk4_fp8(h[4], h[5], h[6], h[7]);
                    *(GAS u32x2*)rowp = w; }
        } else {
        GAS bf16* C = (GAS bf16*)cld64(&Pp->C);
#pragma unroll
        for (int ai = 0; ai < 2; ++ai)
#pragma unroll
            for (int m = 0; m < 4; ++m) { GAS bf16* rowp = C + (size_t)(row0 + ai * HALF + m * 16) * ldc + u.pn * HALF + colL;
                f32x4 h0, h1;
#pragma unroll
                for (int j = 0; j < 4; ++j) { h0[j] = siluf_(acc[ai][0][m][0][j]) * acc[ai][1][m][0][j]; h1[j] = siluf_(acc[ai][0][m][1][j]) * acc[ai][1][m][1][j]; }
                u32x4 w; w.x = pk2(h0[0], h0[1]); w.y = pk2(h0[2], h0[3]); w.z = pk2(h1[0], h1[1]); w.w = pk2(h1[2], h1[3]);
                *(GAS u32x4*)rowp = w; }
        }
    } else if constexpr (KIND == EPI_ROWSCALE) {
        GAS bf16* C = (GAS bf16*)cld64(&Pp->C); const GAS float* gate = (const GAS float*)cld64(&Pp->aux);
        float ga[2][4];
#pragma unroll
        for (int ai = 0; ai < 2; ++ai)
#pragma unroll
            for (int m = 0; m < 4; ++m) ga[ai][m] = gate[row0 + ai * HALF + m * 16];
#pragma unroll
        for (int ai = 0; ai < 2; ++ai)
#pragma unroll
            for (int m = 0; m < 4; ++m) { const int row = row0 + ai * HALF + m * 16; const float g = ga[ai][m] * (FP8 ? (1.0f / 1024.0f) : 1.0f); GAS bf16* rowp = C + (size_t)row * ldc + u.pn * BM + colL;
#pragma unroll
                for (int bj = 0; bj < 2; ++bj) { const f32x4 v0 = acc[ai][bj][m][0] * g, v1 = acc[ai][bj][m][1] * g;
                    u32x4 w; w.x = pk2(v0[0], v0[1]); w.y = pk2(v0[2], v0[3]); w.z = pk2(v1[0], v1[1]); w.w = pk2(v1[2], v1[3]);
                    *(GAS u32x4*)(rowp + bj * HALF) = w; } }
    } else {
        GAS bf16* C = (GAS bf16*)cld64(&Pp->C);
        const float sc = __uint_as_float((unsigned)cld32(&Pp->scale)) * 1.4426950408889634f;
        LAS f32x2* SMX = (LAS f32x2*)xlds;
        float mloc[2][4];
#pragma unroll
        for (int ai = 0; ai < 2; ++ai)
#pragma unroll
            for (int m = 0; m < 4; ++m) {
                float mx = -3.0e38f;
#pragma unroll
                for (int bj = 0; bj < 2; ++bj)
#pragma unroll
                    for (int n = 0; n < 2; ++n)
#pragma unroll
                        for (int j = 0; j < 4; ++j) mx = fmaxf(mx, acc[ai][bj][m][n][j]);
                mx = xor32_max(xor16_max(mx));
                const float nmx = -mx * sc;
                float s = 0.f;
#pragma unroll
                for (int bj = 0; bj < 2; ++bj)
#pragma unroll
                    for (int n = 0; n < 2; ++n)
#pragma unroll
                        for (int j = 0; j < 4; ++j) { const float e = __builtin_amdgcn_exp2f(__builtin_fmaf(acc[ai][bj][m][n][j], sc, nmx)); acc[ai][bj][m][n][j] = e; s += e; }
                s = xor32_sum(xor16_sum(s));
                mloc[ai][m] = mx;
                if (fq == 0) SMX[(ai * HALF + wr * 64 + m * 16 + fr) * 4 + wc] = (f32x2){mx, s};
            }
        LDS_WAIT(); __builtin_amdgcn_s_barrier(); asm volatile("" ::: "memory");
#pragma unroll
        for (int ai = 0; ai < 2; ++ai)
#pragma unroll
            for (int m = 0; m < 4; ++m) {
                const int rt = ai * HALF + wr * 64 + m * 16 + fr;
                const f32x2 a = SMX[rt * 4 + 0], b = SMX[rt * 4 + 1], c = SMX[rt * 4 + 2], d = SMX[rt * 4 + 3];
                const float M = fmaxf(fmaxf(a.x, b.x), fmaxf(c.x, d.x));
                const float tot = a.y * __builtin_amdgcn_exp2f((a.x - M) * sc) + b.y * __builtin_amdgcn_exp2f((b.x - M) * sc) + c.y * __builtin_amdgcn_exp2f((c.x - M) * sc) + d.y * __builtin_amdgcn_exp2f((d.x - M) * sc);
                const float f = __builtin_amdgcn_exp2f((mloc[ai][m] - M) * sc) * __builtin_amdgcn_rcpf(tot);
                GAS bf16* rowp = C + (size_t)(row0 + ai * HALF + m * 16) * ldc + u.pn * BM + colL;
#pragma unroll
                for (int bj = 0; bj < 2; ++bj) { const f32x4 v0 = acc[ai][bj][m][0] * f, v1 = acc[ai][bj][m][1] * f;
                    u32x4 w; w.x = pk2(v0[0], v0[1]); w.y = pk2(v0[2], v0[3]); w.z = pk2(v1[0], v1[1]); w.w = pk2(v1[2], v1[3]);
                    *(GAS u32x4*)(rowp + bj * HALF) = w; }
            }
        LDS_WAIT(); __builtin_amdgcn_s_barrier(); asm volatile("" ::: "memory");
    }
}

template <int KIND, bool FP8 = false> __device__ __forceinline__ void gemm_phase(LAS uchar* lds, LAS uchar* xlds, const GPhase* php, const GP* tab_all, int G, int c, const unsigned char* wsb, int wave_sgpr_) {
    const int tid = opaque_tid(), wid = uni(tid >> 6), lane = tid & 63, wr = wid >> 2, wc = wid & 3, fr = lane & 15, fq = lane >> 4;
    const int K = uni(php->K), lda = uni(php->lda), ldb = uni(php->ldb), nt = K / 128;
    TableOrder S; S.tab = tab_all + uni(php->first); S.nprob = uni(php->count); S.total = uni(php->total); S.G = G; S.c = c; S.cntA = uni(php->cntA); S.szA = uni(php->szA); S.szB = uni(php->szB);
    constexpr bool GATH = MOE_GATHER_FUSED && FP8 && KIND == EPI_SWIGLU;
    unsigned voffA[2], voffB[2], voffA1[2], nvP0 = 0u, nvP1 = 0u;
#pragma unroll
    for (int i = 0; i < 2; ++i) { int R, C; stage_rc(tid * 16 + i * 8192, R, C); const int Rb = (R & ~31) + perm32(R & 31);
        voffA[i] = (unsigned)(R * lda + C * 2); voffB[i] = (unsigned)(Rb * ldb + C * 2); voffA1[i] = voffA[i]; }
    const __amdgpu_buffer_rsrc_t rsrc = __builtin_amdgcn_make_buffer_rsrc((void*)wsb, 0, 0xffffffff, 0x00020000);
    const unsigned kstep = (unsigned)(BK * 2);
    const unsigned hstepA = (unsigned)HALF * lda, hstepB = (unsigned)HALF * ldb;
    const unsigned tstepA = 2 * hstepA, tstepB = 2 * hstepB;
    const unsigned ldsw = (unsigned)wid * 1024u;
    const int aoff = lds_byte(wr * 64 + fr, fq * 8), boff = lds_byte(wc * 32 + fr, fq * 8);
#define PG8_SA(b, h) (((b) * 2 + (h)) * HTB)
#define PG8_SB(b, h) ((4 + (b) * 2 + (h)) * HTB)
#ifndef USE_BUFLD
#define USE_BUFLD 1
#endif
#if USE_BUFLD
#define PG8_STAGE(bufoff, gbase, voff) do { _Pragma("unroll") for (int _i = 0; _i < 2; ++_i) \
        __builtin_amdgcn_raw_ptr_buffer_load_lds(rsrc, (LAS void*)(lds + (bufoff) + ldsw + _i * 8192), 16, (int)(voff)[_i], (int)(gbase), 0, 0); } while (0)
#else
#define PG8_STAGE(bufoff, gbase, voff) do { _Pragma("unroll") for (int _i = 0; _i < 2; ++_i) \
        __builtin_amdgcn_global_load_lds((const unsigned*)((const char*)wsb + (size_t)(gbase) + (voff)[_i]), (LAS unsigned*)(lds + (bufoff) + ldsw + _i * 8192), 16, 0, 0); } while (0)
#endif
#define PG8_LD8(ptr_) __builtin_shufflevector(*(const LAS v4i_t*)(ptr_), *(const LAS v4i_t*)((ptr_) + 1024), 0, 1, 2, 3, 4, 5, 6, 7)
#define PG8_LDA(dst, b, h) do { _Pragma("unroll") for (int m = 0; m < 4; ++m) { if constexpr (FP8) dst##8[m] = PG8_LD8(lds + PG8_SA(b, h) + aoff + m * 2048); \
        else { _Pragma("unroll") for (int k = 0; k < 2; ++k) dst[m][k] = *(const LAS bf16x8*)(lds + PG8_SA(b, h) + aoff + m * 2048 + k * 1024); } } } while (0)
#define PG8_LDB(dst, b, h) do { _Pragma("unroll") for (int n = 0; n < 2; ++n) { if constexpr (FP8) dst##8[n] = PG8_LD8(lds + PG8_SB(b, h) + boff + n * 2048); \
        else { _Pragma("unroll") for (int k = 0; k < 2; ++k) dst[n][k] = *(const LAS bf16x8*)(lds + PG8_SB(b, h) + boff + n * 2048 + k * 1024); } } } while (0)
#define PG8_MMA(ai, bj, At, Bt) do { __builtin_amdgcn_s_setprio(1); _Pragma("unroll") for (int m = 0; m < 4; ++m) _Pragma("unroll") for (int n = 0; n < 2; ++n) { \
        if constexpr (FP8) acc[ai][bj][m][n] = __builtin_amdgcn_mfma_scale_f32_16x16x128_f8f6f4(Bt##8[n], At##8[m], acc[ai][bj][m][n], 0, 0, 0, 0, 0, 0); \
        else { _Pragma("unroll") for (int k = 0; k < 2; ++k) acc[ai][bj][m][n] = __builtin_amdgcn_mfma_f32_16x16x32_bf16(Bt[n][k], At[m][k], acc[ai][bj][m][n], 0, 0, 0); } } \
        __builtin_amdgcn_s_setprio(0); } while (0)
#define PG8_WAIT_V(n) asm volatile("s_waitcnt vmcnt(" #n ")" ::: "memory")
#define PG8_WAIT_L(n) asm volatile("s_waitcnt lgkmcnt(" #n ")" ::: "memory")
#define PG8_BAR __builtin_amdgcn_s_barrier()
#define PG8_SCHED __builtin_amdgcn_sched_barrier(0)
    Unit cur, nxt; int ui = 0;
    if (!S.next(0, cur)) return;
    f32x4 acc[2][2][4][2];
#pragma unroll
    for (int a = 0; a < 2; ++a)
#pragma unroll
        for (int b = 0; b < 2; ++b)
#pragma unroll
            for (int m = 0; m < 4; ++m)
#pragma unroll
                for (int n = 0; n < 2; ++n) acc[a][b][m][n] = (f32x4){0.f, 0.f, 0.f, 0.f};
    bf16x8 At[4][2], B0[2][2], B1[2][2]; v8i_t At8[4], B08[2], B18[2]; (void)At; (void)B0; (void)B1; (void)At8; (void)B08; (void)B18;
#define PG8_OFF(p_) ((unsigned)(cld64(&(p_)) - (unsigned long long)wsb))
    const unsigned hsA = GATH ? 0u : hstepA;
#define PG8_GATHP(u_, p0_, p1_) do { const GAS int* ip_ = (const GAS int*)cld64(&S.tab[(u_).p].aux) + (u_).pm * 256; const int tz_ = opaque_tid(); int Ra_, Rb_, C_; \
        stage_rc(tz_ * 16, Ra_, C_); stage_rc(tz_ * 16 + 8192, Rb_, C_); \
        (p0_) = (unsigned)ip_[Ra_] | ((unsigned)ip_[Rb_] << 16); (p1_) = (unsigned)ip_[128 + Ra_] | ((unsigned)ip_[128 + Rb_] << 16); } while (0)
#define PG8_EXPAND(p0_, p1_) do { voffA[0] = (((p0_) & 0xffffu) << 10) | (voffA[0] & 1023u); voffA[1] = (((p0_) >> 16) << 10) | (voffA[1] & 1023u); \
        voffA1[0] = (((p1_) & 0xffffu) << 10) | (voffA1[0] & 1023u); voffA1[1] = (((p1_) >> 16) << 10) | (voffA1[1] & 1023u); } while (0)
    static_assert(!MOE_GATHER_FUSED || NTOK <= 65536, "16-bit row ids");
    if constexpr (GATH) { PG8_GATHP(cur, nvP0, nvP1); PG8_EXPAND(nvP0, nvP1); }
    unsigned cA = PG8_OFF(S.tab[cur.p].A) + (GATH ? 0u : (unsigned)cur.pm * tstepA), cB = PG8_OFF(S.tab[cur.p].B) + (unsigned)cur.pn * tstepB;
    PG8_STAGE(PG8_SB(0, 0), cB, voffB); PG8_STAGE(PG8_SB(0, 1), cB + hstepB, voffB); PG8_STAGE(PG8_SA(0, 0), cA, voffA); PG8_STAGE(PG8_SA(0, 1), cA + hsA, voffA1);
    if (wr == 1) PG8_BAR;
    PG8_WAIT_V(2); PG8_BAR;
    PG8_STAGE(PG8_SB(1, 0), cB + kstep, voffB); PG8_STAGE(PG8_SA(1, 0), cA + kstep, voffA); PG8_STAGE(PG8_SB(1, 1), cB + hstepB + kstep, voffB);
    PG8_WAIT_V(6); PG8_BAR;
    for (;;) {
        const bool has_next = S.next(ui + 1, nxt);
        if constexpr (GATH) {
            if (has_next && wid == 0) __builtin_amdgcn_raw_ptr_buffer_load_lds(rsrc, (LAS void*)xlds, 16, (int)(lane * 16), (int)(PG8_OFF(S.tab[nxt.p].aux) + (unsigned)nxt.pm * 1024u), 0, 0); }
        const unsigned nA = has_next ? PG8_OFF(S.tab[nxt.p].A) + (GATH ? 0u : (unsigned)nxt.pm * tstepA) : cA, nB = has_next ? PG8_OFF(S.tab[nxt.p].B) + (unsigned)nxt.pn * tstepB : cB;
        for (int t = 0; t < nt; t += 2) {
            const bool last = (t == nt - 2);
            const unsigned a1 = cA + (unsigned)(t + 1) * kstep;
            const unsigned a2 = last ? nA : cA + (unsigned)(t + 2) * kstep, b2 = last ? nB : cB + (unsigned)(t + 2) * kstep;
            const unsigned a3 = a2 + kstep, b3 = b2 + kstep;
            PG8_LDB(B0, 0, 0); PG8_LDB(B1, 0, 1); PG8_SCHED; PG8_LDA(At, 0, 0); PG8_STAGE(PG8_SA(1, 1), a1 + hsA, voffA1);
            if constexpr (GATH) { if (last && has_next) {
                const LAS int* il_ = (const LAS int*)xlds; const int tz_ = opaque_tid(); int Ra_, Rb_, C_; stage_rc(tz_ * 16, Ra_, C_); stage_rc(tz_ * 16 + 8192, Rb_, C_);
                nvP0 = (unsigned)il_[Ra_] | ((unsigned)il_[Rb_] << 16); nvP1 = (unsigned)il_[128 + Ra_] | ((unsigned)il_[128 + Rb_] << 16);
                PG8_EXPAND(nvP0, nvP1); } }
            PG8_WAIT_V(8); PG8_WAIT_L(0); PG8_BAR; PG8_MMA(0, 0, At, B0); PG8_MMA(0, 1, At, B1); PG8_BAR; PG8_SCHED;
            PG8_LDA(At, 0, 1); PG8_STAGE(PG8_SB(0, 0), b2, voffB); PG8_STAGE(PG8_SB(0, 1), b2 + hstepB, voffB); PG8_STAGE(PG8_SA(0, 0), a2, voffA);
            PG8_WAIT_V(8); PG8_WAIT_L(0); PG8_BAR; PG8_MMA(1, 0, At, B0); PG8_MMA(1, 1, At, B1); PG8_BAR; PG8_SCHED;
            PG8_LDB(B0, 1, 0); PG8_LDB(B1, 1, 1); PG8_SCHED; PG8_LDA(At, 1, 0); PG8_STAGE(PG8_SA(0, 1), a2 + hsA, voffA1);
            PG8_WAIT_V(8); PG8_WAIT_L(0); PG8_BAR; PG8_MMA(0, 0, At, B0); PG8_MMA(0, 1, At, B1); PG8_BAR; PG8_SCHED;
            PG8_LDA(At, 1, 1); PG8_STAGE(PG8_SB(1, 0), b3, voffB); PG8_STAGE(PG8_SB(1, 1), b3 + hstepB, voffB); PG8_STAGE(PG8_SA(1, 0), a3, voffA);
            PG8_WAIT_V(8); PG8_WAIT_L(0); PG8_BAR; PG8_MMA(1, 0, At, B0); PG8_MMA(1, 1, At, B1); PG8_BAR; PG8_SCHED;
        }
        if (wr == 0) PG8_BAR;
        { const int tz2 = opaque_tid(), wid2 = uni(tz2 >> 6), lane2 = tz2 & 63;
          epilogue<KIND, FP8>(S.tab + cur.p, acc, cur, wid2 >> 2, wid2 & 3, lane2 & 15, lane2 >> 4, xlds); }
        if (!has_next) break;
#pragma unroll
        for (int a = 0; a < 2; ++a)
#pragma unroll
            for (int b = 0; b < 2; ++b)
#pragma unroll
                for (int m = 0; m < 4; ++m)
#pragma unroll
                    for (int n = 0; n < 2; ++n) acc[a][b][m][n] = (f32x4){0.f, 0.f, 0.f, 0.f};
        cur = nxt; cA = nA; cB = nB; ++ui;
        if (wr == 1) PG8_BAR;
    }
    PG8_WAIT_V(0);
    PG8_BAR;
#undef PG8_OFF
#undef PG8_GATHP
#undef PG8_EXPAND
#undef PG8_SA
#undef PG8_SB
#undef PG8_STAGE
#undef PG8_LDA
#undef PG8_LDB
#undef PG8_MMA
#undef PG8_WAIT_V
#undef PG8_WAIT_L
#undef PG8_BAR
#undef PG8_SCHED
}
}

struct Args { const float* in[33]; float* out; unsigned char* ws; int ph_lo, ph_hi; };
enum { I_XP = 0, I_XS, I_MP, I_MS, I_EWIN, I_ELB, I_ENA, I_ENB, I_EWOUT, I_OMU, I_ORKV, I_OW0, I_OW1, I_OW2, I_OA0, I_OA1, I_OA2, I_OG1, I_OG2, I_OKK, I_OKA, I_ORK, I_OLNW, I_OLNB, I_OWOUT,
       I_CWQ, I_CWKV, I_CWO, I_MR, I_MWIN, I_MWOUT, I_LNW, I_LNB };

constexpr int GPH_PRO = 36, GPH_PRO2 = 37;

__device__ __forceinline__ void transpose_load(f32x4 (&rg)[8], const float* W, int ldw, int k0, int n0, int lane) {
#pragma unroll
    for (int i = 0; i < 8; ++i) rg[i] = *(const f32x4*)(W + (size_t)(k0 + 8 * i + (lane >> 3)) * ldw + n0 + 4 * (lane & 7));
}
__device__ __forceinline__ void transpose_finish(const f32x4 (&rg)[8], bf16* dst, int ldd, float fp8scale, LAS float* scr, int lane) {
#pragma unroll
    for (int i = 0; i < 8; ++i) { LAS float* p = scr + (8 * i + (lane >> 3)) * 33 + 4 * (lane & 7); p[0] = rg[i].x; p[1] = rg[i].y; p[2] = rg[i].z; p[3] = rg[i].w; }
    LDS_WAIT(); asm volatile("" ::: "memory");
    const int c = lane & 7;
#pragma unroll
    for (int j = 0; j < 4; ++j) { const int n = (lane >> 3) + 8 * j; const LAS float* sp = scr + (8 * c) * 33 + n;
        if (fp8scale != 0.f) {
            u32x2 o; o.x = pk4_fp8(sp[0 * 33] * fp8scale, sp[1 * 33] * fp8scale, sp[2 * 33] * fp8scale, sp[3 * 33] * fp8scale); o.y = pk4_fp8(sp[4 * 33] * fp8scale, sp[5 * 33] * fp8scale, sp[6 * 33] * fp8scale, sp[7 * 33] * fp8scale);
            *(u32x2*)((uchar*)dst + (size_t)n * ldd + 8 * c) = o;
        } else {
            u32x4 o; o.x = pk2(sp[0 * 33], sp[1 * 33]); o.y = pk2(sp[2 * 33], sp[3 * 33]); o.z = pk2(sp[4 * 33], sp[5 * 33]); o.w = pk2(sp[6 * 33], sp[7 * 33]);
            *(u32x4*)(dst + (size_t)n * ldd + 8 * c) = o; } }
    LDS_WAIT(); asm volatile("" ::: "memory");
}
__device__ __forceinline__ void transpose_batch(const float* src, size_t sstride, int nb, int K, int ldw, int ncols, bf16* dst, size_t dstride, int ldd, int dk0, int mode, LAS float* scr, int gw, int NGW, int lane, float fp8scale = 0.f) {
    const int kb_n = K / 64, nb_n = ncols / 32, per = kb_n * nb_n, total = nb * per;
    f32x4 nxt[8];
#pragma unroll
    for (int i = 0; i < 8; ++i) nxt[i] = (f32x4){0.f, 0.f, 0.f, 0.f};
#define TB_DECODE(it_) const int b = (it_) / per, r = (it_) % per, kb = r / nb_n, nbk = r % nb_n, n0 = nbk * 32, k0 = kb * 64
    if (gw < total) { TB_DECODE(gw); transpose_load(nxt, src + (size_t)b * sstride, ldw, k0, n0, lane); }
    for (int it = gw; it < total; it += NGW) {
        f32x4 cur[8];
#pragma unroll
        for (int i = 0; i < 8; ++i) cur[i] = nxt[i];
        if (it + NGW < total) { TB_DECODE(it + NGW); transpose_load(nxt, src + (size_t)b * sstride, ldw, k0, n0, lane); }
        TB_DECODE(it);
        int drow = n0;
        if (mode == 1) drow = (n0 < 2048) ? ((n0 >> 7) * 256 + (n0 & 127)) : ((((n0 - 2048) >> 7) * 256) + 128 + ((n0 - 2048) & 127));
        if (fp8scale != 0.f) transpose_finish(cur, (bf16*)((uchar*)dst + (size_t)b * dstride + (size_t)drow * ldd + dk0 + k0), ldd, fp8scale, scr, lane);
        else transpose_finish(cur, dst + (size_t)b * dstride + (size_t)drow * ldd + dk0 + k0, ldd, 0.f, scr, lane);
    }
#undef TB_DECODE
}
__device__ __forceinline__ void transpose_batch_r(const float* src, size_t sstride, int nb, int K, int ldw, int ncols, bf16* dst, size_t dstride, int ldd, int dk0, int mode, LAS float* scr, int gw, int NGW, int lane, int& rot) {
    const int total = nb * (K / 64) * (ncols / 32);
    transpose_batch(src, sstride, nb, K, ldw, ncols, dst, dstride, ldd, dk0, mode, scr, (gw + NGW - rot % NGW) % NGW, NGW, lane);
    rot += total;
}
__device__ __forceinline__ void sincos_acc(float angf, float& c, float& s) {
    const double a = (double)angf;
    const double q = __builtin_rint(a * 0.63661977236758134308);
    const double r = (a - q * 1.57079632679489655800) - q * 6.123233995736766036e-17;
    const double r2 = r * r;
    double sp = r * (1.0 + r2 * (-1.0 / 6 + r2 * (1.0 / 120 + r2 * (-1.0 / 5040 + r2 * (1.0 / 362880 + r2 * (-1.0 / 39916800 + r2 * (1.0 / 6227020800.0)))))));
    double cp = 1.0 + r2 * (-0.5 + r2 * (1.0 / 24 + r2 * (-1.0 / 720 + r2 * (1.0 / 40320 + r2 * (-1.0 / 3628800 + r2 * (1.0 / 479001600.0 + r2 * (-1.0 / 87178291200.0)))))));
    const int qi = ((int)q) & 3;
    double ss = (qi == 0) ? sp : (qi == 1) ? cp : (qi == 2) ? -sp : -cp;
    double cc = (qi == 0) ? cp : (qi == 1) ? -sp : (qi == 2) ? -cp : sp;
    c = (float)cc; s = (float)ss;
}

__device__ __forceinline__ void build_tables(const Args& args, int who) {
    unsigned char* ws = opaque_ptr(args.ws);
    GPhase* gph = (GPhase*)(ws + WS_GPH); GP* gpt = (GP*)(ws + WS_GPT);
    auto put = [&](int idx, const void* A, const void* B, void* C, const void* aux, int mt, int nt, int ustart, int ldc, int epi, float scale) {
        GP g; g.A = (const bf16*)A; g.B = (const bf16*)B; g.C = C; g.aux = aux; g.mt = mt; g.nt = nt; g.ustart = ustart; g.ldc = ldc; g.epi = epi; g.scale = scale; g.pad0 = 0; g.pad1 = 0; gpt[idx] = g; };
    auto phase = [&](int id, int first, int count, int K, int lda, int ldb, int total, int cntA, int szA, int szB) { GPhase p; p.first = first; p.count = count; p.K = K; p.lda = lda; p.ldb = ldb; p.total = total; p.cntA = cntA; p.szA = szA; p.szB = szB;
        p.pad0 = p.pad1 = p.pad2 = p.pad3 = p.pad4 = p.pad5 = p.pad6 = 0; gph[id] = p; };
    bf16* XB = (bf16*)(ws + WS_XB); float* X32 = (float*)(ws + WS_X32); float* Z32 = (float*)(ws + WS_Z32);
    if (who < 4) {
        const int L = who, j = L >> 1; int e = 256 * L;
        if ((L & 1) == 0) {
            phase(L * 9 + 0, e, 1, 2 * 1024, 2 * 1024, 2 * 1024, 192 * 18, 1, 192 * 18, 1);
            put(e, XB, ws + WS_W_EIN + (size_t)j * DIN * D * 2, ws + AR_PROJ, nullptr, 192, 18, 0, DIN, EPI_BF16, 0.f); e += 1;
            phase(L * 9 + 1, e, 0, 2 * 256, 2 * 256, 2 * 256, 0, 0, 1, 1);
            phase(L * 9 + 2, e, 1, 2 * 1024, 2 * 1024, 2 * 1024, 192 * 4, 1, 768, 1);
            put(e, ws + AR_OME, ws + WS_W_EOUT + (size_t)j * D * D * 2, Z32, RESID_BF16 ? (void*)XB : (void*)X32, 192, 4, 0, D, EPI_RESID, 0.f); e += 1;
        } else {
            phase(L * 9 + 0, e, 6, 2 * 1024, 2 * 1024, 2 * 1024, 3 * 192 * 4 + 3 * 192, 3, 768, 192);
            int us = 0;
            for (int p = 0; p < 3; ++p) { put(e + p, ws + AR_XM + (size_t)p * NTOK * D * 2, ws + WS_W_RKV + (size_t)(j * 3 + p) * D * D * 2, ws + (p == 2 ? AR_V : AR_RKV + (size_t)p * NTOK * D * 2), nullptr, 192, 4, us, D, EPI_BF16, 0.f); us += 768; }
            for (int p = 0; p < 3; ++p) { put(e + 3 + p, ws + AR_XM + (size_t)(3 + p) * NTOK * D * 2, ws + WS_W_L1 + (size_t)(j * 3 + p) * 256 * D * 2, ws + AR_H1 + (size_t)p * 256 * 2, nullptr, 192, 1, us, 768, EPI_BF16 | ((p == 0 ? 1 : p == 2 ? 2 : 0) << 8), 0.f); us += 192; }
            e += 6;
            phase(L * 9 + 1, e, 3, 2 * 256, 2 * 768, 2 * 256, 192 * 8 + 192 * 8 + 192 * 4, 2, 1536, 768);
            put(e + 0, ws + AR_H1 + 0, ws + WS_W_L2W + (size_t)j * 2048 * 256 * 2, ws + AR_LW, nullptr, 192, 8, 0, 2048, EPI_BF16, 0.f);
            put(e + 1, ws + AR_H1 + 256 * 2, ws + WS_W_L2A + (size_t)j * 2048 * 256 * 2, ws + AR_LA, nullptr, 192, 8, 192 * 8, 2048, EPI_BF16, 0.f);
            put(e + 2, ws + AR_H1 + 512 * 2, ws + WS_W_L2G + (size_t)j * 1024 * 256 * 2, ws + AR_GG, nullptr, 192, 4, 192 * 16, D, EPI_BF16, 0.f);
            e += 3;
            phase(L * 9 + 2, e, 1, 2 * 1024, 2 * 1024, 2 * 1024, 192 * 4, 1, 768, 1);
            put(e, ws + AR_OMO, ws + WS_W_OOUT + (size_t)j * D * D * 2, Z32, RESID_BF16 ? (void*)XB : (void*)X32, 192, 4, 0, D, EPI_RESID, 0.f); e += 1;
        }
        phase(L * 9 + 3, e, 80, 2 * 1024, 2 * 1024, 2 * 1024, 768, 16, 16, 8);
        { int us = 0; for (int s = 0; s < NSEQ; ++s) for (int h = 0; h < 4; ++h) { const int r0 = s < 4 ? s * 4096 : NP + (s - 4) * 2048, mt = (s < 4 ? 4096 : 2048) / 256;
            put(e, XB + (size_t)r0 * D, ws + WS_MQ + ((((size_t)L * 20 + s) * 4 + h) * 256 * 1024) * 2, ws + AR_P + ((size_t)r0 * D + h * 256) * 2, nullptr, mt, 1, us, D, EPI_SOFTMAX, 0.0625f); us += mt; ++e; } }
        phase(L * 9 + 4, e, 0, 2 * 256, 2 * 256, 2 * 256, 0, 0, 1, 1);
        phase(L * 9 + 5, e, 0, 2 * 256, 2 * 256, 2 * 256, 0, 0, 1, 1);
        phase(L * 9 + 6, e, 20, 2 * 1024, 2 * 1024, 2 * 1024, 768, 4, 64, 32);
        { int us = 0; for (int s = 0; s < NSEQ; ++s) { const int r0 = s < 4 ? s * 4096 : NP + (s - 4) * 2048, mt = (s < 4 ? 4096 : 2048) / 256;
            put(e, ws + AR_P + (size_t)r0 * D * 2, ws + WS_VW + (((size_t)L * 20 + s) * 1024 * 1024) * 2, (unsigned char*)Z32 + (size_t)r0 * D * (Z_BF16 ? 2 : 4), XB + (size_t)r0 * D, mt, 4, us, D, EPI_RESID, 0.f); us += mt * 4; ++e; } }
        phase(L * 9 + 7, e, 32, MOE_FP8 ? 1024 : 2048, MOE_FP8 ? 1024 : 2048, MOE_FP8 ? 1024 : 2048, 384 * 16, 16, 128, 256);
        { int us = 0; for (int g = 0; g < 2; ++g) for (int x = 0; x < 16; ++x) { const int sb = g ? NP * 2 + x * 4096 : x * 2048, mt = g ? 16 : 8;
            put(e, ws + AR_XE + (MOE_GATHER_FUSED ? 0 : (size_t)sb * D * (MOE_FP8 ? 1 : 2)), ws + WS_W_MIN + ((size_t)(L * 16 + x) * 4096 * D) * (MOE_FP8 ? 1 : 2), ws + AR_HACT + (size_t)sb * 2048 * (MOE_FP8 ? 1 : 2), MOE_GATHER_FUSED ? (const void*)(ws + WS_IDX + (size_t)sb * 4) : nullptr, mt, 16, us, 2048, EPI_SWIGLU, 0.f); us += mt * 16; ++e; } }
        phase(L * 9 + 8, e, 32, MOE_FP8 ? 2048 : 4096, MOE_FP8 ? 2048 : 4096, MOE_FP8 ? 2048 : 4096, 384 * 4, 16, 32, 64);
        { int us = 0; for (int g = 0; g < 2; ++g) for (int x = 0; x < 16; ++x) { const int sb = g ? NP * 2 + x * 4096 : x * 2048, mt = g ? 16 : 8;
            put(e, ws + AR_HACT + (size_t)sb * 2048 * (MOE_FP8 ? 1 : 2), ws + WS_W_MOUT + ((size_t)(L * 16 + x) * D * 2048) * (MOE_FP8 ? 1 : 2), ws + AR_YE + (size_t)sb * D * 2, ws + WS_GATE + (size_t)sb * 4, mt, 4, us, D, EPI_ROWSCALE, 0.f); us += mt * 4; ++e; } }
    } else {
        int e = 1024; int us = 0;
        for (int L = 0; L < 4; ++L) { put(e, ws + WS_MEMB, ws + WS_W_CKV + (size_t)L * 2048 * D * 2, ws + WS_KMEM + (size_t)L * 5120 * D * 2, nullptr, 20, 4, us, D, EPI_BF16, 0.f); us += 80; ++e; }
        for (int L = 0; L < 4; ++L) { put(e, ws + WS_MEMB, ws + WS_W_CKV + ((size_t)L * 2048 + 1024) * D * 2, ws + WS_VMEM + (size_t)L * 5120 * D * 2, nullptr, 20, 4, us, D, EPI_BF16, 0.f); us += 80; ++e; }
        phase(GPH_PRO, 1024, 8, 2 * 1024, 2 * 1024, 2 * 1024, us, 8, 80, 1);
        const int e2 = e; us = 0;
        for (int L = 0; L < 4; ++L) for (int s = 0; s < NSEQ; ++s) for (int h = 0; h < 4; ++h) {
            put(e, ws + WS_KMEM + (((size_t)L * 5120 + s * 256) * D + h * 256) * 2, ws + WS_WQN + ((size_t)L * D * D + h * 256) * 2, ws + WS_MQ + ((((size_t)L * 20 + s) * 4 + h) * 256 * 1024) * 2, nullptr, 1, 4, us, D, EPI_BF16, 0.f); us += 4; ++e; }
        for (int L = 0; L < 4; ++L) for (int s = 0; s < NSEQ; ++s) for (int h = 0; h < 4; ++h) {
            put(e, ws + WS_W_CO + ((size_t)L * D * D + h * 256) * 2, ws + WS_VMEM + (((size_t)L * 5120 + s * 256) * D + h * 256) * 2, ws + WS_VW + ((((size_t)L * 20 + s) * 1024) * 1024 + h * 256) * 2, nullptr, 4, 1, us, D, EPI_BF16, 0.f); us += 4; ++e; }
        phase(GPH_PRO2, e2, 640, 2 * 256, 2 * 1024, 2 * 1024, us, 640, 4, 1);
    }
}

__device__ __forceinline__ void moe_weights(const Args& args, int L, LAS float* scr, int gw, int NGW, int lane) {
    unsigned char* ws = opaque_ptr(args.ws);
    constexpr size_t ESZ = MOE_FP8 ? 1 : 2;
    transpose_batch(args.in[I_MWIN] + (size_t)L * 16 * D * 4096, (size_t)D * 4096, 16, D, 4096, 4096, (bf16*)(ws + WS_W_MIN + (size_t)L * 16 * 4096 * D * ESZ), (size_t)4096 * D, D, 0, 1, scr, gw, NGW, lane, MOE_FP8 ? 32.f : 0.f);
    transpose_batch(args.in[I_MWOUT] + (size_t)L * 16 * 2048 * D, (size_t)2048 * D, 16, 2048, D, D, (bf16*)(ws + WS_W_MOUT + (size_t)L * 16 * D * 2048 * ESZ), (size_t)D * 2048, 2048, 0, 0, scr, gw, NGW, lane, MOE_FP8 ? 128.f : 0.f);
}
__device__ __forceinline__ void prologue(const Args& args, LAS uchar* lds, int gw, int NGW, int wave, int lane) {
    unsigned char* ws = opaque_ptr(args.ws);
    LAS float* scr = (LAS float*)(lds + wave * 16384);
    if (opaque_bx() == 0 && lane == 0 && wave < 5) build_tables(args, wave);
    int rot = 0;
    transpose_batch_r(args.in[I_EWIN], (size_t)D * DIN, 2, D, DIN, DIN, (bf16*)(ws + WS_W_EIN), (size_t)DIN * D, D, 0, 0, scr, gw, NGW, lane, rot);
    transpose_batch_r(args.in[I_EWOUT], (size_t)D * D, 2, D, D, D, (bf16*)(ws + WS_W_EOUT), (size_t)D * D, D, 0, 0, scr, gw, NGW, lane, rot);
    transpose_batch_r(args.in[I_ORKV], (size_t)D * D, 6, D, D, D, (bf16*)(ws + WS_W_RKV), (size_t)D * D, D, 0, 0, scr, gw, NGW, lane, rot);
    for (int j = 0; j < 2; ++j) {
        bf16* l1 = (bf16*)(ws + WS_W_L1) + (size_t)j * 3 * 256 * D;
        transpose_batch_r(args.in[I_OW1] + (size_t)j * 2 * D * 64, (size_t)D * 64, 2, D, 64, 64, l1, (size_t)64 * D, D, 0, 0, scr, gw, NGW, lane, rot);
        transpose_batch_r(args.in[I_OA1] + (size_t)j * 2 * D * 64, (size_t)D * 64, 2, D, 64, 64, l1 + (size_t)256 * D, (size_t)64 * D, D, 0, 0, scr, gw, NGW, lane, rot);
        transpose_batch_r(args.in[I_OG1] + (size_t)j * D * 128, 0, 1, D, 128, 128, l1 + (size_t)512 * D, 0, D, 0, 0, scr, gw, NGW, lane, rot);
        for (int dir = 0; dir < 2; ++dir) {
            transpose_batch_r(args.in[I_OW2] + ((size_t)j * 2 + dir) * 64 * D, 0, 1, 64, D, D, (bf16*)(ws + WS_W_L2W) + ((size_t)j * 2048 + dir * 1024) * 256, 0, 256, dir * 64, 0, scr, gw, NGW, lane, rot);
            transpose_batch_r(args.in[I_OA2] + ((size_t)j * 2 + dir) * 64 * D, 0, 1, 64, D, D, (bf16*)(ws + WS_W_L2A) + ((size_t)j * 2048 + dir * 1024) * 256, 0, 256, dir * 64, 0, scr, gw, NGW, lane, rot);
        }
        transpose_batch_r(args.in[I_OG2] + (size_t)j * 128 * D, 0, 1, 128, D, D, (bf16*)(ws + WS_W_L2G) + (size_t)j * 1024 * 256, 0, 256, 0, 0, scr, gw, NGW, lane, rot);
    }
    transpose_batch_r(args.in[I_OWOUT], (size_t)D * D, 2, D, D, D, (bf16*)(ws + WS_W_OOUT), (size_t)D * D, D, 0, 0, scr, gw, NGW, lane, rot);
    { const float* wq = args.in[I_CWQ]; bf16* wqn = (bf16*)(ws + WS_WQN);
      for (int r = gw; r < 4 * D; r += NGW) { const f32x4* p = (const f32x4*)(wq + (size_t)r * D + 16 * lane); const f32x4 a = p[0], b = p[1], c = p[2], d = p[3];
          u32x4 o0, o1; o0.x = pk2(a.x, a.y); o0.y = pk2(a.z, a.w); o0.z = pk2(b.x, b.y); o0.w = pk2(b.z, b.w); o1.x = pk2(c.x, c.y); o1.y = pk2(c.z, c.w); o1.z = pk2(d.x, d.y); o1.w = pk2(d.z, d.w);
          u32x4* q = (u32x4*)(wqn + (size_t)r * D + 16 * lane); q[0] = o0; q[1] = o1; } }
    transpose_batch_r(args.in[I_CWKV], (size_t)D * 2048, 4, D, 2048, 2048, (bf16*)(ws + WS_W_CKV), (size_t)2048 * D, D, 0, 0, scr, gw, NGW, lane, rot);
    transpose_batch_r(args.in[I_CWO], (size_t)D * D, 4, D, D, D, (bf16*)(ws + WS_W_CO), (size_t)D * D, D, 0, 0, scr, gw, NGW, lane, rot);
    {
        const int gt = gw * 64 + lane, NT = NGW * 64; const u32x4 z = (u32x4){0u, 0u, 0u, 0u};
        for (int i = gt; i < 6 * 128 * 128; i += NT) { const int blk = i / (128 * 128), r = i % (128 * 128); *(u32x4*)((bf16*)(ws + WS_W_L1) + ((size_t)blk * 256 + 128 + r / 128) * D + (r % 128) * 8) = z; }
        for (int i = gt; i < 2 * 2 * 2048 * 32; i += NT) { const int t = i / (2 * 2048 * 32), r = i % (2 * 2048 * 32), n = (r / 32) % 2048, k8 = r % 32, lo = (n >= 1024) ? 8 : 0;
            if (k8 < lo || k8 >= lo + 8) *(u32x4*)((bf16*)(ws + (t ? WS_W_L2A : WS_W_L2W)) + (size_t)(r / 32) * 256 + k8 * 8) = z; }
        for (int i = gt; i < 2 * 1024 * 16; i += NT) { *(u32x4*)((bf16*)(ws + WS_W_L2G) + (size_t)(i / 16) * 256 + 128 + (i % 16) * 8) = z; }
        float2* rot = (float2*)(ws + WS_ROT);
        for (int i = gt; i < 4096 * 64; i += NT) { const int t = i >> 6, k = i & 63; const float xf = (float)k / 63.0f; const float th = (float)(1.0 / exp((double)xf * 9.210340371976184)); const float ang = (float)t * th;
            float c, s; sincos_acc(ang, c, s); rot[i] = make_float2(c, s); }
    }
    {
        float* X32 = (float*)(ws + WS_X32); bf16* XB = (bf16*)(ws + WS_XB); bf16* MB = (bf16*)(ws + WS_MEMB);
        for (int r = gw; r < NTOK; r += NGW) { const float* src = r < NP ? args.in[I_XP] + (size_t)r * D : args.in[I_XS] + (size_t)(r - NP) * D;
#pragma unroll
            for (int jj = 0; jj < 4; ++jj) { const f32x4 v = *((const f32x4*)src + lane + 64 * jj); if (!RESID_BF16) *((f32x4*)(X32 + (size_t)r * D) + lane + 64 * jj) = v;
                u32x2 o; o.x = pk2(v.x, v.y); o.y = pk2(v.z, v.w); *((u32x2*)(XB + (size_t)r * D) + lane + 64 * jj) = o; } }
        for (int r = gw; r < 5120; r += NGW) { const float* src = r < 1024 ? args.in[I_MP] + (size_t)r * D : args.in[I_MS] + (size_t)(r - 1024) * D;
#pragma unroll
            for (int jj = 0; jj < 4; ++jj) { const f32x4 v = *((const f32x4*)src + lane + 64 * jj); u32x2 o; o.x = pk2(v.x, v.y); o.y = pk2(v.z, v.w); *((u32x2*)(MB + (size_t)r * D) + lane + 64 * jj) = o; } }
    }
}

#define LN_COL(jj) ((((jj) >> 1) * 512) + lane * 8 + (((jj) & 1) * 4))
#define LN_UNPK(dst, q_, hh) do { dst[2 * (hh)] = (f32x4){bflo((q_).x), bfhi((q_).x), bflo((q_).y), bfhi((q_).y)}; dst[2 * (hh) + 1] = (f32x4){bflo((q_).z), bfhi((q_).z), bflo((q_).w), bfhi((q_).w)}; } while (0)
#define LN_ACC(dst, q_, hh) do { dst[2 * (hh)].x += bflo((q_).x); dst[2 * (hh)].y += bfhi((q_).x); dst[2 * (hh)].z += bflo((q_).y); dst[2 * (hh)].w += bfhi((q_).y); dst[2 * (hh) + 1].x += bflo((q_).z); dst[2 * (hh) + 1].y += bfhi((q_).z); dst[2 * (hh) + 1].z += bflo((q_).w); dst[2 * (hh) + 1].w += bfhi((q_).w); } while (0)
__device__ __forceinline__ void ln_phase(const Args& args, LAS uchar* lds, int layer, int which, int mode, bool final_out, int gw, int NGW, int wave, int lane) {
    const int wave_sgpr_ = wave;
    unsigned char* ws = opaque_ptr(args.ws);
    float* X32 = (float*)(ws + WS_X32); const float* Z32 = (const float*)(ws + WS_Z32); bf16* XB = (bf16*)(ws + WS_XB);
    const float* lw = args.in[I_LNW] + (size_t)(layer * 3 + which) * D; const float* lb = args.in[I_LNB] + (size_t)(layer * 3 + which) * D;
    LAS float* wrT = (LAS float*)lds;
    if (mode == 1) {
        const float* wr = args.in[I_MR] + (size_t)layer * D * 16;
        for (int i = opaque_tid(); i < D * 16; i += 512) { const int col = i >> 4, jj = ((col >> 9) << 1) + ((col >> 2) & 1), ln_ = (col & 511) >> 3;
            wrT[(i & 15) * 1024 + (jj * 64 + ln_) * 4 + (col & 3)] = wr[i]; }
        __syncthreads();
    }
    f32x4 gw4[4], gb4[4];
#pragma unroll
    for (int j = 0; j < 4; ++j) { gw4[j] = *(const f32x4*)(lw + LN_COL(j)); gb4[j] = *(const f32x4*)(lb + LN_COL(j)); }
    f32x4 nx[4]; int ninv = -1;
#define LN_LOADROW(r_) do { if (mode == 2 && RESID_BF16) { _Pragma("unroll") for (int hh = 0; hh < 2; ++hh) { const u32x4 w_ = *(const u32x4*)(XB + (size_t)(r_) * D + hh * 512 + lane * 8); LN_UNPK(nx, w_, hh); } } \
        else if (Z_BF16 && mode != 2) { _Pragma("unroll") for (int hh = 0; hh < 2; ++hh) { const u32x4 w_ = *(const u32x4*)((const bf16*)Z32 + (size_t)(r_) * D + hh * 512 + lane * 8); LN_UNPK(nx, w_, hh); } } \
        else { const float* src_ = (mode == 2 ? (const float*)X32 : Z32) + (size_t)(r_) * D; _Pragma("unroll") for (int j = 0; j < 4; ++j) nx[j] = *(const f32x4*)(src_ + LN_COL(j)); } \
        if (mode == 2) ninv = ((const int*)(ws + WS_INV))[(size_t)(r_) * 16 + (lane & 15)]; } while (0)
    static_assert(RESID_BF16 == 1, "mode 2 below reads the residual row from XB");
    u32x4 pre[4][2]; unsigned prest = 0u;
#define YE_PREF(rr_, inv_) do { unsigned long long m_ = __builtin_amdgcn_ballot_w64(lane < 16 && (inv_) >= 0); const int g_ = (rr_) >= NP; \
        _Pragma("unroll") for (int p = 0; p < 4; ++p) { \
            if (m_ != 0ull) { const int e_ = __builtin_ctzll(m_); m_ &= m_ - 1ull; const int sl_ = __builtin_amdgcn_readlane((inv_), e_); \
                const bf16* ye_ = (const bf16*)(ws + AR_YE) + (size_t)((g_ ? NP * 2 + e_ * 4096 : e_ * 2048) + sl_) * D; \
                _Pragma("unroll") for (int hh = 0; hh < 2; ++hh) pre[p][hh] = *(const u32x4*)(ye_ + hh * 512 + lane * 8); } \
            else { _Pragma("unroll") for (int hh = 0; hh < 2; ++hh) pre[p][hh] = (u32x4){0u, 0u, 0u, 0u}; } } \
        prest = (unsigned)m_; } while (0)
    int inv1 = -1;
    if (gw < NTOK) { LN_LOADROW(gw);
        if (mode == 2) { if (gw + NGW < NTOK) inv1 = ((const int*)(ws + WS_INV))[(size_t)(gw + NGW) * 16 + (lane & 15)]; YE_PREF(gw, ninv); } }
    for (int r = gw; r < NTOK; r += NGW) {
        f32x4 v[4];
#pragma unroll
        for (int j = 0; j < 4; ++j) v[j] = nx[j];
        if (mode == 2) {
            const int myinv = ninv; const unsigned myrest = prest;
            u32x4 cur[4][2];
#pragma unroll
            for (int p = 0; p < 4; ++p)
#pragma unroll
                for (int hh = 0; hh < 2; ++hh) cur[p][hh] = pre[p][hh];
            if (r + NGW < NTOK) {
#pragma unroll
                for (int hh = 0; hh < 2; ++hh) { const u32x4 w_ = *(const u32x4*)(XB + (size_t)(r + NGW) * D + hh * 512 + lane * 8); LN_UNPK(nx, w_, hh); }
                ninv = inv1; YE_PREF(r + NGW, ninv);
                if (r + 2 * NGW < NTOK) inv1 = ((const int*)(ws + WS_INV))[(size_t)(r + 2 * NGW) * 16 + (lane & 15)];
            }
#pragma unroll
            for (int j = 0; j < 4; ++j) v[j] = v[j] * DN_ALPHA;
#pragma unroll
            for (int p = 0; p < 4; ++p)
#pragma unroll
                for (int hh = 0; hh < 2; ++hh) { const u32x4 w = cur[p][hh]; LN_ACC(v, w, hh); }
            const int g = r >= NP;
            for (unsigned mr = myrest; mr != 0u; mr &= mr - 1u) {
                const int e = __builtin_ctz(mr); const int sl = __builtin_amdgcn_readlane(myinv, e);
                const bf16* ye = (const bf16*)(ws + AR_YE) + (size_t)((g ? NP * 2 + e * 4096 : e * 2048) + sl) * D;
#pragma unroll
                for (int hh = 0; hh < 2; ++hh) { const u32x4 w = *(const u32x4*)(ye + hh * 512 + lane * 8); LN_ACC(v, w, hh); }
            }
        } else {
            if (r + NGW < NTOK) LN_LOADROW(r + NGW);
        }
        float s = 0.f;
#pragma unroll
        for (int j = 0; j < 4; ++j) s += (v[j].x + v[j].y) + (v[j].z + v[j].w);
        const float mean = wave_sum(s) * (1.f / D); float s2 = 0.f;
#pragma unroll
        for (int j = 0; j < 4; ++j) { v[j] = v[j] - mean; s2 += (v[j].x * v[j].x + v[j].y * v[j].y) + (v[j].z * v[j].z + v[j].w * v[j].w); }
        const float rstd = 1.f / sqrtf(wave_sum(s2) * (1.f / D) + LN_EPS);
#pragma unroll
        for (int j = 0; j < 4; ++j) v[j] = v[j] * rstd * gw4[j] + gb4[j];
        if (final_out) {
#pragma unroll
            for (int j = 0; j < 4; ++j) *(f32x4*)(args.out + (size_t)r * D + LN_COL(j)) = v[j];
        } else {
#pragma unroll
            for (int hh = 0; hh < 2; ++hh) { if (!RESID_BF16) { *(f32x4*)(X32 + (size_t)r * D + LN_COL(2 * hh)) = v[2 * hh]; *(f32x4*)(X32 + (size_t)r * D + LN_COL(2 * hh + 1)) = v[2 * hh + 1]; }
                u32x4 o; o.x = pk2(v[2 * hh].x, v[2 * hh].y); o.y = pk2(v[2 * hh].z, v[2 * hh].w); o.z = pk2(v[2 * hh + 1].x, v[2 * hh + 1].y); o.w = pk2(v[2 * hh + 1].z, v[2 * hh + 1].w);
                *(u32x4*)(XB + (size_t)r * D + hh * 512 + lane * 8) = o;
                if (MOE_GATHER_FUSED && mode == 1) { u32x2 q; q.x = pk4_fp8(v[2 * hh].x, v[2 * hh].y, v[2 * hh].z, v[2 * hh].w); q.y = pk4_fp8(v[2 * hh + 1].x, v[2 * hh + 1].y, v[2 * hh + 1].z, v[2 * hh + 1].w);
                    *(u32x2*)(ws + AR_XE + (size_t)r * D + hh * 512 + lane * 8) = q; } }
        }
        if (mode == 1) {
            asm volatile("" ::: "memory");
            float pa[16];
#pragma unroll
            for (int e = 0; e < 16; ++e) { float a = 0.f;
#pragma unroll
                for (int j = 0; j < 4; ++j) { const f32x4 w = *((const LAS f32x4*)(wrT + e * 1024) + lane + 64 * j); a += (v[j].x * w.x + v[j].y * w.y) + (v[j].z * w.z + v[j].w * w.w); }
                pa[e] = a; }
            const bool b5 = (lane & 32) != 0, b4 = (lane & 16) != 0, b3 = (lane & 8) != 0, b2 = (lane & 4) != 0;
            float p8[8], p4[4], p2[2];
#pragma unroll
            for (int k = 0; k < 8; ++k) p8[k] = (b5 ? pa[8 + k] : pa[k]) + shx(b5 ? pa[k] : pa[8 + k], 32, lane);
#pragma unroll
            for (int k = 0; k < 4; ++k) p4[k] = (b4 ? p8[4 + k] : p8[k]) + shx(b4 ? p8[k] : p8[4 + k], 16, lane);
#pragma unroll
            for (int k = 0; k < 2; ++k) p2[k] = (b3 ? p4[2 + k] : p4[k]) + shx(b3 ? p4[k] : p4[2 + k], 8, lane);
            float lgv = (b2 ? p2[1] : p2[0]) + shx(b2 ? p2[0] : p2[1], 4, lane);
            lgv += shx(lgv, 2, lane); lgv += shx(lgv, 1, lane);
            float mx = lgv; mx = fmaxf(mx, shx(mx, 4, lane)); mx = fmaxf(mx, shx(mx, 8, lane)); mx = fmaxf(mx, shx(mx, 16, lane)); mx = fmaxf(mx, shx(mx, 32, lane));
            const float ex = exp_(lgv - mx);
            float tot = ex; tot += shx(tot, 4, lane); tot += shx(tot, 8, lane); tot += shx(tot, 16, lane); tot += shx(tot, 32, lane);
            if ((lane & 3) == 0) ((float*)(ws + WS_AFF))[(size_t)(lane >> 2) * NTOK + r] = ex * (1.f / tot);
        }
    }
}

struct CV { float q, k, lf; };
__device__ __forceinline__ CV chanvals(int type, const bf16* prow, int h, int k, int dir, float lbv, float lg, const float2* rot) {
    CV o;
    if (type == 0) {
        const float aq = bf2f(prow[h * 128 + k]); o.q = siluf_(aq);
        const float z = bf2f(prow[1024 + dir * 512 + h * 128 + k]);
        const float f = lbv + (1.f - lbv) * sigmoidf_(z);
        o.k = 1.f - f; o.lf = log_(f);
    } else {
        const int c0 = h * 128 + k, c1 = h * 128 + (k ^ 1);
        const float2 cs = rot[k >> 1];
        const float xq = bf2f(prow[2560 + c0]), xq2 = bf2f(prow[2560 + c1]), xk = bf2f(prow[3072 + c0]), xk2 = bf2f(prow[3072 + c1]);
        if (k & 1) { o.q = xq * cs.x + xq2 * cs.y; o.k = xk * cs.x + xk2 * cs.y; } else { o.q = xq * cs.x - xq2 * cs.y; o.k = xk * cs.x - xk2 * cs.y; }
        o.k *= 0.08838834764831845f; o.lf = lg;
    }
    return o;
}
__device__ __forceinline__ void even_setup(const Args& args, int j, int type, int h, int k, int dir, float& lbv, float& lg) {
    lbv = 0.f; lg = 0.f;
    if (type == 0) { if (j == 1) { const float* l = args.in[I_ELB] + (size_t)dir * 2 * 512; lbv = sigmoidf_(l[512 + h * 128 + k] - l[h * 128 + k]); } }
    else lg = logf(1.f - exp2f(-5.f - (float)h));
}
__device__ __forceinline__ bf16x8 load_vfrag(const bf16* base, int ld) {
    bf16x8 r;
#pragma unroll
    for (int e = 0; e < 8; ++e) r[e] = (short)base[(size_t)e * ld];
    return r;
}
__device__ __forceinline__ void even_stage_load(u32x4 (&rg)[4][2], const bf16* PROJ, int type, int h, int row0, int tid) {
#pragma unroll
    for (int i = 0; i < 4; ++i) {
        if (i == 2 && type != 0) continue;
        const int col0 = (i == 3 ? (type == 0 ? 512 : 3584) : type == 0 ? (i == 0 ? 0 : i == 1 ? 1024 : 1536) : (i == 0 ? 2560 : 3072)) + h * 128;
#pragma unroll
        for (int c2 = 0; c2 < 2; ++c2) { const int c = tid + 512 * c2, row = c >> 4, c16 = c & 15; rg[i][c2] = *(const u32x4*)(PROJ + (size_t)(row0 + row) * DIN + col0 + c16 * 8); }
    }
}
__device__ __forceinline__ void even_stage_commit(const u32x4 (&rg)[4][2], LAS uchar* raw, LAS uchar* vtile, int type, int tid) {
#pragma unroll
    for (int i = 0; i < 4; ++i) {
        if (i == 2 && type != 0) continue;
#pragma unroll
        for (int c2 = 0; c2 < 2; ++c2) { const int c = tid + 512 * c2, row = c >> 4, c16 = c & 15; *(LAS u32x4*)((i == 3 ? vtile : raw + i * 17408) + row * 272 + c16 * 16) = rg[i][c2]; }
    }
}
__device__ __forceinline__ bf16x8 lds_vfrag(const LAS uchar* vtile, int tok0, int ch) {
    bf16x8 r;
#pragma unroll
    for (int e = 0; e < 8; ++e) r[e] = (short)*(const LAS bf16*)(vtile + (tok0 + e) * 272 + ch * 2);
    return r;
}
__device__ __forceinline__ void even_elem(const Args& args, int j, int type, int h, int row0, int pos0, const bf16* PROJ, const float2* ROT, LAS uchar* raw, LAS float* HS, int tid,
                                          float (&qv)[32], float (&kv)[32], float (&lf)[32], float& start, float& ref, float& total) {
    const int k = tid & 127, dir = (tid >> 7) & 1, half = tid >> 8;
    float lbv, lg; even_setup(args, j, type, h, k, dir, lbv, lg);
    __syncthreads();
    float sum = 0.f;
    if (type == 0) {
        const LAS bf16* R0 = (const LAS bf16*)raw; const LAS bf16* RZ = (const LAS bf16*)(raw + (1 + dir) * 17408);
#pragma unroll
        for (int i = 0; i < 32; ++i) { const int t = 32 * half + i;
            const float aq = bf2f(R0[t * 136 + k]), z = bf2f(RZ[t * 136 + k]);
            const float f = lbv + (1.f - lbv) * sigmoidf_(z);
            qv[i] = siluf_(aq); kv[i] = 1.f - f; lf[i] = log_(f); sum += lf[i]; }
    } else {
        const LAS bf16* R0 = (const LAS bf16*)raw; const LAS bf16* R1 = (const LAS bf16*)(raw + 17408);
        const float2 dcs = ROT[64 + (k >> 1)];
        float2 cs = ROT[(size_t)(pos0 + 32 * half) * 64 + (k >> 1)]; const float2 cs16 = ROT[(size_t)(pos0 + 32 * half + 16) * 64 + (k >> 1)];
#pragma unroll
        for (int i = 0; i < 32; ++i) { const int t = 32 * half + i;
            if (i == 16) cs = cs16; else if (i > 0) { const float c_ = cs.x * dcs.x - cs.y * dcs.y, s_ = cs.y * dcs.x + cs.x * dcs.y; cs.x = c_; cs.y = s_; }
            const float xq = bf2f(R0[t * 136 + k]), xq2 = bf2f(R0[t * 136 + (k ^ 1)]), xk = bf2f(R1[t * 136 + k]), xk2 = bf2f(R1[t * 136 + (k ^ 1)]);
            float q_, k_;
            if (k & 1) { q_ = xq * cs.x + xq2 * cs.y; k_ = xk * cs.x + xk2 * cs.y; } else { q_ = xq * cs.x - xq2 * cs.y; k_ = xk * cs.x - xk2 * cs.y; }
            qv[i] = q_; kv[i] = k_ * 0.08838834764831845f; lf[i] = lg; sum += lg; }
    }
    HS[(dir * 2 + half) * 128 + k] = sum;
    __syncthreads();
    const float other = HS[(dir * 2 + (half ^ 1)) * 128 + k];
    const bool first = dir ? (half == 1) : (half == 0);
    start = first ? 0.f : other; ref = first ? sum : other; total = sum + other;
}
__device__ __forceinline__ void even_elem_c(const Args& args, int j, int type, int h, int row0, int pos0, const bf16* PROJ, const float2* ROT, LAS uchar* raw, LAS float* HS, int tid,
                                            LAS bf16* qx, LAS bf16* kx, float (&lf)[32], float& start, float& ref, float& total) {
    const int k = tid & 127, dir = (tid >> 7) & 1, half = tid >> 8;
    float lbv, lg; even_setup(args, j, type, h, k, dir, lbv, lg);
    __syncthreads();
    float sum = 0.f;
    if (type == 0) {
        const LAS bf16* R0 = (const LAS bf16*)raw + (32 * half) * 136 + k; const LAS bf16* RZ = (const LAS bf16*)(raw + (1 + dir) * 17408) + (32 * half) * 136 + k;
#pragma unroll
        for (int i = 0; i < 32; ++i) {
            const float aq = bf2f(R0[i * 136]), z = bf2f(RZ[i * 136]);
            const float f = lbv + (1.f - lbv) * sigmoidf_(z);
            qx[i * 136] = f2bf_hw(siluf_(aq)); kx[i * 136] = f2bf_hw(1.f - f); lf[i] = log_(f); sum += lf[i]; }
    } else {
        const LAS bf16* R0 = (const LAS bf16*)raw + (32 * half) * 136; const LAS bf16* R1 = (const LAS bf16*)(raw + 17408) + (32 * half) * 136;
        const float2* rot = ROT + (size_t)(pos0 + 32 * half) * 64 + (k >> 1);
        const float2 dcs = ROT[64 + (k >> 1)]; float2 cs = rot[0]; const float2 cs16 = rot[16 * 64];
#pragma unroll
        for (int i = 0; i < 32; ++i) {
            if (i == 16) cs = cs16; else if (i > 0) { const float c_ = cs.x * dcs.x - cs.y * dcs.y, s_ = cs.y * dcs.x + cs.x * dcs.y; cs.x = c_; cs.y = s_; }
            const float xq = bf2f(R0[i * 136 + k]), xq2 = bf2f(R0[i * 136 + (k ^ 1)]), xk = bf2f(R1[i * 136 + k]), xk2 = bf2f(R1[i * 136 + (k ^ 1)]);
            float q_, k_;
            if (k & 1) { q_ = xq * cs.x + xq2 * cs.y; k_ = xk * cs.x + xk2 * cs.y; } else { q_ = xq * cs.x - xq2 * cs.y; k_ = xk * cs.x - xk2 * cs.y; }
            qx[i * 136] = f2bf_hw(q_); kx[i * 136] = f2bf_hw(k_ * 0.08838834764831845f); lf[i] = lg; sum += lg; }
    }
    HS[(dir * 2 + half) * 128 + k] = sum;
    __syncthreads();
    const float other = HS[(dir * 2 + (half ^ 1)) * 128 + k];
    const bool first = dir ? (half == 1) : (half == 0);
    start = first ? 0.f : other; ref = first ? sum : other; total = sum + other;
}
__device__ __forceinline__ void even_cumul(int dir, float start, float (&lf)[32]) {
    float run = start;
    if (dir == 0) {
#pragma unroll
        for (int i = 0; i < 32; ++i) { run += lf[i]; lf[i] = run; }
    } else {
#pragma unroll
        for (int i = 31; i >= 0; --i) { run += lf[i]; lf[i] = run; }
    }
}
__device__ __forceinline__ void even_phase_a(const Args& args, LAS uchar* lds, int j, int G, int wave_sgpr_) {
    unsigned char* ws = opaque_ptr(args.ws);
    const bf16* PROJ = (const bf16*)(ws + AR_PROJ); bf16* ST = (bf16*)(ws + AR_ST); float* DEC = (float*)(ws + AR_DEC); const float2* ROT = (const float2*)(ws + WS_ROT);
    const int tid = opaque_tid(), wave = uni(tid >> 6), lane = tid & 63, fr = lane & 15, fq = lane >> 4;
    LAS bf16* KT = (LAS bf16*)lds;
    LAS uchar* RAW = lds + 36864;
    LAS float* HS = (LAS float*)(lds + 36864 + 3 * 17408);
    LAS uchar* VTL = lds + 36864 + 3 * 17408 + 2048;
    u32x4 rg[4][2];
#pragma unroll
    for (int i = 0; i < 4; ++i) { rg[i][0] = (u32x4){0u, 0u, 0u, 0u}; rg[i][1] = rg[i][0]; }
    { const int u = opaque_bx(); if (u < 2 * NCHUNK * 4) even_stage_load(rg, PROJ, u / (NCHUNK * 4), u & 3, ((u % (NCHUNK * 4)) >> 2) * 64, tid); }
    for (int u = opaque_bx(); u < 2 * NCHUNK * 4; u += G) {
        const int type = u / (NCHUNK * 4), rem = u % (NCHUNK * 4), cg = rem >> 2, h = rem & 3, row0 = cg * 64, pos0 = row_pos(row0);
        __syncthreads();
        even_stage_commit(rg, RAW, VTL, type, tid);
        { const int un = u + G; if (un < 2 * NCHUNK * 4) even_stage_load(rg, PROJ, un / (NCHUNK * 4), un & 3, ((un % (NCHUNK * 4)) >> 2) * 64, tid); }
        {
            float qv[32], kv[32], lf[32], start, ref, total;
            even_elem(args, j, type, h, row0, pos0, PROJ, ROT, RAW, HS, tid, qv, kv, lf, start, ref, total);
            const int k = tid & 127, dir = (tid >> 7) & 1, half = tid >> 8;
            if (half == 0) DEC[((size_t)((type * 2 + dir) * NCHUNK + cg) * 4 + h) * 128 + k] = exp_(total);
            even_cumul(uni(dir), start, lf);
            float val[32];
#pragma unroll
            for (int i = 0; i < 32; ++i) val[i] = kv[i] * exp_(total - lf[i]);
            LAS bf16* kt = KT + ((size_t)dir * 128 + k) * 72 + 32 * half;
#pragma unroll
            for (int g8 = 0; g8 < 4; ++g8) { u32x4 o; o.x = pk2(val[8 * g8 + 0], val[8 * g8 + 1]); o.y = pk2(val[8 * g8 + 2], val[8 * g8 + 3]); o.z = pk2(val[8 * g8 + 4], val[8 * g8 + 5]); o.w = pk2(val[8 * g8 + 6], val[8 * g8 + 7]);
                *(LAS u32x4*)(kt + 8 * g8) = o; }
        }
        __syncthreads();
        bf16x8 vf[2];
#pragma unroll
        for (int ks = 0; ks < 2; ++ks) vf[ks] = lds_vfrag(VTL, 32 * ks + 8 * fq, 16 * wave + fr);
#pragma unroll
        for (int dir = 0; dir < 2; ++dir) {
            bf16* st = ST + ((size_t)((type * 2 + dir) * NCHUNK + cg) * 4 + h) * 16384 + (size_t)(16 * wave + fr) * 128;
#pragma unroll
            for (int nb = 0; nb < 8; ++nb) {
                f32x4 acc = (f32x4){0.f, 0.f, 0.f, 0.f};
#pragma unroll
                for (int ks = 0; ks < 2; ++ks) { const bf16x8 kf = *(const LAS bf16x8*)(KT + ((size_t)dir * 128 + 16 * nb + fr) * 72 + 32 * ks + 8 * fq);
                    acc = __builtin_amdgcn_mfma_f32_16x16x32_bf16(kf, vf[ks], acc, 0, 0, 0); }
                { u32x2 o_; o_.x = pk2(acc[0], acc[1]); o_.y = pk2(acc[2], acc[3]); *(u32x2*)(st + 16 * nb + 4 * fq) = o_; }
            }
        }
    }
}
__device__ __forceinline__ void even_phase_b(const Args& args, int G, int wave_sgpr_) {
    unsigned char* ws = opaque_ptr(args.ws); bf16* ST = (bf16*)(ws + AR_ST); const float* DEC = (const float*)(ws + AR_DEC);
    const int gt = opaque_bx() * 512 + opaque_tid(), NT = G * 512;
    for (int it = gt; it < 4 * NSEQ * 4 * 2048; it += NT) {
        const int e8 = it & 2047, h = (it >> 11) & 3, rest = it >> 13, s = rest % NSEQ, td = rest / NSEQ, dir = td & 1;
        const int nc = s < 4 ? 64 : 32, cg0 = s < 4 ? s * 64 : 256 + (s - 4) * 32;
        float run[8];
#pragma unroll
        for (int i = 0; i < 8; ++i) run[i] = 0.f;
        for (int c0 = 0; c0 < nc; c0 += 8) {
            u32x4 uu[8]; f32x4 d0[8], d1[8];
#pragma unroll
            for (int e = 0; e < 8; ++e) { const int c = c0 + e, cg = dir ? cg0 + nc - 1 - c : cg0 + c;
                uu[e] = *((const u32x4*)(ST + ((size_t)(td * NCHUNK + cg) * 4 + h) * 16384) + e8);
                const f32x4* dp = (const f32x4*)(DEC + ((size_t)(td * NCHUNK + cg) * 4 + h) * 128) + 2 * (e8 & 15); d0[e] = dp[0]; d1[e] = dp[1]; }
#pragma unroll
            for (int e = 0; e < 8; ++e) { const int c = c0 + e, cg = dir ? cg0 + nc - 1 - c : cg0 + c;
                u32x4 o; o.x = pk2(run[0], run[1]); o.y = pk2(run[2], run[3]); o.z = pk2(run[4], run[5]); o.w = pk2(run[6], run[7]);
                *((u32x4*)(ST + ((size_t)(td * NCHUNK + cg) * 4 + h) * 16384) + e8) = o;
                run[0] = d0[e].x * run[0] + bflo(uu[e].x); run[1] = d0[e].y * run[1] + bfhi(uu[e].x); run[2] = d0[e].z * run[2] + bflo(uu[e].y); run[3] = d0[e].w * run[3] + bfhi(uu[e].y);
                run[4] = d1[e].x * run[4] + bflo(uu[e].z); run[5] = d1[e].y * run[5] + bfhi(uu[e].z); run[6] = d1[e].z * run[6] + bflo(uu[e].w); run[7] = d1[e].w * run[7] + bfhi(uu[e].w); }
        }
    }
}
__device__ __forceinline__ void even_phase_c(const Args& args, LAS uchar* lds, int j, int G, int wave_sgpr_) {
    unsigned char* ws = opaque_ptr(args.ws);
    const bf16* PROJ = (const bf16*)(ws + AR_PROJ); const bf16* ST = (const bf16*)(ws + AR_ST); const float2* ROT = (const float2*)(ws + WS_ROT); bf16* OM = (bf16*)(ws + AR_OME);
    const int tid = opaque_tid(), wave = uni(tid >> 6), lane = tid & 63, fr = lane & 15, fq = lane >> 4;
    constexpr int TP = 136;
    LAS bf16* QX = (LAS bf16*)lds;
    LAS bf16* KX = QX + 2 * 64 * TP;
    LAS bf16* QI = KX + 2 * 64 * TP;
    LAS bf16* PT = QI + 2 * 64 * TP;
    LAS f32x2* STAT = (LAS f32x2*)(PT + 64 * 72);
    LAS uchar* RAW = lds + 69632;
    LAS float* HS = (LAS float*)(lds + 69632 + 3 * 17408);
    LAS uchar* VTL = lds + MISC_OFF + 64;
    static_assert(69632 + 3 * 17408 + 2048 <= XLDS_OFF && MISC_OFF + 64 + 17408 <= LDS_BYTES, "even_phase_c LDS map");
    u32x4 rg[4][2];
#pragma unroll
    for (int i = 0; i < 4; ++i) { rg[i][0] = (u32x4){0u, 0u, 0u, 0u}; rg[i][1] = rg[i][0]; }
    { const int u = opaque_bx(); if (u < 2 * NCHUNK * 4) even_stage_load(rg, PROJ, u / (NCHUNK * 4), u & 3, ((u % (NCHUNK * 4)) >> 2) * 64, tid); }
    for (int u = opaque_bx(); u < 2 * NCHUNK * 4; u += G) {
        const int type = u / (NCHUNK * 4), rem = u % (NCHUNK * 4), cg = rem >> 2, h = rem & 3, row0 = cg * 64, pos0 = row_pos(row0);
        bf16x8 sfq[2][4]; u32x2 gwq[4];
        {
#pragma unroll
            for (int dir = 0; dir < 2; ++dir) { const bf16* st = ST + ((size_t)((type * 2 + dir) * NCHUNK + cg) * 4 + h) * 16384 + (size_t)(16 * wave + fr) * 128;
#pragma unroll
                for (int ks = 0; ks < 4; ++ks) sfq[dir][ks] = *(const bf16x8*)(st + 32 * ks + 8 * fq); }
            const int gcol = (type == 0 ? 2048 : 4096) + h * 128 + 16 * wave + 4 * fq;
#pragma unroll
            for (int mb = 0; mb < 4; ++mb) gwq[mb] = *(const u32x2*)(PROJ + (size_t)(row0 + 16 * mb + fr) * DIN + gcol);
        }
        __syncthreads();
        even_stage_commit(rg, RAW, VTL, type, tid);
        { const int un = u + G; if (un < 2 * NCHUNK * 4) even_stage_load(rg, PROJ, un / (NCHUNK * 4), un & 3, ((un % (NCHUNK * 4)) >> 2) * 64, tid); }
        {
            float lf[32], start, ref, total;
            const int k = tid & 127, dir = (tid >> 7) & 1, half = tid >> 8;
            LAS bf16* qx = QX + ((size_t)dir * 64 + 32 * half) * TP + k; LAS bf16* kx = KX + ((size_t)dir * 64 + 32 * half) * TP + k; LAS bf16* qi = QI + ((size_t)dir * 64 + 32 * half) * TP + k;
            even_elem_c(args, j, type, h, row0, pos0, PROJ, ROT, RAW, HS, tid, qx, kx, lf, start, ref, total);
            even_cumul(uni(dir), start, lf);
            const float eref = exp_(ref);
#pragma unroll
            for (int i = 0; i < 32; ++i) {
                const float e1 = exp_(lf[i] - ref), q_ = bf2f(qx[i * TP]), k_ = bf2f(kx[i * TP]);
                qx[i * TP] = f2bf_hw(q_ * e1);
                kx[i * TP] = f2bf_hw(k_ * __builtin_amdgcn_rcpf(e1));
                qi[i * TP] = f2bf_hw(q_ * e1 * eref); }
        }
        __syncthreads();
        {
            const int mb = wave >> 1;
#pragma unroll
            for (int nn = 0; nn < 2; ++nn) {
                const int nbk = 2 * (wave & 1) + nn;
                f32x4 af = (f32x4){0.f, 0.f, 0.f, 0.f}, ab = af;
#pragma unroll
                for (int ks = 0; ks < 4; ++ks) {
                    const bf16x8 kf = *(const LAS bf16x8*)(KX + ((size_t)0 * 64 + 16 * nbk + fr) * TP + 32 * ks + 8 * fq), qf = *(const LAS bf16x8*)(QX + ((size_t)0 * 64 + 16 * mb + fr) * TP + 32 * ks + 8 * fq);
                    af = __builtin_amdgcn_mfma_f32_16x16x32_bf16(kf, qf, af, 0, 0, 0);
                    const bf16x8 kb = *(const LAS bf16x8*)(KX + ((size_t)1 * 64 + 16 * nbk + fr) * TP + 32 * ks + 8 * fq), qb = *(const LAS bf16x8*)(QX + ((size_t)1 * 64 + 16 * mb + fr) * TP + 32 * ks + 8 * fq);
                    ab = __builtin_amdgcn_mfma_f32_16x16x32_bf16(kb, qb, ab, 0, 0, 0);
                }
                const int t = 16 * mb + fr; float p[4];
#pragma unroll
                for (int r = 0; r < 4; ++r) { const int s = 16 * nbk + 4 * fq + r; const float vf_ = (s <= t) ? af[r] : 0.f; const float vb_ = (type == 0 ? (s >= t) : (s > t)) ? ab[r] : 0.f; p[r] = vf_ + vb_; }
                u32x2 o; o.x = pk2(p[0], p[1]); o.y = pk2(p[2], p[3]);
                *(LAS u32x2*)(PT + (size_t)t * 72 + 16 * nbk + 4 * fq) = o;
            }
        }
        __syncthreads();
#ifndef E2C_DBG
#define E2C_DBG 0
#endif
        f32x4 acc[4];
#pragma unroll
        for (int mb = 0; mb < 4; ++mb) acc[mb] = (f32x4){0.f, 0.f, 0.f, 0.f};
        {
            bf16x8 vfq[2];
#pragma unroll
            for (int ks = 0; ks < 2; ++ks) vfq[ks] = lds_vfrag(VTL, 32 * ks + 8 * fq, 16 * wave + fr);
#pragma unroll
            for (int ks = 0; ks < 2; ++ks) {
#pragma unroll
                for (int mb = 0; mb < 4; ++mb) { const bf16x8 pf = *(const LAS bf16x8*)(PT + (size_t)(16 * mb + fr) * 72 + 32 * ks + 8 * fq); acc[mb] = __builtin_amdgcn_mfma_f32_16x16x32_bf16(vfq[ks], pf, acc[mb], 0, 0, 0); } }
#pragma unroll
            for (int dir = 0; dir < 2; ++dir) {
#pragma unroll
                for (int ks = 0; ks < 4; ++ks) {
#pragma unroll
                    for (int mb = 0; mb < 4; ++mb) { const bf16x8 qf = *(const LAS bf16x8*)(QI + ((size_t)dir * 64 + 16 * mb + fr) * TP + 32 * ks + 8 * fq); acc[mb] = __builtin_amdgcn_mfma_f32_16x16x32_bf16(sfq[dir][ks], qf, acc[mb], 0, 0, 0); } }
            }
        }
#pragma unroll
        for (int mb = 0; mb < 4; ++mb) { float s1 = (acc[mb][0] + acc[mb][1]) + (acc[mb][2] + acc[mb][3]); float s2 = (acc[mb][0] * acc[mb][0] + acc[mb][1] * acc[mb][1]) + (acc[mb][2] * acc[mb][2] + acc[mb][3] * acc[mb][3]);
            s1 = xor32_sum(xor16_sum(s1)); s2 = xor32_sum(xor16_sum(s2));
            if (fq == 0) STAT[(16 * mb + fr) * 8 + wave] = (f32x2){s1, s2}; }
        __syncthreads();
        {
            const float* gain = (type == 0 ? args.in[I_ENA] : args.in[I_ENB]) + (size_t)j * 512 + h * 128 + 16 * wave + 4 * fq;
            const f32x4 gn = *(const f32x4*)gain;
#pragma unroll
            for (int mb = 0; mb < 4; ++mb) {
                const int t = 16 * mb + fr; float S1 = 0.f, S2 = 0.f;
#pragma unroll
                for (int w = 0; w < 8; ++w) { const f32x2 a = STAT[t * 8 + w]; S1 += a.x; S2 += a.y; }
                const float mean = (type == 0) ? 0.f : ldexpf(S1, -7);
                const float var = ldexpf(S2, -7) - mean * mean;
                const float rstd = 1.f / sqrtf(fmaxf(var, 0.f) + 1e-6f);
                const u32x2 gw = gwq[mb];
                const float g0 = siluf_(bflo(gw.x)), g1 = siluf_(bfhi(gw.x)), g2 = siluf_(bflo(gw.y)), g3 = siluf_(bfhi(gw.y));
                const float o0 = (acc[mb][0] - mean) * rstd * gn.x * g0, o1 = (acc[mb][1] - mean) * rstd * gn.y * g1, o2 = (acc[mb][2] - mean) * rstd * gn.z * g2, o3 = (acc[mb][3] - mean) * rstd * gn.w * g3;
                u32x2 o; o.x = pk2(o0, o1); o.y = pk2(o2, o3);
                if (E2C_DBG) { o.x = pk2(acc[mb][0], acc[mb][1]); o.y = pk2(acc[mb][2], acc[mb][3]); }
                *(u32x2*)(OM + (size_t)(row0 + t) * D + type * 512 + h * 128 + 16 * wave + 4 * fq) = o;
            }
        }
    }
}

__device__ __forceinline__ void unpack8(const u32x4 a, float (&o)[8]) {
    o[0] = bflo(a.x); o[1] = bfhi(a.x); o[2] = bflo(a.y); o[3] = bfhi(a.y); o[4] = bflo(a.z); o[5] = bfhi(a.z); o[6] = bflo(a.w); o[7] = bfhi(a.w);
}
__device__ __forceinline__ u32x4 pack8(const float (&v)[8]) { u32x4 a; a.x = pk2(v[0], v[1]); a.y = pk2(v[2], v[3]); a.z = pk2(v[4], v[5]); a.w = pk2(v[6], v[7]); return a; }
__device__ __forceinline__ void load8f(const float* p, float (&o)[8]) { const f32x4 a = *(const f32x4*)p, b = *((const f32x4*)p + 1); o[0] = a.x; o[1] = a.y; o[2] = a.z; o[3] = a.w; o[4] = b.x; o[5] = b.y; o[6] = b.z; o[7] = b.w; }
__device__ __forceinline__ float oct_sum(float v) {
    v = quad_sum(v);
    v += __builtin_bit_cast(float, __builtin_amdgcn_mov_dpp(__builtin_bit_cast(int, v), 0x141, 0xF, 0xF, true));
    return v;
}
__device__ __forceinline__ void odd_shiftmix(const Args& args, int j, int gw, int NGW, int lane) {
    unsigned char* ws = opaque_ptr(args.ws); const bf16* XBr = (const bf16*)(ws + WS_XB); bf16* XM = (bf16*)(ws + AR_XM);
    const float* mu = args.in[I_OMU] + (size_t)j * 6 * D + 16 * lane;
    const int per = (NTOK + NGW - 1) / NGW, rb = gw * per, re = rb + per < NTOK ? rb + per : NTOK;
    if (rb >= re) return;
    float m[6][2][8];
#pragma unroll
    for (int p = 0; p < 6; ++p) { load8f(mu + (size_t)p * D, m[p][0]); load8f(mu + (size_t)p * D + 8, m[p][1]); }
    const u32x4 z4 = (u32x4){0u, 0u, 0u, 0u};
    u32x4 pv[2] = {z4, z4}, cu[2], nx[2] = {z4, z4};
#define SM_LD(dst_, rr_) do { const u32x4* p_ = (const u32x4*)(XBr + (size_t)(rr_) * D + 16 * lane); dst_[0] = p_[0]; dst_[1] = p_[1]; } while (0)
    if (rb > 0) SM_LD(pv, rb - 1);
    SM_LD(cu, rb);
    if (rb + 1 < NTOK) SM_LD(nx, rb + 1);
    for (int r = rb; r < re; ++r) {
        u32x4 n2[2] = {z4, z4};
        if (r + 1 < re && r + 2 < NTOK) SM_LD(n2, r + 2);
        const int pos = row_pos(r), T = row_T(r);
        const bool hp = pos > 0, hn = pos < T - 1;
#pragma unroll
        for (int hh = 0; hh < 2; ++hh) {
            float x[8], xp[8], xn[8], xx[8];
            unpack8(cu[hh], x); unpack8(pv[hh], xp); unpack8(nx[hh], xn);
#pragma unroll
            for (int i = 0; i < 8; ++i) xx[i] = ((hp ? xp[i] : 0.f) + (hn ? xn[i] : 0.f)) * 0.5f - x[i];
#pragma unroll
            for (int p = 0; p < 6; ++p) { float v[8];
#pragma unroll
                for (int i = 0; i < 8; ++i) v[i] = x[i] + xx[i] * m[p][hh][i];
                *((u32x4*)(XM + ((size_t)p * NTOK + r) * D + 16 * lane) + hh) = pack8(v); }
        }
        pv[0] = cu[0]; pv[1] = cu[1]; cu[0] = nx[0]; cu[1] = nx[1]; nx[0] = n2[0]; nx[1] = n2[1];
    }
#undef SM_LD
}
__device__ __forceinline__ void unpack16(const bf16* p, float (&o)[16]) {
    const u32x4 a = *(const u32x4*)p, b = *((const u32x4*)p + 1);
    o[0] = bflo(a.x); o[1] = bfhi(a.x); o[2] = bflo(a.y); o[3] = bfhi(a.y); o[4] = bflo(a.z); o[5] = bfhi(a.z); o[6] = bflo(a.w); o[7] = bfhi(a.w);
    o[8] = bflo(b.x); o[9] = bfhi(b.x); o[10] = bflo(b.y); o[11] = bfhi(b.y); o[12] = bflo(b.z); o[13] = bfhi(b.z); o[14] = bflo(b.w); o[15] = bfhi(b.w);
}
__device__ __forceinline__ void load16f(const float* p, float (&o)[16]) {
#pragma unroll
    for (int i = 0; i < 4; ++i) { const f32x4 v = *((const f32x4*)p + i); o[4 * i] = v.x; o[4 * i + 1] = v.y; o[4 * i + 2] = v.z; o[4 * i + 3] = v.w; }
}
__device__ __forceinline__ void store16bf(void* p, const float (&v)[16]) {
    u32x4 a, b; a.x = pk2(v[0], v[1]); a.y = pk2(v[2], v[3]); a.z = pk2(v[4], v[5]); a.w = pk2(v[6], v[7]); b.x = pk2(v[8], v[9]); b.y = pk2(v[10], v[11]); b.z = pk2(v[12], v[13]); b.w = pk2(v[14], v[15]);
    *(u32x4*)p = a; *((u32x4*)p + 1) = b;
}
__device__ __forceinline__ void odd_prep(const Args& args, int j, int gw, int NGW, int lane) {
    unsigned char* ws = opaque_ptr(args.ws);
    const bf16* R = (const bf16*)(ws + AR_RKV); const bf16* Kk = R + (size_t)NTOK * D; const bf16* LW = (const bf16*)(ws + AR_LW); const bf16* LA = (const bf16*)(ws + AR_LA);
    unsigned char* SCN = ws + AR_SCN; float* CB = (float*)(ws + AR_CB);
    const int hf = gw & 1, c0 = hf * 512 + 8 * lane, h = hf * 8 + (lane >> 3), sub = lane & 7;
    float k_k[8], k_a[8], r_k[8], w0v[2][8], a0v[2][8];
    load8f(args.in[I_OKK] + (size_t)j * D + c0, k_k); load8f(args.in[I_OKA] + (size_t)j * D + c0, k_a); load8f(args.in[I_ORK] + (size_t)j * D + c0, r_k);
#pragma unroll
    for (int dir = 0; dir < 2; ++dir) { load8f(args.in[I_OW0] + (size_t)j * 2 * D + dir * D + c0, w0v[dir]); load8f(args.in[I_OA0] + (size_t)j * 2 * D + dir * D + c0, a0v[dir]); }
    const int rstep = NGW >> 1;
    u32x4 nxt[6];
#define PREP_LD(rr_) do { const size_t r_ = (size_t)(rr_); nxt[0] = *(const u32x4*)(R + r_ * D + c0); nxt[1] = *(const u32x4*)(Kk + r_ * D + c0); \
        nxt[2] = *(const u32x4*)(LW + r_ * 2048 + c0); nxt[3] = *(const u32x4*)(LW + r_ * 2048 + 1024 + c0); nxt[4] = *(const u32x4*)(LA + r_ * 2048 + c0); nxt[5] = *(const u32x4*)(LA + r_ * 2048 + 1024 + c0); } while (0)
    if ((gw >> 1) < NTOK) PREP_LD(gw >> 1);
    for (int r = gw >> 1; r < NTOK; r += rstep) {
        u32x4 cur[6];
#pragma unroll
        for (int i = 0; i < 6; ++i) cur[i] = nxt[i];
        if (r + rstep < NTOK) PREP_LD(r + rstep);
        float rv[8], kv[8], kk[8];
        unpack8(cur[0], rv); unpack8(cur[1], kv);
        float ss = 0.f;
#pragma unroll
        for (int i = 0; i < 8; ++i) { kk[i] = kv[i] * k_k[i]; ss += kk[i] * kk[i]; }
        ss = oct_sum(ss);
        const float inv = 1.f / fmaxf(sqrtf(ss), 1e-12f);
#pragma unroll
        for (int i = 0; i < 8; ++i) kk[i] *= inv;
        unsigned char* row = SCN + ((size_t)r * 16 + h) * 1280;
        *(u32x4*)(row + sub * 16) = cur[0]; *(u32x4*)(row + 128 + sub * 16) = pack8(kk);
        float cbp = 0.f;
#pragma unroll
        for (int dir = 0; dir < 2; ++dir) {
            float lw[8], la[8], kd[8], bb[8], dec[8];
            unpack8(cur[2 + dir], lw); unpack8(cur[4 + dir], la);
#pragma unroll
            for (int i = 0; i < 8; ++i) {
                const float nx = -(w0v[dir][i] + lw[i]); const float sp = fmaxf(nx, 0.f) + log_(1.f + exp_(-fabsf(nx)));
                dec[i] = exp_(-exp_(-sp - 0.5f));
                const float a = sigmoidf_(a0v[dir][i] + la[i]);
                kd[i] = kv[i] * (1.f + (a - 1.f) * k_a[i]); bb[i] = kk[i] * a;
                cbp += rv[i] * r_k[i] * kd[i];
            }
            *(u32x4*)(row + 256 + dir * 512 + sub * 16) = pack8(kd); *(u32x4*)(row + 384 + dir * 512 + sub * 16) = pack8(bb);
            *(f32x4*)(row + 512 + dir * 512 + sub * 32) = (f32x4){dec[0], dec[1], dec[2], dec[3]}; *(f32x4*)(row + 512 + dir * 512 + sub * 32 + 16) = (f32x4){dec[4], dec[5], dec[6], dec[7]};
        }
        cbp = oct_sum(cbp);
        if (sub == 0) CB[(size_t)r * 16 + h] = cbp;
    }
#undef PREP_LD
}
__device__ __forceinline__ f32x2 oct_sum2(f32x2 v) { f32x2 r; r.x = oct_sum(v.x); r.y = oct_sum(v.y); return r; }
__device__ __forceinline__ void odd_scan_unit(const Args& args, LAS uchar* wl  , int s_, int h_, int dir_, int q16_, int lane) {
    const int s = uni(s_), h = uni(h_), dir = uni(dir_), q16 = uni(q16_);
    unsigned char* ws = opaque_ptr(args.ws); const unsigned char* SCN = ws + AR_SCN; const bf16* V = (const bf16*)(ws + AR_V); bf16* Y = (bf16*)(ws + (dir ? AR_YB : AR_YF));
    const int T = seq_T(s), r0 = seq_row0(s), rp = lane >> 3, c8 = lane & 7, i0 = q16 * 16 + 2 * rp;
    constexpr int TS = 8;
    f32x2 S[2][4];
#pragma unroll
    for (int r = 0; r < 2; ++r)
#pragma unroll
        for (int c = 0; c < 4; ++c) S[r][c] = (f32x2){0.f, 0.f};
    const int soff = lane < 32 ? 8 * lane : (256 + dir * 512) + 8 * (lane - 32);
    const int soffw = lane < 16 ? (512 + dir * 512) + 16 * lane : (int)0xfffffff0u;
    u32x2 pre[2][TS]; u32x4 prew[2][TS]; unsigned vpre[2][TS];
    const int nblk = T / TS;
    const __amdgpu_buffer_rsrc_t rsrc = __builtin_amdgcn_make_buffer_rsrc((void*)ws, 0, 0xffffffff, 0x00020000);
    const unsigned sstep = dir ? 0u - 20480u : 20480u, vstep = dir ? 0u - 2048u : 2048u;
    const unsigned scn_base = (unsigned)AR_SCN + (unsigned)h * 1280u, v_base = (unsigned)AR_V + (unsigned)h * 128u;
    const int voff_v = i0 * 2, voff_y = c8 == 0 ? i0 * 2 : (int)0xfffffff0u;
    const unsigned y_base = (unsigned)(dir ? AR_YB : AR_YF) + (unsigned)h * 128u;
    unsigned ysoff = y_base + (unsigned)(r0 + (dir ? T - 1 : 0)) * 2048u; const unsigned ystep = dir ? 0u - 2048u : 2048u;
#define SCAN_ISSUE(set_, blk_) do { const int t0_ = dir ? T - 1 - (blk_) * TS : (blk_) * TS; const unsigned row0_ = (unsigned)(r0 + t0_); \
        unsigned so_ = scn_base + row0_ * 20480u, vo_ = v_base + row0_ * 2048u;     \
        _Pragma("unroll") for (int e = 0; e < TS; ++e) { \
            pre[set_][e] = __builtin_bit_cast(u32x2, __builtin_amdgcn_raw_buffer_load_b64(rsrc, soff, (int)so_, 0)); prew[set_][e] = __builtin_amdgcn_raw_buffer_load_b128(rsrc, soffw, (int)so_, 0); \
            vpre[set_][e] = __builtin_amdgcn_raw_buffer_load_b32(rsrc, voff_v, (int)vo_, 0); so_ += sstep; vo_ += vstep; } } while (0)
    const int cvec = lane >> 4, cdst = (cvec == 0 ? 256 : cvec == 1 ? 0 : cvec == 2 ? 512 : 768) + (lane & 15) * 16;
#define SCAN_COMMIT(set_, buf_) do { LAS uchar* base_ = wl + (buf_) * (TS * 1280); \
        _Pragma("unroll") for (int e = 0; e < TS; ++e) { const u32x2 w_ = pre[set_][e]; *(LAS f32x4*)(base_ + e * 1280 + cdst) = (f32x4){bflo(w_.x), bfhi(w_.x), bflo(w_.y), bfhi(w_.y)}; } \
        if (lane < 16) { _Pragma("unroll") for (int e = 0; e < TS; ++e) *(LAS u32x4*)(base_ + e * 1280 + 1024 + lane * 16) = prew[set_][e]; } } while (0)
    f32x4 okk[2][2], orr[2], okd[2], obb[2], oww[2];
#define SCAN_LOADKK(buf_, stp_) do { const LAS uchar* sp_ = (stp_); okk[buf_][0] = *(const LAS f32x4*)(sp_); okk[buf_][1] = *(const LAS f32x4*)(sp_ + 16); } while (0)
#define SCAN_LOADREST(stp_) do { const LAS uchar* sp_ = (stp_); _Pragma("unroll") for (int c4 = 0; c4 < 2; ++c4) { \
        okd[c4] = *(const LAS f32x4*)(sp_ + 512 + c4 * 16); obb[c4] = *(const LAS f32x4*)(sp_ + 768 + c4 * 16); oww[c4] = *(const LAS f32x4*)(sp_ + 1024 + c4 * 16); orr[c4] = *(const LAS f32x4*)(sp_ + 256 + c4 * 16); } } while (0)
    unsigned vcur[TS];
    SCAN_ISSUE(0, 0); SCAN_COMMIT(0, 0);
#pragma unroll
    for (int e = 0; e < TS; ++e) vcur[e] = vpre[0][e];
    SCAN_ISSUE(1, 1);
    SCAN_LOADKK(0, wl + c8 * 32);
    for (int blk2 = 0; blk2 < nblk; blk2 += 2) {
#pragma unroll
        for (int par = 0; par < 2; ++par) {
            const int blk = blk2 + par;
            if (blk + 2 < nblk) SCAN_ISSUE(par, blk + 2);
            LAS uchar* base = wl + par * (TS * 1280);
#pragma unroll
            for (int e = 0; e < TS; ++e) {
                const int cb = e & 1;
                SCAN_LOADREST(base + e * 1280 + c8 * 32);
                if (e + 1 < TS) SCAN_LOADKK(cb ^ 1, base + (e + 1) * 1280 + c8 * 32);
                const float vr[2] = {bflo(vcur[e]), bfhi(vcur[e])};
                const f32x2 kkp[4] = {(f32x2){okk[cb][0].x, okk[cb][0].y}, (f32x2){okk[cb][0].z, okk[cb][0].w}, (f32x2){okk[cb][1].x, okk[cb][1].y}, (f32x2){okk[cb][1].z, okk[cb][1].w}};
                float sa[2];
#pragma unroll
                for (int r = 0; r < 2; ++r) { f32x2 a = S[r][0] * kkp[0]; a = __builtin_elementwise_fma(S[r][1], kkp[1], a); a = __builtin_elementwise_fma(S[r][2], kkp[2], a); a = __builtin_elementwise_fma(S[r][3], kkp[3], a);
                    sa[r] = oct_sum(a.x + a.y); }
                const f32x2 kdp[4] = {(f32x2){okd[0].x, okd[0].y}, (f32x2){okd[0].z, okd[0].w}, (f32x2){okd[1].x, okd[1].y}, (f32x2){okd[1].z, okd[1].w}};
                const f32x2 bbp[4] = {(f32x2){obb[0].x, obb[0].y}, (f32x2){obb[0].z, obb[0].w}, (f32x2){obb[1].x, obb[1].y}, (f32x2){obb[1].z, obb[1].w}};
                const f32x2 wwp[4] = {(f32x2){oww[0].x, oww[0].y}, (f32x2){oww[0].z, oww[0].w}, (f32x2){oww[1].x, oww[1].y}, (f32x2){oww[1].z, oww[1].w}};
                const f32x2 rrp[4] = {(f32x2){orr[0].x, orr[0].y}, (f32x2){orr[0].z, orr[0].w}, (f32x2){orr[1].x, orr[1].y}, (f32x2){orr[1].z, orr[1].w}};
                float yy[2];
#pragma unroll
                for (int r = 0; r < 2; ++r) {
                    const f32x2 nsa = (f32x2){-sa[r], -sa[r]}, vv = (f32x2){vr[r], vr[r]};
                    f32x2 y = (f32x2){0.f, 0.f};
#pragma unroll
                    for (int c = 0; c < 4; ++c) { const f32x2 t = __builtin_elementwise_fma(nsa, bbp[c], vv * kdp[c]); S[r][c] = __builtin_elementwise_fma(S[r][c], wwp[c], t); y = __builtin_elementwise_fma(S[r][c], rrp[c], y); }
                    yy[r] = oct_sum(y.x + y.y);
                }
                asm volatile("" : "+v"(yy[0]), "+v"(yy[1]));
                __builtin_amdgcn_raw_buffer_store_b32(pk2(yy[0], yy[1]), rsrc, voff_y, (int)ysoff, 0);
                ysoff += ystep;
            }
            if (blk + 1 < nblk) {
                SCAN_COMMIT(par ^ 1, par ^ 1);
#pragma unroll
                for (int e = 0; e < TS; ++e) vcur[e] = vpre[par ^ 1][e];
                SCAN_LOADKK(0, wl + (par ^ 1) * (TS * 1280) + c8 * 32);
            }
        }
    }
}
__device__ __forceinline__ void odd_scan(const Args& args, LAS uchar* lds, int G, int wave, int lane, bool only0 = false) {
    const int c = blockIdx.x;
    volatile LAS unsigned* st = (volatile LAS unsigned*)(lds + MISC_OFF) + 8;
    unsigned st0 = 0u, st1 = 0u;
    if (wave == 0 && lane == 0) { st0 = st[0]; st1 = st[1]; }
    __syncthreads();
    if (c < 256 && !(only0 && wave != 0)) {
        LAS uchar* wl = lds + wave * 20480;
        if (wave < 2) { const int unit = 2 * c + wave;
            odd_scan_unit(args, wl, unit >> 7, (unit >> 3) & 15, (unit >> 2) & 1, unit & 3, lane);
        } else { const int k0 = wave < 4 ? 2 * (wave - 2) : wave, nk = wave < 4 ? 2 : 1;
            for (int uu = 0; uu < nk; ++uu) { const int u = 8 * c + k0 + uu; odd_scan_unit(args, wl, 4 + (u >> 7), (u >> 3) & 15, (u >> 2) & 1, u & 3, lane); }
        }
    }
    __syncthreads();
    if (wave == 0 && lane == 0) { st[0] = st0; st[1] = st1; }
}
__device__ __forceinline__ void unpack16r(const u32x4 a, const u32x4 b, float (&o)[16]) {
    o[0] = bflo(a.x); o[1] = bfhi(a.x); o[2] = bflo(a.y); o[3] = bfhi(a.y); o[4] = bflo(a.z); o[5] = bfhi(a.z); o[6] = bflo(a.w); o[7] = bfhi(a.w);
    o[8] = bflo(b.x); o[9] = bfhi(b.x); o[10] = bflo(b.y); o[11] = bfhi(b.y); o[12] = bflo(b.z); o[13] = bfhi(b.z); o[14] = bflo(b.w); o[15] = bfhi(b.w);
}
__device__ __forceinline__ void odd_post(const Args& args, int j, int gw, int NGW, int lane) {
    unsigned char* ws = opaque_ptr(args.ws);
    const bf16* YF = (const bf16*)(ws + AR_YF); const bf16* YB = (const bf16*)(ws + AR_YB); const bf16* V = (const bf16*)(ws + AR_V); const bf16* GG = (const bf16*)(ws + AR_GG);
    const float* CB = (const float*)(ws + AR_CB); bf16* OM = (bf16*)(ws + AR_OMO);
    const int c0 = 16 * lane, h = lane >> 2;
    float lw[16], lb[16];
    load16f(args.in[I_OLNW] + (size_t)j * D + c0, lw); load16f(args.in[I_OLNB] + (size_t)j * D + c0, lb);
    u32x4 nxt[8]; float ncb = 0.f;
#define POST_LD(rr_) do { const size_t o_ = (size_t)(rr_) * D + c0; nxt[0] = *(const u32x4*)(YF + o_); nxt[1] = *((const u32x4*)(YF + o_) + 1); nxt[2] = *(const u32x4*)(YB + o_); nxt[3] = *((const u32x4*)(YB + o_) + 1); \
        nxt[4] = *(const u32x4*)(V + o_); nxt[5] = *((const u32x4*)(V + o_) + 1); nxt[6] = *(const u32x4*)(GG + o_); nxt[7] = *((const u32x4*)(GG + o_) + 1); ncb = CB[(size_t)(rr_) * 16 + h]; } while (0)
    if (gw < NTOK) POST_LD(gw);
    for (int r = gw; r < NTOK; r += NGW) {
        const size_t o = (size_t)r * D + c0;
        float yf[16], yb[16], vv[16], gg[16], y[16], on[16];
        unpack16r(nxt[0], nxt[1], yf); unpack16r(nxt[2], nxt[3], yb); unpack16r(nxt[4], nxt[5], vv); unpack16r(nxt[6], nxt[7], gg);
        const float cb = ncb;
        if (r + NGW < NTOK) POST_LD(r + NGW);
        float s1 = 0.f;
#pragma unroll
        for (int i = 0; i < 16; ++i) { y[i] = yf[i] + yb[i]; s1 += y[i]; }
        const float mean = quad_sum(s1) * (1.f / 64.f);
        float s2 = 0.f;
#pragma unroll
        for (int i = 0; i < 16; ++i) { y[i] -= mean; s2 += y[i] * y[i]; }
        const float rstd = 1.f / sqrtf(quad_sum(s2) * (1.f / 64.f) + 64e-5f);
#pragma unroll
        for (int i = 0; i < 16; ++i) on[i] = ((y[i] * rstd) * lw[i] + lb[i] + cb * vv[i]) * gg[i];
        store16bf(OM + o, on);
    }
#undef POST_LD
}

typedef short bf16x4 __attribute__((ext_vector_type(4)));
__device__ __forceinline__ u32x2 pk4bf(float a, float b, float c, float d) { u32x2 w; w.x = pk2(a, b); w.y = pk2(c, d); return w; }
#define ROW_SHR_ADD(x_, n_) ((x_) + __builtin_bit_cast(float, __builtin_amdgcn_update_dpp(0, __builtin_bit_cast(int, (x_)), 0x110 + (n_), 0xF, 0xF, true)))
__device__ __forceinline__ void odd_prepc(const Args& args, LAS uchar* lds, int gw, int NGW, int wave, int lane) {
    unsigned char* ws = opaque_ptr(args.ws); const unsigned char* SCN = ws + AR_SCN;
    LAS float* KKs = (LAS float*)(lds + (wave < 7 ? wave * 19456 : MISC_OFF + 64));
    static_assert(7 * 19456 <= MISC_OFF && MISC_OFF + 64 + 18944 <= LDS_BYTES, "odd_prepc LDS areas");
    LAS float* RRs = KKs + 16 * 68; LAS float* BIs = RRs + 16 * 68; LAS float* KIs = BIs + 16 * 68;
    LAS float* Gs = KIs + 16 * 68;
    LAS float* As = Gs + 64;
    const int tau = lane & 15, jq = lane >> 4;
    for (int it = gw; it < (NTOK / 16) * 32; it += NGW) {
        const int dir = it & 1, h = (it >> 1) & 15, cg = it >> 5;
        const int tok = cg * 16 + (dir ? 15 - tau : tau);
        const unsigned char* row = SCN + ((size_t)tok * 16 + h) * 1280;
        const u32x4 r0 = *(const u32x4*)(row + jq * 32), r1 = *(const u32x4*)(row + jq * 32 + 16);
        const u32x4 k0 = *(const u32x4*)(row + 128 + jq * 32), k1 = *(const u32x4*)(row + 128 + jq * 32 + 16);
        const u32x4 d0 = *(const u32x4*)(row + 256 + dir * 512 + jq * 32), d1 = *(const u32x4*)(row + 256 + dir * 512 + jq * 32 + 16);
        const u32x4 b0 = *(const u32x4*)(row + 384 + dir * 512 + jq * 32), b1 = *(const u32x4*)(row + 384 + dir * 512 + jq * 32 + 16);
        f32x4 wv[4];
#pragma unroll
        for (int i = 0; i < 4; ++i) wv[i] = *(const f32x4*)(row + 512 + dir * 512 + jq * 64 + 16 * i);
        float rv[16], kkv[16], kdv[16], bv[16];
        unpack16r(r0, r1, rv); unpack16r(k0, k1, kkv); unpack16r(d0, d1, kdv); unpack16r(b0, b1, bv);
        LDS_WAIT(); asm volatile("" ::: "memory");
#pragma unroll
        for (int i = 0; i < 4; ++i) { f32x4 okk, orr, obi, oki, og;
#pragma unroll
            for (int e = 0; e < 4; ++e) { const int c = 4 * i + e;
                const float lw = log_(wv[i][e]);
                float cum = lw; cum = ROW_SHR_ADD(cum, 1); cum = ROW_SHR_ADD(cum, 2); cum = ROW_SHR_ADD(cum, 4); cum = ROW_SHR_ADD(cum, 8);
                const float ecum = exp_(cum), eexc = exp_(cum - lw), inv = __builtin_amdgcn_rcpf(ecum);
                okk[e] = kkv[c] * eexc; orr[e] = rv[c] * ecum; obi[e] = bv[c] * inv; oki[e] = kdv[c] * inv; og[e] = ecum; }
            *(LAS f32x4*)(KKs + tau * 68 + 16 * jq + 4 * i) = okk; *(LAS f32x4*)(RRs + tau * 68 + 16 * jq + 4 * i) = orr;
            *(LAS f32x4*)(BIs + tau * 68 + 16 * jq + 4 * i) = obi; *(LAS f32x4*)(KIs + tau * 68 + 16 * jq + 4 * i) = oki;
            if (tau == 15) *(LAS f32x4*)(Gs + 16 * jq + 4 * i) = og; }
        LDS_WAIT(); asm volatile("" ::: "memory");
        unsigned char* rec = ws + (dir ? AR_CH1 : AR_CH0) + ((size_t)cg * 16 + h) * CH_REC;
        f32x4 aab = (f32x4){0.f, 0.f, 0.f, 0.f}, aak = aab, arb = aab, ark = aab;
#pragma unroll
        for (int jt = 0; jt < 4; ++jt) {
            const f32x4 kf = *(const LAS f32x4*)(KKs + tau * 68 + 16 * jt + 4 * jq), rf = *(const LAS f32x4*)(RRs + tau * 68 + 16 * jt + 4 * jq);
            const f32x4 bf_ = *(const LAS f32x4*)(BIs + tau * 68 + 16 * jt + 4 * jq), kif = *(const LAS f32x4*)(KIs + tau * 68 + 16 * jt + 4 * jq);
            const u32x2 kkp = pk4bf(kf.x, kf.y, kf.z, kf.w), rrp = pk4bf(rf.x, rf.y, rf.z, rf.w), bip = pk4bf(bf_.x, bf_.y, bf_.z, bf_.w), kip = pk4bf(kif.x, kif.y, kif.z, kif.w);
            aab = __builtin_amdgcn_mfma_f32_16x16x16bf16_1k(__builtin_bit_cast(bf16x4, bip), __builtin_bit_cast(bf16x4, kkp), aab, 0, 0, 0);
            aak = __builtin_amdgcn_mfma_f32_16x16x16bf16_1k(__builtin_bit_cast(bf16x4, kip), __builtin_bit_cast(bf16x4, kkp), aak, 0, 0, 0);
            arb = __builtin_amdgcn_mfma_f32_16x16x16bf16_1k(__builtin_bit_cast(bf16x4, bip), __builtin_bit_cast(bf16x4, rrp), arb, 0, 0, 0);
            ark = __builtin_amdgcn_mfma_f32_16x16x16bf16_1k(__builtin_bit_cast(bf16x4, kip), __builtin_bit_cast(bf16x4, rrp), ark, 0, 0, 0);
            *(u32x2*)(rec + CH_KK + (jt * 64 + lane) * 8) = kkp; *(u32x2*)(rec + CH_RR + (jt * 64 + lane) * 8) = rrp;
        }
#pragma unroll
        for (int e = 0; e < 4; ++e) { const int sg = 4 * jq + e; if (!(sg < tau)) { aab[e] = 0.f; aak[e] = 0.f; } if (!(sg <= tau)) { arb[e] = 0.f; ark[e] = 0.f; } }
        *(LAS f32x4*)(As + tau * 20 + 4 * jq) = (f32x4){aab[0], aab[1], aab[2], aab[3]};
        *(u32x2*)(rec + CH_MAT + (0 * 64 + lane) * 8) = pk4bf(aak[0], aak[1], aak[2], aak[3]);
        *(u32x2*)(rec + CH_MAT + (2 * 64 + lane) * 8) = pk4bf(-arb[0], -arb[1], -arb[2], -arb[3]);
        *(u32x2*)(rec + CH_MAT + (3 * 64 + lane) * 8) = pk4bf(ark[0], ark[1], ark[2], ark[3]);
#pragma unroll
        for (int jt = 0; jt < 4; ++jt) {
            const int j = 16 * jt + tau; const float g = Gs[j]; float nb[4], kt[4];
#pragma unroll
            for (int e = 0; e < 4; ++e) { nb[e] = -BIs[(4 * jq + e) * 68 + j] * g; kt[e] = KIs[(4 * jq + e) * 68 + j] * g; }
            *(u32x2*)(rec + CH_NBT + (jt * 64 + lane) * 8) = pk4bf(nb[0], nb[1], nb[2], nb[3]); *(u32x2*)(rec + CH_KT + (jt * 64 + lane) * 8) = pk4bf(kt[0], kt[1], kt[2], kt[3]);
        }
        if (lane < 16) *(f32x4*)(rec + CH_G + lane * 16) = *(const LAS f32x4*)(Gs + 4 * lane);
        LDS_WAIT(); asm volatile("" ::: "memory");
        float X[16];
#pragma unroll
        for (int t = 0; t < 16; ++t) { float x = (t == tau) ? 1.f : 0.f;
#pragma unroll
            for (int s4 = 0; s4 < (t + 3) / 4; ++s4) { const f32x4 l4 = *(const LAS f32x4*)(As + t * 20 + 4 * s4);
#pragma unroll
                for (int e = 0; e < 4; ++e) if (4 * s4 + e < t) x -= l4[e] * X[4 * s4 + e]; }
            X[t] = x; }
        LDS_WAIT(); asm volatile("" ::: "memory");
#pragma unroll
        for (int t = 0; t < 16; ++t) As[t * 20 + tau] = X[t];
        LDS_WAIT(); asm volatile("" ::: "memory");
        { const f32x4 ti = *(const LAS f32x4*)(As + tau * 20 + 4 * jq); *(u32x2*)(rec + CH_MAT + (1 * 64 + lane) * 8) = pk4bf(ti.x, ti.y, ti.z, ti.w); }
    }
}
#define ROW_SHL_ADD(x_, n_) ((x_) + __builtin_bit_cast(float, __builtin_amdgcn_update_dpp(0, __builtin_bit_cast(int, (x_)), 0x100 + (n_), 0xF, 0xF, true)))
__device__ __forceinline__ void odd_prepm(const Args& args, LAS uchar* lds, int j, int gw, int NGW, int wave, int lane) {
    unsigned char* ws = opaque_ptr(args.ws);
    const bf16* R = (const bf16*)(ws + AR_RKV); const bf16* Kk = R + (size_t)NTOK * D; const bf16* LW = (const bf16*)(ws + AR_LW); const bf16* LA = (const bf16*)(ws + AR_LA); float* CB = (float*)(ws + AR_CB);
    LAS float* KKs = (LAS float*)(lds + wave * 20480);
    LAS float* RRs = KKs + 16 * 68; LAS float* BIs = RRs + 16 * 68; LAS float* KIs = BIs + 16 * 68;
    LAS float* As = KIs + 16 * 68;
    LAS float* Gs = As;
    LAS float* W0s = As + 16 * 20;
    LAS float* A0s = W0s + 128; LAS float* PKs = A0s + 128;
    const int tau = lane & 15, jq = lane >> 4;
    const int h = gw & 15, ch0 = h * 64 + 16 * jq;
    { const int dd = lane >> 5, cc = (lane & 31) * 2;
      const float* w0 = args.in[I_OW0] + (size_t)j * 2 * D + dd * D + h * 64 + cc; const float* a0 = args.in[I_OA0] + (size_t)j * 2 * D + dd * D + h * 64 + cc;
      W0s[dd * 64 + cc] = w0[0]; W0s[dd * 64 + cc + 1] = w0[1]; A0s[dd * 64 + cc] = a0[0]; A0s[dd * 64 + cc + 1] = a0[1];
      PKs[lane] = args.in[I_OKK][(size_t)j * D + h * 64 + lane]; PKs[64 + lane] = args.in[I_OKA][(size_t)j * D + h * 64 + lane]; PKs[128 + lane] = args.in[I_ORK][(size_t)j * D + h * 64 + lane]; }
    LDS_WAIT(); asm volatile("" ::: "memory");
    const int cgs = NGW >> 4, np = ((NTOK / 16 - (gw >> 4) + cgs - 1) / cgs) * 2;
    u32x4 nr0, nr1, nk0, nk1, nlw0, nlw1, nla0, nla1;
#define PM_LOAD(p_) do { const int pc_ = (p_) < np ? (p_) : np - 1; const int cg_ = (gw >> 4) + (pc_ >> 1) * cgs, d_ = pc_ & 1; const size_t tk_ = (size_t)(cg_ * 16 + tau); \
        const u32x4* pr_ = (const u32x4*)(R + tk_ * D + ch0); const u32x4* pk_ = (const u32x4*)(Kk + tk_ * D + ch0); nr0 = pr_[0]; nr1 = pr_[1]; nk0 = pk_[0]; nk1 = pk_[1]; \
        const u32x4* pw_ = (const u32x4*)(LW + tk_ * 2048 + d_ * 1024 + ch0); const u32x4* pa_ = (const u32x4*)(LA + tk_ * 2048 + d_ * 1024 + ch0); nlw0 = pw_[0]; nlw1 = pw_[1]; nla0 = pa_[0]; nla1 = pa_[1]; } while (0)
    if (np > 0) PM_LOAD(0);
    float cbp = 0.f;
#pragma unroll 1
    for (int p = 0; p < np; ++p) {
        const int cg = (gw >> 4) + (p >> 1) * cgs, dir = p & 1;
        const int tok = cg * 16 + tau;
        {
            const u32x4 r0 = nr0, r1 = nr1, k0 = nk0, k1 = nk1, lw0 = nlw0, lw1 = nlw1, la0 = nla0, la1 = nla1;
            PM_LOAD(p + 1);
            if (dir == 0) cbp = 0.f;
            float rv[16], kv[16], kkv[16];
            unpack16r(r0, r1, rv); unpack16r(k0, k1, kv);
            float ss = 0.f;
#pragma unroll
            for (int i = 0; i < 4; ++i) { const f32x4 kk4 = *(const LAS f32x4*)(PKs + 16 * jq + 4 * i);
#pragma unroll
                for (int e = 0; e < 4; ++e) { const int c = 4 * i + e; kkv[c] = kv[c] * kk4[e]; ss += kkv[c] * kkv[c]; } }
            ss = xor32_sum(xor16_sum(ss));
            { const float inv = 1.f / fmaxf(sqrtf(ss), 1e-12f);
#pragma unroll
              for (int c = 0; c < 16; ++c) kkv[c] *= inv; }
            float lwv[16], lav[16];
            unpack16r(lw0, lw1, lwv); unpack16r(la0, la1, lav);
            const int prow = dir ? 15 - tau : tau;
            LDS_WAIT(); asm volatile("" ::: "memory");
#pragma unroll
            for (int i = 0; i < 4; ++i) { f32x4 okk, orr, obi, oki, og;
                const f32x4 w04 = *(const LAS f32x4*)(W0s + dir * 64 + 16 * jq + 4 * i), a04 = *(const LAS f32x4*)(A0s + dir * 64 + 16 * jq + 4 * i);
                const f32x4 ka4 = *(const LAS f32x4*)(PKs + 64 + 16 * jq + 4 * i), rk4 = *(const LAS f32x4*)(PKs + 128 + 16 * jq + 4 * i);
#pragma unroll
                for (int e = 0; e < 4; ++e) { const int c = 4 * i + e;
                    const float nx = -(w04[e] + lwv[c]); const float tq = exp_(-fabsf(nx));
                    const float lw = -0.6065306597126334f * ((nx >= 0.f ? tq : 1.f) * __builtin_amdgcn_rcpf(1.f + tq));
                    const float a = sigmoidf_(a04[e] + lav[c]);
                    const float kd = kv[c] * (1.f + (a - 1.f) * ka4[e]), b = kkv[c] * a;
                    cbp += rv[c] * rk4[e] * kd;
                    float cum = lw;
                    if (dir == 0) { cum = ROW_SHR_ADD(cum, 1); cum = ROW_SHR_ADD(cum, 2); cum = ROW_SHR_ADD(cum, 4); cum = ROW_SHR_ADD(cum, 8); }
                    else { cum = ROW_SHL_ADD(cum, 1); cum = ROW_SHL_ADD(cum, 2); cum = ROW_SHL_ADD(cum, 4); cum = ROW_SHL_ADD(cum, 8); }
                    const float ecum = exp_(cum), eexc = exp_(cum - lw), inv = __builtin_amdgcn_rcpf(ecum);
                    okk[e] = kkv[c] * eexc; orr[e] = rv[c] * ecum; obi[e] = b * inv; oki[e] = kd * inv; og[e] = ecum; }
                *(LAS f32x4*)(KKs + prow * 68 + 16 * jq + 4 * i) = okk; *(LAS f32x4*)(RRs + prow * 68 + 16 * jq + 4 * i) = orr;
                *(LAS f32x4*)(BIs + prow * 68 + 16 * jq + 4 * i) = obi; *(LAS f32x4*)(KIs + prow * 68 + 16 * jq + 4 * i) = oki;
                if (prow == 15) *(LAS f32x4*)(Gs + 16 * jq + 4 * i) = og; }
            LDS_WAIT(); asm volatile("" ::: "memory");
            unsigned char* rec = ws + (dir ? AR_CH1 : AR_CH0) + ((size_t)cg * 16 + h) * CH_REC;
            f32x4 aab = (f32x4){0.f, 0.f, 0.f, 0.f}, aak = aab, arb = aab, ark = aab;
#pragma unroll
            for (int jt = 0; jt < 4; ++jt) {
                const f32x4 kf = *(const LAS f32x4*)(KKs + tau * 68 + 16 * jt + 4 * jq), rf = *(const LAS f32x4*)(RRs + tau * 68 + 16 * jt + 4 * jq);
                const f32x4 bf_ = *(const LAS f32x4*)(BIs + tau * 68 + 16 * jt + 4 * jq), kif = *(const LAS f32x4*)(KIs + tau * 68 + 16 * jt + 4 * jq);
                const u32x2 kkp = pk4bf(kf.x, kf.y, kf.z, kf.w), rrp = pk4bf(rf.x, rf.y, rf.z, rf.w), bip = pk4bf(bf_.x, bf_.y, bf_.z, bf_.w), kip = pk4bf(kif.x, kif.y, kif.z, kif.w);
                aab = __builtin_amdgcn_mfma_f32_16x16x16bf16_1k(__builtin_bit_cast(bf16x4, bip), __builtin_bit_cast(bf16x4, kkp), aab, 0, 0, 0);
                aak = __builtin_amdgcn_mfma_f32_16x16x16bf16_1k(__builtin_bit_cast(bf16x4, kip), __builtin_bit_cast(bf16x4, kkp), aak, 0, 0, 0);
                arb = __builtin_amdgcn_mfma_f32_16x16x16bf16_1k(__builtin_bit_cast(bf16x4, bip), __builtin_bit_cast(bf16x4, rrp), arb, 0, 0, 0);
                ark = __builtin_amdgcn_mfma_f32_16x16x16bf16_1k(__builtin_bit_cast(bf16x4, kip), __builtin_bit_cast(bf16x4, rrp), ark, 0, 0, 0);
                *(u32x2*)(rec + CH_KK + (jt * 64 + lane) * 8) = kkp; *(u32x2*)(rec + CH_RR + (jt * 64 + lane) * 8) = rrp;
                const int jj = 16 * jt + tau; const float g = Gs[jj]; float nb[4], kt[4];
#pragma unroll
                for (int e = 0; e < 4; ++e) { nb[e] = -BIs[(4 * jq + e) * 68 + jj] * g; kt[e] = KIs[(4 * jq + e) * 68 + jj] * g; }
                *(u32x2*)(rec + CH_NBT + (jt * 64 + lane) * 8) = pk4bf(nb[0], nb[1], nb[2], nb[3]); *(u32x2*)(rec + CH_KT + (jt * 64 + lane) * 8) = pk4bf(kt[0], kt[1], kt[2], kt[3]);
            }
            if (lane < 16) *(f32x4*)(rec + CH_G + lane * 16) = *(const LAS f32x4*)(Gs + 4 * lane);
#pragma unroll
            for (int e = 0; e < 4; ++e) { const int sg = 4 * jq + e; if (!(sg < tau)) { aab[e] = 0.f; aak[e] = 0.f; } if (!(sg <= tau)) { arb[e] = 0.f; ark[e] = 0.f; } }
            *(u32x2*)(rec + CH_MAT + (0 * 64 + lane) * 8) = pk4bf(aak[0], aak[1], aak[2], aak[3]);
            *(u32x2*)(rec + CH_MAT + (2 * 64 + lane) * 8) = pk4bf(-arb[0], -arb[1], -arb[2], -arb[3]);
            *(u32x2*)(rec + CH_MAT + (3 * 64 + lane) * 8) = pk4bf(ark[0], ark[1], ark[2], ark[3]);
            LDS_WAIT(); asm volatile("" ::: "memory");
            *(LAS f32x4*)(As + tau * 20 + 4 * jq) = aab;
            LDS_WAIT(); asm volatile("" ::: "memory");
            float X[16];
#pragma unroll
            for (int t = 0; t < 16; ++t) { float x = (t == tau) ? 1.f : 0.f;
#pragma unroll
                for (int s4 = 0; s4 < (t + 3) / 4; ++s4) { const f32x4 l4 = *(const LAS f32x4*)(As + t * 20 + 4 * s4);
#pragma unroll
                    for (int e = 0; e < 4; ++e) if (4 * s4 + e < t) x -= l4[e] * X[4 * s4 + e]; }
                X[t] = x; }
            LDS_WAIT(); asm volatile("" ::: "memory");
#pragma unroll
            for (int t = 0; t < 16; ++t) As[t * 20 + tau] = X[t];
            LDS_WAIT(); asm volatile("" ::: "memory");
            { const f32x4 ti = *(const LAS f32x4*)(As + tau * 20 + 4 * jq); *(u32x2*)(rec + CH_MAT + (1 * 64 + lane) * 8) = pk4bf(ti.x, ti.y, ti.z, ti.w); }
        }
        if (dir == 1) { const float cbt = xor32_sum(xor16_sum(cbp)); if (jq == 0) CB[(size_t)tok * 16 + h] = cbt; }
    }
#undef PM_LOAD
}
constexpr int SC_VOFF = (int)CH_REC;
constexpr int SC_SLOT = SC_VOFF + 2048;
template <int NQ, int DEPTH> __device__ __forceinline__ void odd_scanc_unit(const Args& args, LAS uchar* ring, int s_, int h_, int dir_, int q0_, int lane) {
    const int s = uni(s_), h = uni(h_), dir = uni(dir_), q0 = uni(q0_);
    unsigned char* ws = opaque_ptr(args.ws);
    const int T = seq_T(s), r0 = seq_row0(s), nch = T / 16, cg0 = r0 / 16, fr = lane & 15, fq = lane >> 4;
    const __amdgpu_buffer_rsrc_t rsrc = __builtin_amdgcn_make_buffer_rsrc((void*)ws, 0, 0xffffffff, 0x00020000);
    const unsigned ch_base = (unsigned)(dir ? AR_CH1 : AR_CH0) + (unsigned)h * (unsigned)CH_REC, v_base = (unsigned)AR_V + (unsigned)h * 128u;
    const int voff_rec = lane * 16, voff_v = (lane >> 3) * 2048 + (lane & 7) * 16, voff_last = lane < 16 ? lane * 16 : (int)0xfffffff0u;
    bf16* Y = (bf16*)(ws + (dir ? AR_YB : AR_YF));
    f32x4 ST[NQ][4];
#pragma unroll
    for (int qi = 0; qi < NQ; ++qi)
#pragma unroll
        for (int jt = 0; jt < 4; ++jt) ST[qi][jt] = (f32x4){0.f, 0.f, 0.f, 0.f};
#define SC_DMA(c_) do { const int cl_ = (c_) < nch ? (c_) : nch - 1; const int cc_ = dir ? nch - 1 - cl_ : cl_; LAS uchar* slot_ = ring + ((c_) % DEPTH) * SC_SLOT; \
        const unsigned so_ = ch_base + (unsigned)(cg0 + cc_) * (unsigned)(16 * CH_REC); \
        _Pragma("unroll") for (int i = 0; i < 11; ++i) __builtin_amdgcn_raw_ptr_buffer_load_lds(rsrc, (LAS void*)(slot_ + i * 1024), 16, i < 10 ? voff_rec : voff_last, (int)(so_ + (unsigned)i * 1024u), 0, 0); \
        const unsigned sv_ = v_base + (unsigned)(r0 + 16 * cc_) * 2048u; \
        _Pragma("unroll") for (int k = 0; k < 2; ++k) __builtin_amdgcn_raw_ptr_buffer_load_lds(rsrc, (LAS void*)(slot_ + SC_VOFF + k * 1024), 16, voff_v, (int)(sv_ + (unsigned)k * 16384u), 0, 0); } while (0)
#define SC_MFMA(a_, b_, c_) __builtin_amdgcn_mfma_f32_16x16x16bf16_1k(__builtin_bit_cast(bf16x4, (a_)), __builtin_bit_cast(bf16x4, (b_)), (c_), 0, 0, 0)
    static_assert(DEPTH >= 3 && (DEPTH - 1) * 13 <= 63, "ring depth: the counted wait must fit the 6-bit vmcnt");
#pragma unroll
    for (int c = 0; c < DEPTH - 1; ++c) SC_DMA(c);
    for (int c = 0; c < nch; ++c) {
        SC_DMA(c + DEPTH - 1);
        if constexpr (DEPTH == 5) asm volatile("s_waitcnt vmcnt(52)" ::: "memory");
        else if constexpr (DEPTH == 4) asm volatile("s_waitcnt vmcnt(39)" ::: "memory");
        else asm volatile("s_waitcnt vmcnt(26)" ::: "memory");
        const LAS uchar* slot = ring + (c % DEPTH) * SC_SLOT;
        u32x2 okk[4], orr[4], onb[4], okt[4], omat[4]; f32x4 og[4];
#pragma unroll
        for (int jt = 0; jt < 4; ++jt) { okk[jt] = *(const LAS u32x2*)(slot + CH_KK + jt * 512 + lane * 8); orr[jt] = *(const LAS u32x2*)(slot + CH_RR + jt * 512 + lane * 8); onb[jt] = *(const LAS u32x2*)(slot + CH_NBT + jt * 512 + lane * 8);
            okt[jt] = *(const LAS u32x2*)(slot + CH_KT + jt * 512 + lane * 8); omat[jt] = *(const LAS u32x2*)(slot + CH_MAT + jt * 512 + lane * 8); og[jt] = *(const LAS f32x4*)(slot + CH_G + (16 * jt + 4 * fq) * 4); }
        u32x2 vb[NQ];
#pragma unroll
        for (int qi = 0; qi < NQ; ++qi) { unsigned v_[4];
#pragma unroll
            for (int e = 0; e < 4; ++e) { const int t_ = 4 * fq + e; v_[e] = *(const LAS bf16*)(slot + SC_VOFF + (dir ? 15 - t_ : t_) * 128 + (16 * (q0 + qi) + fr) * 2); }
            vb[qi].x = v_[0] | (v_[1] << 16); vb[qi].y = v_[2] | (v_[3] << 16); }
        LDS_WAIT(); asm volatile("" ::: "memory");
        LAS uchar* yst = (LAS uchar*)slot + SC_VOFF;
#pragma unroll
        for (int qi = 0; qi < NQ; ++qi) {
            u32x2 sb[4];
#pragma unroll
            for (int jt = 0; jt < 4; ++jt) sb[jt] = pk4bf(ST[qi][jt][0], ST[qi][jt][1], ST[qi][jt][2], ST[qi][jt][3]);
            f32x4 pa = (f32x4){0.f, 0.f, 0.f, 0.f}, pr = pa;
#pragma unroll
            for (int jt = 0; jt < 4; ++jt) { pa = SC_MFMA(okk[jt], sb[jt], pa); pr = SC_MFMA(orr[jt], sb[jt], pr); }
            const f32x4 x = SC_MFMA(omat[0], vb[qi], pa);
            const u32x2 xb = pk4bf(x[0], x[1], x[2], x[3]);
            const f32x4 u = SC_MFMA(omat[1], xb, ((f32x4){0.f, 0.f, 0.f, 0.f}));
            const u32x2 ub = pk4bf(u[0], u[1], u[2], u[3]);
            f32x4 y = SC_MFMA(omat[2], ub, pr); y = SC_MFMA(omat[3], vb[qi], y);
#pragma unroll
            for (int jt = 0; jt < 4; ++jt) { f32x4 t = ST[qi][jt] * og[jt]; t = SC_MFMA(onb[jt], ub, t); ST[qi][jt] = SC_MFMA(okt[jt], vb[qi], t); }
#pragma unroll
            for (int e = 0; e < 4; ++e) { const int t_ = 4 * fq + e; *(LAS bf16*)(yst + (dir ? 15 - t_ : t_) * 128 + (16 * (q0 + qi) + fr) * 2) = (bf16)(pk2(y[e], 0.f) & 0xffffu); }
        }
        LDS_WAIT(); asm volatile("" ::: "memory");
        { const int cc = dir ? nch - 1 - c : c;
          if (NQ == 4) { const u32x4 a = *(const LAS u32x4*)(yst + (lane >> 2) * 128 + (lane & 3) * 32), b = *(const LAS u32x4*)(yst + (lane >> 2) * 128 + (lane & 3) * 32 + 16);
              u32x4* dst = (u32x4*)(Y + (size_t)(r0 + 16 * cc + (lane >> 2)) * D + h * 64 + (lane & 3) * 16); dst[0] = a; dst[1] = b; }
          else { const u32x4 a = *(const LAS u32x4*)(yst + (lane >> 2) * 128 + q0 * 32 + (lane & 3) * 16);
              *(u32x4*)(Y + (size_t)(r0 + 16 * cc + (lane >> 2)) * D + h * 64 + q0 * 16 + (lane & 3) * 8) = a; } }
    }
    asm volatile("s_waitcnt vmcnt(0)" ::: "memory");
#undef SC_DMA
#undef SC_MFMA
}
__device__ __forceinline__ void odd_scanc(const Args& args, LAS uchar* lds, int wave, int lane) {
    const int bx = blockIdx.x;
    volatile LAS unsigned* st = (volatile LAS unsigned*)(lds + MISC_OFF) + 8;
    unsigned st0 = 0u, st1 = 0u;
    if (wave == 0 && lane == 0) { st0 = st[0]; st1 = st[1]; }
    __syncthreads();
    if (bx < 256 && wave < 3) {
        if (wave == 0) { const int sidp = (bx >> 4) * 8 + (bx & 7), half = (bx >> 3) & 1;
            odd_scanc_unit<2, 5>(args, lds, sidp >> 5, (sidp >> 1) & 15, sidp & 1, 2 * half, lane); }
        else { const int sid = 2 * bx + (wave - 1); odd_scanc_unit<4, 4>(args, lds + 5 * SC_SLOT + (wave - 1) * (4 * SC_SLOT), 4 + (sid >> 5), (sid >> 1) & 15, sid & 1, 0, lane); }
    }
    __syncthreads();
    if (wave == 0 && lane == 0) { st[0] = st0; st[1] = st1; }
}
static_assert(13 * SC_SLOT <= LDS_BYTES, "scan rings");

__device__ __forceinline__ void moe_topk(const Args& args, LAS uchar* lds, int layer, int G, int wave_sgpr_) {
    if (opaque_bx() >= 32) {
        { const int tz = opaque_tid(), wv = uni(tz >> 6); moe_weights(args, layer, (LAS float*)(lds + wv * 16384), (opaque_bx() - 32) * NWAVES + wv, (G - 32) * NWAVES, tz & 63); }
        return;
    }
    unsigned char* ws = opaque_ptr(args.ws);
    const int g = opaque_bx() >> 4, e = opaque_bx() & 15, n = g ? NS : NP, cap = n / 8, base = g ? NP : 0, slotbase = g ? NP * 2 + e * 4096 : e * 2048;
    const float* aff = (const float*)(ws + WS_AFF) + (size_t)e * NTOK + base;
    int* IDX = (int*)(ws + WS_IDX) + slotbase; float* GATE = (float*)(ws + WS_GATE) + slotbase; int* INV = (int*)(ws + WS_INV);
    LAS unsigned* keys = (LAS unsigned*)lds;
    LAS unsigned* hist = (LAS unsigned*)(lds + XLDS_OFF);
    LAS unsigned* sh = hist + 256;
    const int tid = opaque_tid(), wave = tid >> 6, lane = tid & 63;
    for (int i = tid; i < n / 4; i += 512) ((LAS u32x4*)keys)[i] = ((const u32x4*)aff)[i];
    unsigned prefix = 0u, mask = 0u; int need = cap;
    for (int pass = 0; pass < 4; ++pass) {
        const int shift = 24 - 8 * pass;
        if (tid < 256) hist[tid] = 0u;
        __syncthreads();
        for (int i = tid; i < n; i += 512) { const unsigned k = keys[i]; if ((k & mask) == prefix) __hip_atomic_fetch_add(&hist[(k >> shift) & 255u], 1u, __ATOMIC_RELAXED, __HIP_MEMORY_SCOPE_WORKGROUP); }
        __syncthreads();
        if (wave == 0) {
            const int b0 = 255 - 4 * lane;
            const int h0 = (int)hist[b0], h1 = (int)hist[b0 - 1], h2 = (int)hist[b0 - 2], h3 = (int)hist[b0 - 3];
            const int tot = h0 + h1 + h2 + h3; int inc = tot;
#pragma unroll
            for (int d = 1; d < 64; d <<= 1) { const int t = __builtin_amdgcn_ds_bpermute(((lane - d) & 63) << 2, inc); if (lane >= d) inc += t; }
            const unsigned long long hitm = __ballot(inc >= need);
            const int Lh = hitm ? (int)__builtin_ctzll(hitm) : 63;
            if (lane == Lh) { int cum = inc - tot, b = b0;
                if (cum + h0 < need) { cum += h0; b = b0 - 1; if (cum + h1 < need) { cum += h1; b = b0 - 2; if (cum + h2 < need) { cum += h2; b = b0 - 3; } } }
                sh[0] = prefix | ((unsigned)b << shift); sh[1] = (unsigned)(need - cum); }
        }
        __syncthreads();
        prefix = sh[0]; need = (int)sh[1]; mask |= 255u << shift;
        __syncthreads();
    }
    const unsigned T = prefix;
    const int seg = n / 8, s0 = wave * seg;
    int cgt = 0, ceq = 0;
    for (int i = s0 + lane; i < s0 + seg; i += 64) { const unsigned k = keys[i]; cgt += (k > T); ceq += (k == T); }
    cgt = (int)wave_sum((float)cgt); ceq = (int)wave_sum((float)ceq);
    if (lane == 0) { sh[8 + wave] = (unsigned)cgt; sh[24 + wave] = (unsigned)ceq; }
    __syncthreads();
    int gtb = 0, eqb = 0;
    for (int w = 0; w < wave; ++w) { gtb += (int)sh[8 + w]; eqb += (int)sh[24 + w]; }
    for (int i0 = s0; i0 < s0 + seg; i0 += 64) {
        const int i = i0 + lane; const unsigned k = keys[i];
        const bool isgt = k > T, iseq = k == T;
        const unsigned long long mg = __ballot(isgt), me = __ballot(iseq);
        const unsigned long long lt = (lane == 0) ? 0ull : (~0ull >> (64 - lane));
        const int gbef = gtb + __popcll(mg & lt), ebef = eqb + __popcll(me & lt);
        const bool sel = isgt || (iseq && ebef < need);
        const int slot = gbef + (ebef < need ? ebef : need);
        if (sel) { IDX[slot] = base + i; GATE[slot] = __uint_as_float(k); }
        INV[(size_t)(base + i) * 16 + e] = sel ? slot : -1;
        gtb += __popcll(mg); eqb += __popcll(me);
    }
}
__device__ __forceinline__ void moe_gather(const Args& args, int gw, int NGW, int lane) {
    unsigned char* ws = opaque_ptr(args.ws); const int* IDX = (const int*)(ws + WS_IDX); const bf16* XB = (const bf16*)(ws + WS_XB); uchar* XE = ws + AR_XE;
    if (!MOE_FP8) { for (int sl = gw; sl < NSLOT; sl += NGW) { const int r = IDX[sl];
        const u32x4 a = *((const u32x4*)(XB + (size_t)r * D) + lane), b = *((const u32x4*)(XB + (size_t)r * D) + 64 + lane);
        *((u32x4*)((bf16*)XE + (size_t)sl * D) + lane) = a; *((u32x4*)((bf16*)XE + (size_t)sl * D) + 64 + lane) = b; } return; }
    constexpr int NG4 = NSLOT / 4;
    i32x4 nid = (i32x4){0, 0, 0, 0};
    if (gw < NG4) nid = *((const i32x4*)IDX + gw);
    for (int gi = gw; gi < NG4; gi += NGW) {
        const i32x4 id = nid;
        u32x4 a[4][2];
#pragma unroll
        for (int k = 0; k < 4; ++k) { const u32x4* p = (const u32x4*)(XB + (size_t)id[k] * D + 16 * lane); a[k][0] = p[0]; a[k][1] = p[1]; }
        if (gi + NGW < NG4) nid = *((const i32x4*)IDX + gi + NGW);
#pragma unroll
        for (int k = 0; k < 4; ++k) { float v[16]; unpack16r(a[k][0], a[k][1], v);
            u32x4 o; o.x = pk4_fp8(v[0], v[1], v[2], v[3]); o.y = pk4_fp8(v[4], v[5], v[6], v[7]); o.z = pk4_fp8(v[8], v[9], v[10], v[11]); o.w = pk4_fp8(v[12], v[13], v[14], v[15]);
            *((u32x4*)(XE + (size_t)(4 * gi + k) * D) + lane) = o; }
    }
}

constexpr int N_PHASES = 3 + 2 * (6 + 8) + 2 * (8 + 8) - 4 * MOE_GATHER_FUSED;
#ifndef MK_STOP
#define MK_STOP 0
#endif
__global__ void __launch_bounds__(NWAVES * 64, 2) enc_fwd(Args args) {
    extern __shared__ __attribute__((aligned(16))) unsigned char lds_raw[];
    LAS uchar* lds = (LAS uchar*)lds_raw;
    volatile LAS unsigned* MISC = (volatile LAS unsigned*)(lds + MISC_OFF);
    const int tid = threadIdx.x, lane = tid & 63, wave = uni(tid >> 6);
    const int wave_sgpr_ = wave;
    const int G = gridDim.x; const int bx = blockIdx.x; const int vcu = (G % 8 == 0) ? (bx % 8) * (G / 8) + bx / 8 : bx;
    const int gw = vcu * NWAVES + wave, NGW = G * NWAVES;
    unsigned char* ws = opaque_ptr(args.ws);
    if (tid < 16) MISC[tid] = 0u;
    __syncthreads();
    XcdBarrier bar; bar.bar = (unsigned*)(ws + WS_CTL) + CW_BAR; bar.x = 0; bar.st = nullptr;
    const int lo = args.ph_lo, hi = args.ph_hi;
    if (hi - lo > 1) bar = xcd_barrier_post((unsigned*)(ws + WS_CTL) + CW_BAR, MISC + 8);
    const GPhase* gph = (const GPhase*)(ws + WS_GPH); const GP* gpt = (const GP*)(ws + WS_GPT);
    int ph = 0;
#ifndef ONLY
#define ONLY 0
#endif
#ifndef REP_MASK
#define REP_MASK 0
#endif
#define REPS(K) (((REP_MASK >> (K)) & 1) ? 2 : 1)
#define PHASE_BEGIN if (lo <= ph && ph < hi) { const int tz_ = opaque_tid(); const int lane = tz_ & 63, wave = uni(tz_ >> 6), gw = vcu * NWAVES + wave; (void)lane; (void)gw;
#define PHASE_END   if (ph + 1 < hi) xcd_barrier(bar, opaque_tid() == 0); } ++ph;
#define GEMM(kind, id) pg8::gemm_phase<kind, false>(lds, lds + XLDS_OFF, gph + (id), gpt, G, opaque_bx(), ws, wave_sgpr_)
#define GEMM8(kind, id) pg8::gemm_phase<kind, true>(lds, lds + XLDS_OFF, gph + (id), gpt, G, opaque_bx(), ws, wave_sgpr_)

    PHASE_BEGIN if (ONLY == 0 || ONLY == 1) for (int rep_ = 0; rep_ < REPS(1); ++rep_) { prologue(args, lds, gw, NGW, wave, lane); } PHASE_END
    PHASE_BEGIN if (ONLY == 0 || ONLY == 2 || ONLY == 13) for (int rep_ = 0; rep_ < REPS(2); ++rep_) { GEMM(EPI_BF16, GPH_PRO); } PHASE_END
    PHASE_BEGIN if (ONLY == 0 || ONLY == 2 || ONLY == 13) for (int rep_ = 0; rep_ < REPS(2); ++rep_) { GEMM(EPI_BF16, GPH_PRO2); } PHASE_END
#pragma unroll 1
    for (int L = 0; L < 4; ++L) {
        const int j = L >> 1;
        if ((L & 1) == 0) {
            PHASE_BEGIN if (ONLY == 0 || ONLY == 2) for (int rep_ = 0; rep_ < REPS(2); ++rep_) { GEMM(EPI_BF16, L * 9 + 0); } PHASE_END
            PHASE_BEGIN if (ONLY == 0 || ONLY == 3) for (int rep_ = 0; rep_ < REPS(3); ++rep_) { even_phase_a(args, lds, j, G, wave_sgpr_); } PHASE_END
            PHASE_BEGIN if (ONLY == 0 || ONLY == 4) even_phase_b(args, G, wave_sgpr_); PHASE_END
            PHASE_BEGIN if (ONLY == 0 || ONLY == 5) for (int rep_ = 0; rep_ < REPS(5); ++rep_) { even_phase_c(args, lds, j, G, wave_sgpr_); } PHASE_END
            PHASE_BEGIN if (ONLY == 0 || ONLY == 2) for (int rep_ = 0; rep_ < REPS(16); ++rep_) { GEMM(EPI_RESID, L * 9 + 2); } PHASE_END
            PHASE_BEGIN if (ONLY == 0 || ONLY == 6) for (int rep_ = 0; rep_ < REPS(6); ++rep_) { ln_phase(args, lds, L, 0, 0, false, gw, NGW, wave, lane); } PHASE_END
        } else {
            PHASE_BEGIN if (ONLY == 0 || ONLY == 7) for (int rep_ = 0; rep_ < REPS(7); ++rep_) { odd_shiftmix(args, j, gw, NGW, lane); } PHASE_END
            PHASE_BEGIN if (ONLY == 0 || ONLY == 2) for (int rep_ = 0; rep_ < REPS(2); ++rep_) { GEMM(EPI_BF16, L * 9 + 0); } PHASE_END
            PHASE_BEGIN if (ONLY == 0 || ONLY == 2) for (int rep_ = 0; rep_ < REPS(2); ++rep_) { GEMM(EPI_BF16, L * 9 + 1); } PHASE_END
#if !SCAN_CHUNKED
            PHASE_BEGIN if (ONLY == 0 || ONLY == 8) for (int rep_ = 0; rep_ < REPS(8); ++rep_) { odd_prep(args, j, gw, NGW, lane); } PHASE_END
#endif
#if SCAN_CHUNKED
            PHASE_BEGIN if (ONLY == 0 || ONLY == 9) for (int rep_ = 0; rep_ < REPS(9); ++rep_) {
                volatile LAS unsigned* st_ = (volatile LAS unsigned*)(lds + MISC_OFF) + 8; unsigned st0_ = 0u, st1_ = 0u;
                if (tid == 0) { st0_ = st_[0]; st1_ = st_[1]; }
                __syncthreads();
                odd_prepm(args, lds, j, gw, NGW, wave, lane);
                __syncthreads();
                if (tid == 0) { st_[0] = st0_; st_[1] = st1_; } } PHASE_END
            PHASE_BEGIN if (ONLY == 0 || ONLY == 9) for (int rep_ = 0; rep_ < REPS(19); ++rep_) { odd_scanc(args, lds, wave, lane); } PHASE_END
#else
            PHASE_BEGIN if (ONLY == 0 || ONLY == 9) for (int rep_ = 0; rep_ < REPS(9); ++rep_) { odd_scan(args, lds, G, wave, lane, rep_ == 1); } PHASE_END
#endif
            PHASE_BEGIN if (ONLY == 0 || ONLY == 10) for (int rep_ = 0; rep_ < REPS(10); ++rep_) { odd_post(args, j, gw, NGW, lane); } PHASE_END
            PHASE_BEGIN if (ONLY == 0 || ONLY == 2) for (int rep_ = 0; rep_ < REPS(16); ++rep_) { GEMM(EPI_RESID, L * 9 + 2); } PHASE_END
            PHASE_BEGIN if (ONLY == 0 || ONLY == 6) for (int rep_ = 0; rep_ < REPS(6); ++rep_) { ln_phase(args, lds, L, 0, 0, false, gw, NGW, wave, lane); } PHASE_END
        }
        PHASE_BEGIN if (ONLY == 0 || ONLY == 2) for (int rep_ = 0; rep_ < REPS(17); ++rep_) { GEMM(EPI_SOFTMAX, L * 9 + 3); } PHASE_END
        PHASE_BEGIN if (ONLY == 0 || ONLY == 2) for (int rep_ = 0; rep_ < REPS(16); ++rep_) { GEMM(EPI_RESID, L * 9 + 6); } PHASE_END
        PHASE_BEGIN if (ONLY == 0 || ONLY == 6) for (int rep_ = 0; rep_ < REPS(6); ++rep_) { ln_phase(args, lds, L, 1, 1, false, gw, NGW, wave, lane); } PHASE_END
        PHASE_BEGIN if (ONLY == 0 || ONLY == 11) for (int rep_ = 0; rep_ < REPS(11); ++rep_) { moe_topk(args, lds, L, G, wave_sgpr_); } PHASE_END
#if !MOE_GATHER_FUSED
        PHASE_BEGIN if (ONLY == 0 || ONLY == 12) for (int rep_ = 0; rep_ < REPS(12); ++rep_) { moe_gather(args, gw, NGW, lane); } PHASE_END
#endif
        PHASE_BEGIN if (ONLY == 0 || ONLY == 2 || ONLY == 14) for (int rep_ = 0; rep_ < REPS(18); ++rep_) { if (MOE_FP8) GEMM8(EPI_SWIGLU, L * 9 + 7); else GEMM(EPI_SWIGLU, L * 9 + 7); } PHASE_END
        PHASE_BEGIN if (ONLY == 0 || ONLY == 2 || ONLY == 15) for (int rep_ = 0; rep_ < REPS(18); ++rep_) { if (MOE_FP8) GEMM8(EPI_ROWSCALE, L * 9 + 8); else GEMM(EPI_ROWSCALE, L * 9 + 8); } PHASE_END
        PHASE_BEGIN if (ONLY == 0 || ONLY == 6) ln_phase(args, lds, L, 2, 2, L == 3, gw, NGW, wave, lane); PHASE_END
    }
}

extern "C" void kernel_launch(void* const* d_in, const int* in_sizes, int n_in, void* d_out, int out_size, void* d_ws, size_t ws_size, hipStream_t stream) {
    static int grid = 0;
    if (grid == 0) {
        if (n_in != 33 || out_size != NTOK * D || ws_size < WS_END) { fprintf(stderr, "kernel_launch: unexpected shapes (n_in %d out %d ws %zu need %zu)\n", n_in, out_size, ws_size, (size_t)WS_END); grid = -1; return; }
        int dev = 0, cus = 0, per_cu = 0;
        if (hipGetDevice(&dev) != hipSuccess || hipDeviceGetAttribute(&cus, hipDeviceAttributeMultiprocessorCount, dev) != hipSuccess) { grid = -1; return; }
        if (hipFuncSetAttribute((const void*)enc_fwd, hipFuncAttributeMaxDynamicSharedMemorySize, LDS_BYTES) != hipSuccess) { fprintf(stderr, "kernel_launch: hipFuncSetAttribute failed\n"); grid = -1; return; }
        if (hipOccupancyMaxActiveBlocksPerMultiprocessor(&per_cu, (const void*)enc_fwd, NWAVES * 64, LDS_BYTES) != hipSuccess || per_cu < 1) fprintf(stderr, "kernel_launch: occupancy query says %d\n", per_cu);
        (void)hipGetLastError();
        grid = cus;
        if (grid != 256) fprintf(stderr, "kernel_launch: %d CUs (built for 256)\n", grid);
    }
    if (grid < 0) return;
    if (hipMemsetAsync((char*)d_ws + WS_CTL, 0, CTL_ZERO_BYTES, stream) != hipSuccess) return;
    Args a{};
    for (int i = 0; i < 33; ++i) a.in[i] = (const float*)d_in[i];
    a.out = (float*)d_out; a.ws = (unsigned char*)d_ws;
#if MK_PER_PHASE
    for (int p = 0; p < N_PHASES; ++p) { a.ph_lo = p; a.ph_hi = p + 1; hipLaunchKernelGGL(enc_fwd, dim3(grid), dim3(NWAVES * 64), LDS_BYTES, stream, a); }
#else
    a.ph_lo = 0; a.ph_hi = N_PHASES;
    hipLaunchKernelGGL(enc_fwd, dim3(grid), dim3(NWAVES * 64), LDS_BYTES, stream, a);
#endif
}
```

```cpp
#include <hip/hip_runtime.h>
#include <cstdio>
#include <cstdint>

#ifndef MOE_FP8
#define MOE_FP8 1
#endif
#ifndef RESID_BF16
#define RESID_BF16 1
#endif
#ifndef Z_BF16
#define Z_BF16 1
#endif
#ifndef SCAN_CHUNKED
#define SCAN_CHUNKED 1
#endif
#ifndef MOE_GATHER_FUSED
#define MOE_GATHER_FUSED 1
#endif
#ifndef MK_PER_PHASE
#define MK_PER_PHASE 0
#endif

#define GAS __attribute__((address_space(1)))
#define LAS __attribute__((address_space(3)))
typedef unsigned short bf16;
typedef unsigned char uchar;
typedef unsigned u32x4 __attribute__((ext_vector_type(4)));
typedef int i32x4 __attribute__((ext_vector_type(4)));
typedef unsigned u32x2 __attribute__((ext_vector_type(2)));
typedef float f32x4 __attribute__((ext_vector_type(4)));
typedef float f32x2 __attribute__((ext_vector_type(2)));
typedef short bf16x8 __attribute__((ext_vector_type(8)));
typedef int v4i_t __attribute__((ext_vector_type(4)));
typedef int v8i_t __attribute__((ext_vector_type(8)));

constexpr int D = 1024, NP = 16384, NS = 32768, NTOK = NP + NS;
constexpr int NSEQ = 20, NCHUNK = NTOK / 64;
constexpr int DIN = 4608;
constexpr int NSLOT = 2 * NTOK;
constexpr float DN_ALPHA = 1.6817928305074292f;
constexpr float LN_EPS = 1e-5f;
constexpr int NWAVES = 8;

constexpr size_t MiB = 1u << 20;
constexpr size_t WS_CTL = 0, CTL_ZERO_BYTES = 1 * MiB;
constexpr size_t WS_GPH = 1 * MiB;
constexpr size_t WS_GPT = 1 * MiB + 65536;
constexpr size_t WS_ROT = 2 * MiB;
constexpr size_t WS_W_EIN = 4 * MiB;
constexpr size_t SZ_W_EIN = (size_t)2 * DIN * D * 2;
constexpr size_t WS_W_EOUT = WS_W_EIN + SZ_W_EIN;
constexpr size_t WS_W_RKV = WS_W_EOUT + (size_t)2 * D * D * 2;
constexpr size_t WS_W_L1 = WS_W_RKV + (size_t)6 * D * D * 2;
constexpr size_t WS_W_L2W = WS_W_L1 + (size_t)6 * 256 * D * 2;
constexpr size_t WS_W_L2A = WS_W_L2W + (size_t)2 * 2048 * 256 * 2;
constexpr size_t WS_W_L2G = WS_W_L2A + (size_t)2 * 2048 * 256 * 2;
constexpr size_t WS_W_OOUT = WS_W_L2G + (size_t)2 * 1024 * 256 * 2;
constexpr size_t WS_W_CQ = WS_W_OOUT + (size_t)2 * D * D * 2;
constexpr size_t WS_W_CKV = WS_W_CQ + (size_t)4 * D * D * 2;
constexpr size_t WS_W_CO = WS_W_CKV + (size_t)4 * 2048 * D * 2;
constexpr size_t WS_W_MIN = WS_W_CO + (size_t)4 * D * D * 2;
constexpr size_t WS_W_MOUT = WS_W_MIN + (size_t)64 * 4096 * D * 2;
constexpr size_t WS_MEMB = WS_W_MOUT + (size_t)64 * D * 2048 * 2;
constexpr size_t WS_KMEM = WS_MEMB + (size_t)5120 * D * 2;
constexpr size_t WS_VT = WS_KMEM + (size_t)4 * 5120 * D * 2;
constexpr size_t WS_X32 = WS_VT + (size_t)4 * 20 * 1024 * 256 * 2;
constexpr size_t WS_Z32 = WS_X32 + (size_t)NTOK * D * 4;
constexpr size_t WS_XB = WS_Z32 + (size_t)NTOK * D * 4;
constexpr size_t WS_AFF = WS_XB + (size_t)NTOK * D * 2;
constexpr size_t WS_IDX = WS_AFF + (size_t)16 * NTOK * 4;
constexpr size_t WS_GATE = WS_IDX + (size_t)NSLOT * 4;
constexpr size_t WS_INV = WS_GATE + (size_t)NSLOT * 4;
constexpr size_t WS_ARENA = WS_INV + (size_t)NTOK * 16 * 4;
static_assert(MOE_FP8 == 1 && RESID_BF16 == 1, "the folded cross-attention operands live in the halves of the MoE weight regions that fp8 leaves free and in the unused f32 residual buffer");
constexpr size_t WS_MQ = WS_W_MIN + (size_t)64 * 4096 * D;
constexpr size_t WS_WQN = WS_W_MOUT + (size_t)64 * D * 2048;
constexpr size_t WS_VW = WS_X32;
constexpr size_t WS_VMEM = WS_VT;
constexpr size_t AR_PROJ = WS_ARENA;
constexpr size_t AR_ST = AR_PROJ + (size_t)NTOK * DIN * 2;
constexpr size_t AR_DEC = AR_ST + (size_t)4 * NCHUNK * 4 * 16384 * 4;
constexpr size_t AR_OME = AR_DEC + (size_t)4 * NCHUNK * 4 * 128 * 4;
constexpr size_t AR_EVEN_END = AR_OME + (size_t)NTOK * D * 2;
constexpr size_t AR_XM = WS_ARENA;
constexpr size_t AR_H1 = AR_XM + (size_t)6 * NTOK * D * 2;
constexpr size_t AR_SCN = WS_ARENA;
constexpr size_t AR_RKV = AR_SCN + (size_t)NTOK * 16 * 1280;
constexpr size_t AR_LW = AR_RKV + (size_t)2 * NTOK * D * 2;
constexpr size_t AR_LA = AR_LW + (size_t)NTOK * 2048 * 2;
constexpr size_t AR_V = AR_LA + (size_t)NTOK * 2048 * 2;
constexpr size_t AR_GG = AR_V + (size_t)NTOK * D * 2;
constexpr size_t AR_YF = AR_GG + (size_t)NTOK * D * 2;
constexpr size_t AR_YB = AR_YF + (size_t)NTOK * D * 2;
constexpr size_t AR_CB = AR_YB + (size_t)NTOK * D * 2;
constexpr size_t AR_OMO = AR_CB + (size_t)NTOK * 16 * 4;
constexpr size_t CH_KK = 0, CH_RR = 2048, CH_NBT = 4096, CH_KT = 6144, CH_MAT = 8192, CH_G = 10240, CH_REC = 10496;
constexpr size_t AR_CH0 = AR_OMO + (size_t)NTOK * D * 2;
constexpr size_t AR_CH1 = AR_SCN;
constexpr size_t CH_BYTES = (size_t)(NTOK / 16) * 16 * CH_REC;
static_assert(AR_CH1 + CH_BYTES <= AR_RKV, "direction-1 chunk records fit in the SCN area");
constexpr size_t AR_ODD_END = AR_CH0 + CH_BYTES;
static_assert(AR_ODD_END < ((size_t)1 << 32), "32-bit buffer offsets");
static_assert(AR_H1 + (size_t)NTOK * 768 * 2 <= AR_RKV, "XM+H1 inside the SCN overlay region");
constexpr size_t AR_Q = WS_ARENA;
constexpr size_t AR_P = AR_Q + (size_t)NTOK * D * 2;
constexpr size_t AR_O = AR_P + (size_t)NTOK * D * 2;
constexpr size_t AR_XE = WS_ARENA;
constexpr size_t AR_HACT = AR_XE + (size_t)NSLOT * D * 2;
constexpr size_t AR_YE = AR_HACT + (size_t)NSLOT * 2048 * 2;
constexpr size_t AR_MOE_END = AR_YE + (size_t)NSLOT * D * 2;
constexpr size_t WS_END = AR_ODD_END > AR_EVEN_END ? (AR_ODD_END > AR_MOE_END ? AR_ODD_END : AR_MOE_END) : (AR_EVEN_END > AR_MOE_END ? AR_EVEN_END : AR_MOE_END);

constexpr int CW_BAR = 4096;

constexpr int RING_BYTES = 131072;
constexpr int XLDS_OFF = RING_BYTES;
constexpr int MISC_OFF = RING_BYTES + 8192;
constexpr int LDS_BYTES = 163840;

__device__ __forceinline__ float bf2f(unsigned short b) { return __uint_as_float(((unsigned)b) << 16); }
__device__ __forceinline__ float bflo(unsigned w) { return __uint_as_float(w << 16); }
__device__ __forceinline__ float bfhi(unsigned w) { return __uint_as_float(w & 0xffff0000u); }
__device__ __forceinline__ unsigned f2bf(float f) { unsigned u = __float_as_uint(f); return (u + 0x7fffu + ((u >> 16) & 1u)) >> 16; }
__device__ __forceinline__ unsigned short f2bf_hw(float f) { const f32x2 v = {f, 0.f}; typedef __bf16 bfx2_ __attribute__((ext_vector_type(2))); const bfx2_ b = __builtin_convertvector(v, bfx2_); return (unsigned short)__builtin_bit_cast(unsigned, b); }
typedef __bf16 bf16x2_t __attribute__((ext_vector_type(2)));
__device__ __forceinline__ unsigned pk2(float lo, float hi) { const f32x2 v = {lo, hi}; const bf16x2_t b = __builtin_convertvector(v, bf16x2_t); return __builtin_bit_cast(unsigned, b); }
__device__ __forceinline__ unsigned pk4_fp8(float a, float b, float c, float d) { int r = __builtin_amdgcn_cvt_pk_fp8_f32(a, b, 0, false); r = __builtin_amdgcn_cvt_pk_fp8_f32(c, d, r, true); return (unsigned)r; }
__device__ __forceinline__ int uni(int v) { return __builtin_amdgcn_readfirstlane(v); }
__device__ __forceinline__ int lane_id_hw() { return (int)__builtin_amdgcn_mbcnt_hi(~0u, __builtin_amdgcn_mbcnt_lo(~0u, 0u)); }
#define opaque_tid() opaque_tid_(wave_sgpr_)
__device__ __forceinline__ int opaque_tid_(int wave_s) { int l; asm volatile("v_mbcnt_lo_u32_b32 %0, -1, 0\n\tv_mbcnt_hi_u32_b32 %0, -1, %0" : "=v"(l)); return wave_s * 64 + l; }
__device__ __forceinline__ int opaque_bx() { int b = blockIdx.x; asm volatile("" : "+s"(b)); return b; }
__device__ __forceinline__ unsigned char* opaque_ptr(unsigned char* p) { GAS unsigned char* g = (GAS unsigned char*)p; asm volatile("" : "+s"(g)); return (unsigned char*)g; }
template <class T> __device__ __forceinline__ T* uniptr(T* p) { unsigned long long v = (unsigned long long)p; unsigned lo = (unsigned)uni((int)(unsigned)v), hi = (unsigned)uni((int)(unsigned)(v >> 32)); return (T*)(((unsigned long long)hi << 32) | lo); }
typedef unsigned u32x2v_ __attribute__((ext_vector_type(2)));
#ifndef SAFE_SHFL
#define SAFE_SHFL 1
#endif
#if SAFE_SHFL
__device__ __forceinline__ float shx(float v, int o, int lane) { return __builtin_bit_cast(float, __builtin_amdgcn_ds_bpermute((lane ^ o) << 2, __builtin_bit_cast(int, v))); }
#define xor16_sum(v) xor16_sum_((v), lane)
#define xor32_sum(v) xor32_sum_((v), lane)
#define xor16_max(v) xor16_max_((v), lane)
#define xor32_max(v) xor32_max_((v), lane)
#define wave_sum(v) wave_sum_((v), lane)
__device__ __forceinline__ float xor16_sum_(float v, int lane) { return v + shx(v, 16, lane); }
__device__ __forceinline__ float xor32_sum_(float v, int lane) { return v + shx(v, 32, lane); }
__device__ __forceinline__ float xor16_max_(float v, int lane) { return fmaxf(v, shx(v, 16, lane)); }
__device__ __forceinline__ float xor32_max_(float v, int lane) { return fmaxf(v, shx(v, 32, lane)); }
__device__ __forceinline__ float wave_sum_(float v, int lane) {
#pragma unroll
    for (int o = 1; o < 64; o <<= 1) v += shx(v, o, lane);
    return v;
}
#else
__device__ __forceinline__ float xor16_sum(float v) { const unsigned x = __builtin_bit_cast(unsigned, v); const u32x2v_ r = __builtin_amdgcn_permlane16_swap(x, x, false, false); return __builtin_bit_cast(float, r.x) + __builtin_bit_cast(float, r.y); }
__device__ __forceinline__ float xor32_sum(float v) { const unsigned x = __builtin_bit_cast(unsigned, v); const u32x2v_ r = __builtin_amdgcn_permlane32_swap(x, x, false, false); return __builtin_bit_cast(float, r.x) + __builtin_bit_cast(float, r.y); }
__device__ __forceinline__ float xor16_max(float v) { const unsigned x = __builtin_bit_cast(unsigned, v); const u32x2v_ r = __builtin_amdgcn_permlane16_swap(x, x, false, false); return fmaxf(__builtin_bit_cast(float, r.x), __builtin_bit_cast(float, r.y)); }
__device__ __forceinline__ float xor32_max(float v) { const unsigned x = __builtin_bit_cast(unsigned, v); const u32x2v_ r = __builtin_amdgcn_permlane32_swap(x, x, false, false); return fmaxf(__builtin_bit_cast(float, r.x), __builtin_bit_cast(float, r.y)); }
__device__ __forceinline__ float wave_sum(float v) {
    v += __builtin_bit_cast(float, __builtin_amdgcn_mov_dpp(__builtin_bit_cast(int, v), 0xB1, 0xF, 0xF, true));
    v += __builtin_bit_cast(float, __builtin_amdgcn_mov_dpp(__builtin_bit_cast(int, v), 0x4E, 0xF, 0xF, true));
    v += __builtin_bit_cast(float, __builtin_amdgcn_mov_dpp(__builtin_bit_cast(int, v), 0x141, 0xF, 0xF, true));
    v += __builtin_bit_cast(float, __builtin_amdgcn_mov_dpp(__builtin_bit_cast(int, v), 0x140, 0xF, 0xF, true));
    return xor32_sum(xor16_sum(v));
}
#endif
__device__ __forceinline__ float quad_sum(float v) {
    v += __builtin_bit_cast(float, __builtin_amdgcn_mov_dpp(__builtin_bit_cast(int, v), 0xB1, 0xF, 0xF, true));
    v += __builtin_bit_cast(float, __builtin_amdgcn_mov_dpp(__builtin_bit_cast(int, v), 0x4E, 0xF, 0xF, true));
    return v;
}
__device__ __forceinline__ float exp_(float x) { return __builtin_amdgcn_exp2f(x * 1.4426950408889634f); }
__device__ __forceinline__ float log_(float x) { return __builtin_amdgcn_logf(x) * 0.6931471805599453f; }
__device__ __forceinline__ float sigmoidf_(float x) { return __builtin_amdgcn_rcpf(1.f + exp_(-x)); }
__device__ __forceinline__ float siluf_(float x) { return x * __builtin_amdgcn_rcpf(1.f + exp_(-x)); }
__device__ __forceinline__ float tanhf_(float x) { return 1.f - 2.f * __builtin_amdgcn_rcpf(exp_(2.f * x) + 1.f); }
#define LDS_WAIT() asm volatile("s_waitcnt lgkmcnt(0)" ::: "memory")
#define VM_WAIT() asm volatile("s_waitcnt vmcnt(0)" ::: "memory")

__device__ __forceinline__ int row_pos(int r) { return r < NP ? (r & 4095) : ((r - NP) & 2047); }
__device__ __forceinline__ int row_T(int r) { return r < NP ? 4096 : 2048; }
__device__ __forceinline__ int seq_row0(int s) { return s < 4 ? s * 4096 : NP + (s - 4) * 2048; }
__device__ __forceinline__ int seq_T(int s) { return s < 4 ? 4096 : 2048; }

#define XB_TMO      128
#define XB_XCNT(j)  (256  + 64 * (j))
#define XB_XSUB(j)  (1280 + 64 * (j))
#define XB_XGEN(j)  (2304 + 64 * (j))
#define XB_TOP      3328
#define XB_TOPGEN   3392
#define XCD_BAR_WORDS 3456
#define XB_SPIN_CAP (1u << 22)

__device__ __forceinline__ unsigned xb_ld(unsigned* p)              { return __hip_atomic_load(p, __ATOMIC_RELAXED, __HIP_MEMORY_SCOPE_AGENT); }
__device__ __forceinline__ unsigned xb_add(unsigned* p, unsigned v) { return __hip_atomic_fetch_add(p, v, __ATOMIC_RELAXED, __HIP_MEMORY_SCOPE_AGENT); }
__device__ __forceinline__ unsigned xb_xcc_id() { return (unsigned)__builtin_amdgcn_s_getreg((3 << 11) | 20) & 0xFu; }
#define XB_SPIN(cond, bar) do { unsigned _sp = 0; while (cond) { __builtin_amdgcn_s_sleep(1); \
    if ((++_sp & 255u) == 0u) { if (xb_ld(&(bar)[XB_TMO])) break; if (_sp > XB_SPIN_CAP) { atomicAdd(&(bar)[XB_TMO], 1u); break; } } } } while (0)

struct XcdBarrier { unsigned* bar; unsigned x; volatile LAS unsigned* st; };

__device__ __forceinline__ XcdBarrier xcd_barrier_post(unsigned* bar, volatile LAS unsigned* st) {
    XcdBarrier b; b.bar = bar; b.x = xb_xcc_id(); b.st = st;
    if (threadIdx.x == 0) (void)xb_add(&bar[XB_XCNT(b.x)], 1u);
    return b;
}
__device__ __forceinline__ void xcd_barrier_complete(unsigned* bar, unsigned x, unsigned& nloc, unsigned& nx) {
    const unsigned G = gridDim.x * gridDim.y * gridDim.z;
    unsigned sum, cnt, mine, sp = 0u;
    for (;;) {
        sum = 0u; cnt = 0u; mine = 0u;
#pragma unroll
        for (unsigned j = 0; j < 16; ++j) { const unsigned c = xb_ld(&bar[XB_XCNT(j)]); sum += c; cnt += (c > 0u) ? 1u : 0u; mine = (j == x) ? c : mine; }
        if (sum == G) break;
        __builtin_amdgcn_s_sleep(1);
        if ((++sp & 255u) == 0u) { if (xb_ld(&bar[XB_TMO])) break; if (sp > XB_SPIN_CAP) { atomicAdd(&bar[XB_TMO], 1u); break; } }
    }
    nloc = mine > 0u ? mine : 1u; nx = cnt > 0u ? cnt : 1u;
}
__device__ __forceinline__ void xcd_barrier(const XcdBarrier& b, bool is_t0) {
    asm volatile("s_waitcnt vmcnt(0)" ::: "memory");
    __syncthreads();
    if (is_t0) {
        GAS unsigned* barg_ = (GAS unsigned*)b.bar; asm volatile("" : "+s"(barg_)); unsigned* bar = (unsigned*)barg_;
        __builtin_amdgcn_s_waitcnt(0);
        unsigned nloc = b.st[0], nx = b.st[1];
        if (nloc == 0u) { xcd_barrier_complete(bar, b.x, nloc, nx); b.st[0] = nloc; b.st[1] = nx; }
        const unsigned old = xb_add(&bar[XB_XSUB(b.x)], 1u);
        const unsigned gen = old / nloc;
        if (old + 1u == (gen + 1u) * nloc) {
            __builtin_amdgcn_fence(__ATOMIC_RELEASE, "agent");
            asm volatile("s_waitcnt vmcnt(0)" ::: "memory");
            const unsigned og = xb_add(&bar[XB_TOP], 1u);
            const unsigned tg = og / nx;
            if (og + 1u == (tg + 1u) * nx) xb_add(&bar[XB_TOPGEN], 1u);
            else XB_SPIN(xb_ld(&bar[XB_TOPGEN]) == tg, bar);
            __builtin_amdgcn_fence(__ATOMIC_ACQUIRE, "agent");
            xb_add(&bar[XB_XGEN(b.x)], 1u);
            asm volatile("s_waitcnt vmcnt(0)" ::: "memory");
        } else {
            XB_SPIN(xb_ld(&bar[XB_XGEN(b.x)]) == gen, bar);
            __builtin_amdgcn_fence(__ATOMIC_ACQUIRE, "agent");
            asm volatile("s_waitcnt vmcnt(0)" ::: "memory");
        }
    }
    __syncthreads();
}

enum { EPI_BF16 = 0, EPI_RESID = 1, EPI_SWIGLU = 2, EPI_ROWSCALE = 3, EPI_SOFTMAX = 4 };
struct GP { const bf16* A; const bf16* B; void* C; const void* aux; int mt, nt, ustart, ldc, epi; float scale; int pad0, pad1; };
struct GPhase { int first, count, K, lda, ldb, total, cntA, szA, szB, pad0, pad1, pad2, pad3, pad4, pad5, pad6; };
static_assert(sizeof(GP) == 64 && sizeof(GPhase) == 64, "table layout");

namespace pg8 {
constexpr int BM = 256, BK = 64, HALF = 128, HTB = HALF * BK * 2, STAGE_BYTES = 8 * HTB, NXCD = 8, WGM = 16;
__host__ __device__ __forceinline__ int lds_byte(int r, int c) { const int st = (r >> 4) * 2 + (c >> 5), rr = r & 15, cc = c & 31, ob = rr * 64 + cc * 2; return st * 1024 + (ob ^ (((ob >> 9) & 1) << 5)); }
__host__ __device__ __forceinline__ void stage_rc(int b, int& R, int& C) { const int st = b / 1024, sb = b % 1024, swz = sb ^ (((sb >> 9) & 1) << 5); R = (st >> 1) * 16 + swz / 64; C = (st & 1) * 32 + (swz % 64) / 2; }
__host__ __device__ __forceinline__ int perm32(int rho) { const int n = rho >> 4, i = rho & 15; return 8 * (i >> 2) + 4 * n + (i & 3); }
struct Unit { int pm, pn, p; };
#define CAS __attribute__((address_space(4)))
__device__ __forceinline__ int cld32(const void* p) { return *(const CAS int*)p; }
__device__ __forceinline__ unsigned long long cld64(const void* p) { return *(const CAS unsigned long long*)p; }

struct TableOrder {
    const GP* tab; int nprob, total, G, c, cntA, szA, szB;
    __device__ __forceinline__ bool next(int i, Unit& u) const {
        const long L = (long)i * G + c; if (L >= total) return false;
        const int La = cntA * szA; int p, l;
        if ((int)L < La) { p = (int)L / szA; l = (int)L - p * szA; } else { const int q_ = ((int)L - La) / szB; p = cntA + q_; l = (int)L - La - q_ * szB; }
        const int nM = cld32(&tab[p].mt), nN = cld32(&tab[p].nt), nwg = nM * nN;
        int wgid = l; { const int q = nwg / NXCD, r = nwg % NXCD, xcd = wgid % NXCD, off = wgid / NXCD; wgid = (xcd < r ? xcd * (q + 1) : r * (q + 1) + (xcd - r) * q) + off; }
        const int nig = WGM * nN, gid = wgid / nig, fm = gid * WGM, gsz = (nM - fm) < WGM ? (nM - fm) : WGM;
        u.pm = fm + ((wgid % nig) % gsz); u.pn = (wgid % nig) / gsz; u.p = p; return true;
    }
};

template <int KIND, bool FP8> __device__ __forceinline__ void epilogue(const GP* Pp, f32x4 (&acc)[2][2][4][2], const Unit& u, int wr, int wc, int fr, int fq, LAS uchar* xlds) {
    const int epi = cld32(&Pp->epi), kind = KIND, act = epi >> 8, ldc = cld32(&Pp->ldc);
    const int row0 = u.pm * BM + wr * 64 + fr, colL = wc * 32 + 8 * fq, lane = fq * 16 + fr; (void)lane;
    if constexpr (KIND == EPI_BF16) {
        GAS bf16* C = (GAS bf16*)cld64(&Pp->C);
#pragma unroll
        for (int ai = 0; ai < 2; ++ai)
#pragma unroll
            for (int m = 0; m < 4; ++m) { GAS bf16* rowp = C + (size_t)(row0 + ai * HALF + m * 16) * ldc + u.pn * BM + colL;
#pragma unroll
                for (int bj = 0; bj < 2; ++bj) { f32x4 v0 = acc[ai][bj][m][0], v1 = acc[ai][bj][m][1];
                    if (act == 1) {
#pragma unroll
                        for (int j = 0; j < 4; ++j) { v0[j] = tanhf_(v0[j]); v1[j] = tanhf_(v1[j]); } }
                    else if (act == 2) {
#pragma unroll
                        for (int j = 0; j < 4; ++j) { v0[j] = sigmoidf_(v0[j]); v1[j] = sigmoidf_(v1[j]); } }
                    u32x4 w; w.x = pk2(v0[0], v0[1]); w.y = pk2(v0[2], v0[3]); w.z = pk2(v1[0], v1[1]); w.w = pk2(v1[2], v1[3]);
                    *(GAS u32x4*)(rowp + bj * HALF) = w; } }
    } else if constexpr (KIND == EPI_RESID) {
        GAS float* Z = (GAS float*)cld64(&Pp->C);
#if RESID_BF16
        const GAS bf16* X = (const GAS bf16*)cld64(&Pp->aux);
        u32x4 xwa[2][4][2];
#pragma unroll
        for (int ai = 0; ai < 2; ++ai)
#pragma unroll
            for (int m = 0; m < 4; ++m) { const size_t off = (size_t)(row0 + ai * HALF + m * 16) * ldc + u.pn * BM + colL;
#pragma unroll
                for (int bj = 0; bj < 2; ++bj) xwa[ai][m][bj] = *(const GAS u32x4*)(X + off + bj * HALF); }
#pragma unroll
        for (int ai = 0; ai < 2; ++ai)
#pragma unroll
            for (int m = 0; m < 4; ++m) { const size_t off = (size_t)(row0 + ai * HALF + m * 16) * ldc + u.pn * BM + colL;
#pragma unroll
                for (int bj = 0; bj < 2; ++bj) { const u32x4 xw = xwa[ai][m][bj];
                    const f32x4 x0 = (f32x4){bflo(xw.x), bfhi(xw.x), bflo(xw.y), bfhi(xw.y)}, x1 = (f32x4){bflo(xw.z), bfhi(xw.z), bflo(xw.w), bfhi(xw.w)};
                    const f32x4 z0 = x0 * DN_ALPHA + acc[ai][bj][m][0], z1 = x1 * DN_ALPHA + acc[ai][bj][m][1];
#if Z_BF16
                    u32x4 zw; zw.x = pk2(z0[0], z0[1]); zw.y = pk2(z0[2], z0[3]); zw.z = pk2(z1[0], z1[1]); zw.w = pk2(z1[2], z1[3]);
                    *(GAS u32x4*)((GAS bf16*)Z + off + bj * HALF) = zw;
#else
                    *(GAS f32x4*)(Z + off + bj * HALF) = z0; *(GAS f32x4*)(Z + off + bj * HALF + 4) = z1;
#endif
                    } }
#else
        const GAS float* X = (const GAS float*)cld64(&Pp->aux);
#pragma unroll
        for (int ai = 0; ai < 2; ++ai)
#pragma unroll
            for (int m = 0; m < 4; ++m) { const size_t off = (size_t)(row0 + ai * HALF + m * 16) * ldc + u.pn * BM + colL;
#pragma unroll
                for (int bj = 0; bj < 2; ++bj)
#pragma unroll
                    for (int n = 0; n < 2; ++n) { const f32x4 x = *(const GAS f32x4*)(X + off + bj * HALF + 4 * n); *(GAS f32x4*)(Z + off + bj * HALF + 4 * n) = x * DN_ALPHA + acc[ai][bj][m][n]; } }
#endif
    } else if constexpr (KIND == EPI_SWIGLU) {
        if constexpr (FP8) {
            GAS uchar* C = (GAS uchar*)cld64(&Pp->C);
#pragma unroll
            for (int ai = 0; ai < 2; ++ai)
#pragma unroll
                for (int m = 0; m < 4; ++m) { GAS uchar* rowp = C + (size_t)(row0 + ai * HALF + m * 16) * ldc + u.pn * HALF + colL;
                    float h[8];
#pragma unroll
                    for (int n = 0; n < 2; ++n)
#pragma unroll
                        for (int p = 0; p < 2; ++p) {
                            const f32x2 g2 = (f32x2){acc[ai][0][m][n][2 * p], acc[ai][0][m][n][2 * p + 1]}, u2 = (f32x2){acc[ai][1][m][n][2 * p], acc[ai][1][m][n][2 * p + 1]};
                            const f32x2 ea = g2 * (-1.4426950408889634f / 32.f);
                            f32x2 e2; e2.x = __builtin_amdgcn_exp2f(ea.x); e2.y = __builtin_amdgcn_exp2f(ea.y);
                            const f32x2 a2 = e2 + 1.f;
                            f32x2 r2; r2.x = __builtin_amdgcn_rcpf(a2.x); r2.y = __builtin_amdgcn_rcpf(a2.y);
                            f32x2 h2 = (g2 * u2) * r2; h2 = h2 * (1.f / 128.f);
                            asm volatile("" : "+v"(h2));
                            h[4 * n + 2 * p] = h2.x; h[4 * n + 2 * p + 1] = h2.y; }
                    u32x2 w; w.x = pk4_fp8(h[0], h[1], h[2], h[3]); w.y = pk4_fp8(h[4], h[5], h[6], h[7]);
                    *(GAS u32x2*)rowp = w; }
        } else {
        GAS bf16* C = (GAS bf16*)cld64(&Pp->C);
#pragma unroll
        for (int ai = 0; ai < 2; ++ai)
#pragma unroll
            for (int m = 0; m < 4; ++m) { GAS bf16* rowp = C + (size_t)(row0 + ai * HALF + m * 16) * ldc + u.pn * HALF + colL;
                f32x4 h0, h1;
#pragma unroll
                for (int j = 0; j < 4; ++j) { h0[j] = siluf_(acc[ai][0][m][0][j]) * acc[ai][1][m][0][j]; h1[j] = siluf_(acc[ai][0][m][1][j]) * acc[ai][1][m][1][j]; }
                u32x4 w; w.x = pk2(h0[0], h0[1]); w.y = pk2(h0[2], h0[3]); w.z = pk2(h1[0], h1[1]); w.w = pk2(h1[2], h1[3]);
                *(GAS u32x4*)rowp = w; }
        }
    } else if constexpr (KIND == EPI_ROWSCALE) {
        GAS bf16* C = (GAS bf16*)cld64(&Pp->C); const GAS float* gate = (const GAS float*)cld64(&Pp->aux);
        float ga[2][4];
#pragma unroll
        for (int ai = 0; ai < 2; ++ai)
#pragma unroll
            for (int m = 0; m < 4; ++m) ga[ai][m] = gate[row0 + ai * HALF + m * 16];
#pragma unroll
        for (int ai = 0; ai < 2; ++ai)
#pragma unroll
            for (int m = 0; m < 4; ++m) { const int row = row0 + ai * HALF + m * 16; const float g = ga[ai][m] * (FP8 ? (1.0f / 1024.0f) : 1.0f); GAS bf16* rowp = C + (size_t)row * ldc + u.pn * BM + colL;
#pragma unroll
                for (int bj = 0; bj < 2; ++bj) { const f32x4 v0 = acc[ai][bj][m][0] * g, v1 = acc[ai][bj][m][1] * g;
                    u32x4 w; w.x = pk2(v0[0], v0[1]); w.y = pk2(v0[2], v0[3]); w.z = pk2(v1[0], v1[1]); w.w = pk2(v1[2], v1[3]);
                    *(GAS u32x4*)(rowp + bj * HALF) = w; } }
    } else {
        GAS bf16* C = (GAS bf16*)cld64(&Pp->C);
        const float sc = __uint_as_float((unsigned)cld32(&Pp->scale)) * 1.4426950408889634f;
        LAS f32x2* SMX = (LAS f32x2*)xlds;
        float mloc[2][4];
#pragma unroll
        for (int ai = 0; ai < 2; ++ai)
#pragma unroll
            for (int m = 0; m < 4; ++m) {
                float mx = -3.0e38f;
#pragma unroll
                for (int bj = 0; bj < 2; ++bj)
#pragma unroll
                    for (int n = 0; n < 2; ++n)
#pragma unroll
                        for (int j = 0; j < 4; ++j) mx = fmaxf(mx, acc[ai][bj][m][n][j]);
                mx = xor32_max(xor16_max(mx));
                const float nmx = -mx * sc;
                float s = 0.f;
#pragma unroll
                for (int bj = 0; bj < 2; ++bj)
#pragma unroll
                    for (int n = 0; n < 2; ++n)
#pragma unroll
                        for (int j = 0; j < 4; ++j) { const float e = __builtin_amdgcn_exp2f(__builtin_fmaf(acc[ai][bj][m][n][j], sc, nmx)); acc[ai][bj][m][n][j] = e; s += e; }
                s = xor32_sum(xor16_sum(s));
                mloc[ai][m] = mx;
                if (fq == 0) SMX[(ai * HALF + wr * 64 + m * 16 + fr) * 4 + wc] = (f32x2){mx, s};
            }
        LDS_WAIT(); __builtin_amdgcn_s_barrier(); asm volatile("" ::: "memory");
#pragma unroll
        for (int ai = 0; ai < 2; ++ai)
#pragma unroll
            for (int m = 0; m < 4; ++m) {
                const int rt = ai * HALF + wr * 64 + m * 16 + fr;
                const f32x2 a = SMX[rt * 4 + 0], b = SMX[rt * 4 + 1], c = SMX[rt * 4 + 2], d = SMX[rt * 4 + 3];
                const float M = fmaxf(fmaxf(a.x, b.x), fmaxf(c.x, d.x));
                const float tot = a.y * __builtin_amdgcn_exp2f((a.x - M) * sc) + b.y * __builtin_amdgcn_exp2f((b.x - M) * sc) + c.y * __builtin_amdgcn_exp2f((c.x - M) * sc) + d.y * __builtin_amdgcn_exp2f((d.x - M) * sc);
                const float f = __builtin_amdgcn_exp2f((mloc[ai][m] - M) * sc) * __builtin_amdgcn_rcpf(tot);
                GAS bf16* rowp = C + (size_t)(row0 + ai * HALF + m * 16) * ldc + u.pn * BM + colL;
#pragma unroll
                for (int bj = 0; bj < 2; ++bj) { const f32x4 v0 = acc[ai][bj][m][0] * f, v1 = acc[ai][bj][m][1] * f;
                    u32x4 w; w.x = pk2(v0[0], v0[1]); w.y = pk2(v0[2], v0[3]); w.z = pk2(v1[0], v1[1]); w.w = pk2(v1[2], v1[3]);
                    *(GAS u32x4*)(rowp + bj * HALF) = w; }
            }
        LDS_WAIT(); __builtin_amdgcn_s_barrier(); asm volatile("" ::: "memory");
    }
}

template <int KIND, bool FP8 = false> __device__ __forceinline__ void gemm_phase(LAS uchar* lds, LAS uchar* xlds, const GPhase* php, const GP* tab_all, int G, int c, const unsigned char* wsb, int wave_sgpr_) {
    const int tid = opaque_tid(), wid = uni(tid >> 6), lane = tid & 63, wr = wid >> 2, wc = wid & 3, fr = lane & 15, fq = lane >> 4;
    const int K = uni(php->K), lda = uni(php->lda), ldb = uni(php->ldb), nt = K / 128;
    TableOrder S; S.tab = tab_all + uni(php->first); S.nprob = uni(php->count); S.total = uni(php->total); S.G = G; S.c = c; S.cntA = uni(php->cntA); S.szA = uni(php->szA); S.szB = uni(php->szB);
    constexpr bool GATH = MOE_GATHER_FUSED && FP8 && KIND == EPI_SWIGLU;
    unsigned voffA[2], voffB[2], voffA1[2], nvP0 = 0u, nvP1 = 0u;
#pragma unroll
    for (int i = 0; i < 2; ++i) { int R, C; stage_rc(tid * 16 + i * 8192, R, C); const int Rb = (R & ~31) + perm32(R & 31);
        voffA[i] = (unsigned)(R * lda + C * 2); voffB[i] = (unsigned)(Rb * ldb + C * 2); voffA1[i] = voffA[i]; }
    const __amdgpu_buffer_rsrc_t rsrc = __builtin_amdgcn_make_buffer_rsrc((void*)wsb, 0, 0xffffffff, 0x00020000);
    const unsigned kstep = (unsigned)(BK * 2);
    const unsigned hstepA = (unsigned)HALF * lda, hstepB = (unsigned)HALF * ldb;
    const unsigned tstepA = 2 * hstepA, tstepB = 2 * hstepB;
    const unsigned ldsw = (unsigned)wid * 1024u;
    const int aoff = lds_byte(wr * 64 + fr, fq * 8), boff = lds_byte(wc * 32 + fr, fq * 8);
#define PG8_SA(b, h) (((b) * 2 + (h)) * HTB)
#define PG8_SB(b, h) ((4 + (b) * 2 + (h)) * HTB)
#ifndef USE_BUFLD
#define USE_BUFLD 1
#endif
#if USE_BUFLD
#define PG8_STAGE(bufoff, gbase, voff) do { _Pragma("unroll") for (int _i = 0; _i < 2; ++_i) \
        __builtin_amdgcn_raw_ptr_buffer_load_lds(rsrc, (LAS void*)(lds + (bufoff) + ldsw + _i * 8192), 16, (int)(voff)[_i], (int)(gbase), 0, 0); } while (0)
#else
#define PG8_STAGE(bufoff, gbase, voff) do { _Pragma("unroll") for (int _i = 0; _i < 2; ++_i) \
        __builtin_amdgcn_global_load_lds((const unsigned*)((const char*)wsb + (size_t)(gbase) + (voff)[_i]), (LAS unsigned*)(lds + (bufoff) + ldsw + _i * 8192), 16, 0, 0); } while (0)
#endif
#define PG8_LD8(ptr_) __builtin_shufflevector(*(const LAS v4i_t*)(ptr_), *(const LAS v4i_t*)((ptr_) + 1024), 0, 1, 2, 3, 4, 5, 6, 7)
#define PG8_LDA(dst, b, h) do { _Pragma("unroll") for (int m = 0; m < 4; ++m) { if constexpr (FP8) dst##8[m] = PG8_LD8(lds + PG8_SA(b, h) + aoff + m * 2048); \
        else { _Pragma("unroll") for (int k = 0; k < 2; ++k) dst[m][k] = *(const LAS bf16x8*)(lds + PG8_SA(b, h) + aoff + m * 2048 + k * 1024); } } } while (0)
#define PG8_LDB(dst, b, h) do { _Pragma("unroll") for (int n = 0; n < 2; ++n) { if constexpr (FP8) dst##8[n] = PG8_LD8(lds + PG8_SB(b, h) + boff + n * 2048); \
        else { _Pragma("unroll") for (int k = 0; k < 2; ++k) dst[n][k] = *(const LAS bf16x8*)(lds + PG8_SB(b, h) + boff + n * 2048 + k * 1024); } } } while (0)
#define PG8_MMA(ai, bj, At, Bt) do { __builtin_amdgcn_s_setprio(1); _Pragma("unroll") for (int m = 0; m < 4; ++m) _Pragma("unroll") for (int n = 0; n < 2; ++n) { \
        if constexpr (FP8) acc[ai][bj][m][n] = __builtin_amdgcn_mfma_scale_f32_16x16x128_f8f6f4(Bt##8[n], At##8[m], acc[ai][bj][m][n], 0, 0, 0, 0, 0, 0); \
        else { _Pragma("unroll") for (int k = 0; k < 2; ++k) acc[ai][bj][m][n] = __builtin_amdgcn_mfma_f32_16x16x32_bf16(Bt[n][k], At[m][k], acc[ai][bj][m][n], 0, 0, 0); } } \
        __builtin_amdgcn_s_setprio(0); } while (0)
#define PG8_WAIT_V(n) asm volatile("s_waitcnt vmcnt(" #n ")" ::: "memory")
#define PG8_WAIT_L(n) asm volatile("s_waitcnt lgkmcnt(" #n ")" ::: "memory")
#define PG8_BAR __builtin_amdgcn_s_barrier()
#define PG8_SCHED __builtin_amdgcn_sched_barrier(0)
    Unit cur, nxt; int ui = 0;
    if (!S.next(0, cur)) return;
    f32x4 acc[2][2][4][2];
#pragma unroll
    for (int a = 0; a < 2; ++a)
#pragma unroll
        for (int b = 0; b < 2; ++b)
#pragma unroll
            for (int m = 0; m < 4; ++m)
#pragma unroll
                for (int n = 0; n < 2; ++n) acc[a][b][m][n] = (f32x4){0.f, 0.f, 0.f, 0.f};
    bf16x8 At[4][2], B0[2][2], B1[2][2]; v8i_t At8[4], B08[2], B18[2]; (void)At; (void)B0; (void)B1; (void)At8; (void)B08; (void)B18;
#define PG8_OFF(p_) ((unsigned)(cld64(&(p_)) - (unsigned long long)wsb))
    const unsigned hsA = GATH ? 0u : hstepA;
#define PG8_GATHP(u_, p0_, p1_) do { const GAS int* ip_ = (const GAS int*)cld64(&S.tab[(u_).p].aux) + (u_).pm * 256; const int tz_ = opaque_tid(); int Ra_, Rb_, C_; \
        stage_rc(tz_ * 16, Ra_, C_); stage_rc(tz_ * 16 + 8192, Rb_, C_); \
        (p0_) = (unsigned)ip_[Ra_] | ((unsigned)ip_[Rb_] << 16); (p1_) = (unsigned)ip_[128 + Ra_] | ((unsigned)ip_[128 + Rb_] << 16); } while (0)
#define PG8_EXPAND(p0_, p1_) do { voffA[0] = (((p0_) & 0xffffu) << 10) | (voffA[0] & 1023u); voffA[1] = (((p0_) >> 16) << 10) | (voffA[1] & 1023u); \
        voffA1[0] = (((p1_) & 0xffffu) << 10) | (voffA1[0] & 1023u); voffA1[1] = (((p1_) >> 16) << 10) | (voffA1[1] & 1023u); } while (0)
    static_assert(!MOE_GATHER_FUSED || NTOK <= 65536, "16-bit row ids");
    if constexpr (GATH) { PG8_GATHP(cur, nvP0, nvP1); PG8_EXPAND(nvP0, nvP1); }
    unsigned cA = PG8_OFF(S.tab[cur.p].A) + (GATH ? 0u : (unsigned)cur.pm * tstepA), cB = PG8_OFF(S.tab[cur.p].B) + (unsigned)cur.pn * tstepB;
    PG8_STAGE(PG8_SB(0, 0), cB, voffB); PG8_STAGE(PG8_SB(0, 1), cB + hstepB, voffB); PG8_STAGE(PG8_SA(0, 0), cA, voffA); PG8_STAGE(PG8_SA(0, 1), cA + hsA, voffA1);
    if (wr == 1) PG8_BAR;
    PG8_WAIT_V(2); PG8_BAR;
    PG8_STAGE(PG8_SB(1, 0), cB + kstep, voffB); PG8_STAGE(PG8_SA(1, 0), cA + kstep, voffA); PG8_STAGE(PG8_SB(1, 1), cB + hstepB + kstep, voffB);
    PG8_WAIT_V(6); PG8_BAR;
    for (;;) {
        const bool has_next = S.next(ui + 1, nxt);
        if constexpr (GATH) {
            if (has_next && wid == 0) __builtin_amdgcn_raw_ptr_buffer_load_lds(rsrc, (LAS void*)xlds, 16, (int)(lane * 16), (int)(PG8_OFF(S.tab[nxt.p].aux) + (unsigned)nxt.pm * 1024u), 0, 0); }
        const unsigned nA = has_next ? PG8_OFF(S.tab[nxt.p].A) + (GATH ? 0u : (unsigned)nxt.pm * tstepA) : cA, nB = has_next ? PG8_OFF(S.tab[nxt.p].B) + (unsigned)nxt.pn * tstepB : cB;
        for (int t = 0; t < nt; t += 2) {
            const bool last = (t == nt - 2);
            const unsigned a1 = cA + (unsigned)(t + 1) * kstep;
            const unsigned a2 = last ? nA : cA + (unsigned)(t + 2) * kstep, b2 = last ? nB : cB + (unsigned)(t + 2) * kstep;
            const unsigned a3 = a2 + kstep, b3 = b2 + kstep;
            PG8_LDB(B0, 0, 0); PG8_LDB(B1, 0, 1); PG8_SCHED; PG8_LDA(At, 0, 0); PG8_STAGE(PG8_SA(1, 1), a1 + hsA, voffA1);
            if constexpr (GATH) { if (last && has_next) {
                const LAS int* il_ = (const LAS int*)xlds; const int tz_ = opaque_tid(); int Ra_, Rb_, C_; stage_rc(tz_ * 16, Ra_, C_); stage_rc(tz_ * 16 + 8192, Rb_, C_);
                nvP0 = (unsigned)il_[Ra_] | ((unsigned)il_[Rb_] << 16); nvP1 = (unsigned)il_[128 + Ra_] | ((unsigned)il_[128 + Rb_] << 16);
                PG8_EXPAND(nvP0, nvP1); } }
            PG8_WAIT_V(8); PG8_WAIT_L(0); PG8_BAR; PG8_MMA(0, 0, At, B0); PG8_MMA(0, 1, At, B1); PG8_BAR; PG8_SCHED;
            PG8_LDA(At, 0, 1); PG8_STAGE(PG8_SB(0, 0), b2, voffB); PG8_STAGE(PG8_SB(0, 1), b2 + hstepB, voffB); PG8_STAGE(PG8_SA(0, 0), a2, voffA);
            PG8_WAIT_V(8); PG8_WAIT_L(0); PG8_BAR; PG8_MMA(1, 0, At, B0); PG8_MMA(1, 1, At, B1); PG8_BAR; PG8_SCHED;
            PG8_LDB(B0, 1, 0); PG8_LDB(B1, 1, 1); PG8_SCHED; PG8_LDA(At, 1, 0); PG8_STAGE(PG8_SA(0, 1), a2 + hsA, voffA1);
            PG8_WAIT_V(8); PG8_WAIT_L(0); PG8_BAR; PG8_MMA(0, 0, At, B0); PG8_MMA(0, 1, At, B1); PG8_BAR; PG8_SCHED;
            PG8_LDA(At, 1, 1); PG8_STAGE(PG8_SB(1, 0), b3, voffB); PG8_STAGE(PG8_SB(1, 1), b3 + hstepB, voffB); PG8_STAGE(PG8_SA(1, 0), a3, voffA);
            PG8_WAIT_V(8); PG8_WAIT_L(0); PG8_BAR; PG8_MMA(1, 0, At, B0); PG8_MMA(1, 1, At, B1); PG8_BAR; PG8_SCHED;
        }
        if (wr == 0) PG8_BAR;
        { const int tz2 = opaque_tid(), wid2 = uni(tz2 >> 6), lane2 = tz2 & 63;
          epilogue<KIND, FP8>(S.tab + cur.p, acc, cur, wid2 >> 2, wid2 & 3, lane2 & 15, lane2 >> 4, xlds); }
        if (!has_next) break;
#pragma unroll
        for (int a = 0; a < 2; ++a)
#pragma unroll
            for (int b = 0; b < 2; ++b)
#pragma unroll
                for (int m = 0; m < 4; ++m)
#pragma unroll
                    for (int n = 0; n < 2; ++n) acc[a][b][m][n] = (f32x4){0.f, 0.f, 0.f, 0.f};
        cur = nxt; cA = nA; cB = nB; ++ui;
        if (wr == 1) PG8_BAR;
    }
    PG8_WAIT_V(0);
    PG8_BAR;
#undef PG8_OFF
#undef PG8_GATHP
#undef PG8_EXPAND
#undef PG8_SA
#undef PG8_SB
#undef PG8_STAGE
#undef PG8_LDA
#undef PG8_LDB
#undef PG8_MMA
#undef PG8_WAIT_V
#undef PG8_WAIT_L
#undef PG8_BAR
#undef PG8_SCHED
}
}

struct Args { const float* in[33]; float* out; unsigned char* ws; int ph_lo, ph_hi; };
enum { I_XP = 0, I_XS, I_MP, I_MS, I_EWIN, I_ELB, I_ENA, I_ENB, I_EWOUT, I_OMU, I_ORKV, I_OW0, I_OW1, I_OW2, I_OA0, I_OA1, I_OA2, I_OG1, I_OG2, I_OKK, I_OKA, I_ORK, I_OLNW, I_OLNB, I_OWOUT,
       I_CWQ, I_CWKV, I_CWO, I_MR, I_MWIN, I_MWOUT, I_LNW, I_LNB };

constexpr int GPH_PRO = 36, GPH_PRO2 = 37;

__device__ __forceinline__ void transpose_load(f32x4 (&rg)[8], const float* W, int ldw, int k0, int n0, int lane) {
#pragma unroll
    for (int i = 0; i < 8; ++i) rg[i] = *(const f32x4*)(W + (size_t)(k0 + 8 * i + (lane >> 3)) * ldw + n0 + 4 * (lane & 7));
}
__device__ __forceinline__ void transpose_finish(const f32x4 (&rg)[8], bf16* dst, int ldd, float fp8scale, LAS float* scr, int lane) {
#pragma unroll
    for (int i = 0; i < 8; ++i) { LAS float* p = scr + (8 * i + (lane >> 3)) * 33 + 4 * (lane & 7); p[0] = rg[i].x; p[1] = rg[i].y; p[2] = rg[i].z; p[3] = rg[i].w; }
    LDS_WAIT(); asm volatile("" ::: "memory");
    const int c = lane & 7;
#pragma unroll
    for (int j = 0; j < 4; ++j) { const int n = (lane >> 3) + 8 * j; const LAS float* sp = scr + (8 * c) * 33 + n;
        if (fp8scale != 0.f) {
            u32x2 o; o.x = pk4_fp8(sp[0 * 33] * fp8scale, sp[1 * 33] * fp8scale, sp[2 * 33] * fp8scale, sp[3 * 33] * fp8scale); o.y = pk4_fp8(sp[4 * 33] * fp8scale, sp[5 * 33] * fp8scale, sp[6 * 33] * fp8scale, sp[7 * 33] * fp8scale);
            *(u32x2*)((uchar*)dst + (size_t)n * ldd + 8 * c) = o;
        } else {
            u32x4 o; o.x = pk2(sp[0 * 33], sp[1 * 33]); o.y = pk2(sp[2 * 33], sp[3 * 33]); o.z = pk2(sp[4 * 33], sp[5 * 33]); o.w = pk2(sp[6 * 33], sp[7 * 33]);
            *(u32x4*)(dst + (size_t)n * ldd + 8 * c) = o; } }
    LDS_WAIT(); asm volatile("" ::: "memory");
}
__device__ __forceinline__ void transpose_batch(const float* src, size_t sstride, int nb, int K, int ldw, int ncols, bf16* dst, size_t dstride, int ldd, int dk0, int mode, LAS float* scr, int gw, int NGW, int lane, float fp8scale = 0.f) {
    const int kb_n = K / 64, nb_n = ncols / 32, per = kb_n * nb_n, total = nb * per;
    f32x4 nxt[8];
#pragma unroll
    for (int i = 0; i < 8; ++i) nxt[i] = (f32x4){0.f, 0.f, 0.f, 0.f};
#define TB_DECODE(it_) const int b = (it_) / per, r = (it_) % per, kb = r / nb_n, nbk = r % nb_n, n0 = nbk * 32, k0 = kb * 64
    if (gw < total) { TB_DECODE(gw); transpose_load(nxt, src + (size_t)b * sstride, ldw, k0, n0, lane); }
    for (int it = gw; it < total; it += NGW) {
        f32x4 cur[8];
#pragma unroll
        for (int i = 0; i < 8; ++i) cur[i] = nxt[i];
        if (it + NGW < total) { TB_DECODE(it + NGW); transpose_load(nxt, src + (size_t)b * sstride, ldw, k0, n0, lane); }
        TB_DECODE(it);
        int drow = n0;
        if (mode == 1) drow = (n0 < 2048) ? ((n0 >> 7) * 256 + (n0 & 127)) : ((((n0 - 2048) >> 7) * 256) + 128 + ((n0 - 2048) & 127));
        if (fp8scale != 0.f) transpose_finish(cur, (bf16*)((uchar*)dst + (size_t)b * dstride + (size_t)drow * ldd + dk0 + k0), ldd, fp8scale, scr, lane);
        else transpose_finish(cur, dst + (size_t)b * dstride + (size_t)drow * ldd + dk0 + k0, ldd, 0.f, scr, lane);
    }
#undef TB_DECODE
}
__device__ __forceinline__ void transpose_batch_r(const float* src, size_t sstride, int nb, int K, int ldw, int ncols, bf16* dst, size_t dstride, int ldd, int dk0, int mode, LAS float* scr, int gw, int NGW, int lane, int& rot) {
    const int total = nb * (K / 64) * (ncols / 32);
    transpose_batch(src, sstride, nb, K, ldw, ncols, dst, dstride, ldd, dk0, mode, scr, (gw + NGW - rot % NGW) % NGW, NGW, lane);
    rot += total;
}
__device__ __forceinline__ void sincos_acc(float angf, float& c, float& s) {
    const double a = (double)angf;
    const double q = __builtin_rint(a * 0.63661977236758134308);
    const double r = (a - q * 1.57079632679489655800) - q * 6.123233995736766036e-17;
    const double r2 = r * r;
    double sp = r * (1.0 + r2 * (-1.0 / 6 + r2 * (1.0 / 120 + r2 * (-1.0 / 5040 + r2 * (1.0 / 362880 + r2 * (-1.0 / 39916800 + r2 * (1.0 / 6227020800.0)))))));
    double cp = 1.0 + r2 * (-0.5 + r2 * (1.0 / 24 + r2 * (-1.0 / 720 + r2 * (1.0 / 40320 + r2 * (-1.0 / 3628800 + r2 * (1.0 / 479001600.0 + r2 * (-1.0 / 87178291200.0)))))));
    const int qi = ((int)q) & 3;
    double ss = (qi == 0) ? sp : (qi == 1) ? cp : (qi == 2) ? -sp : -cp;
    double cc = (qi == 0) ? cp : (qi == 1) ? -sp : (qi == 2) ? -cp : sp;
    c = (float)cc; s = (float)ss;
}

__device__ __forceinline__ void build_tables(const Args& args, int who) {
    unsigned char* ws = opaque_ptr(args.ws);
    GPhase* gph = (GPhase*)(ws + WS_GPH); GP* gpt = (GP*)(ws + WS_GPT);
    auto put = [&](int idx, const void* A, const void* B, void* C, const void* aux, int mt, int nt, int ustart, int ldc, int epi, float scale) {
        GP g; g.A = (const bf16*)A; g.B = (const bf16*)B; g.C = C; g.aux = aux; g.mt = mt; g.nt = nt; g.ustart = ustart; g.ldc = ldc; g.epi = epi; g.scale = scale; g.pad0 = 0; g.pad1 = 0; gpt[idx] = g; };
    auto phase = [&](int id, int first, int count, int K, int lda, int ldb, int total, int cntA, int szA, int szB) { GPhase p; p.first = first; p.count = count; p.K = K; p.lda = lda; p.ldb = ldb; p.total = total; p.cntA = cntA; p.szA = szA; p.szB = szB;
        p.pad0 = p.pad1 = p.pad2 = p.pad3 = p.pad4 = p.pad5 = p.pad6 = 0; gph[id] = p; };
    bf16* XB = (bf16*)(ws + WS_XB); float* X32 = (float*)(ws + WS_X32); float* Z32 = (float*)(ws + WS_Z32);
    if (who < 4) {
        const int L = who, j = L >> 1; int e = 256 * L;
        if ((L & 1) == 0) {
            phase(L * 9 + 0, e, 1, 2 * 1024, 2 * 1024, 2 * 1024, 192 * 18, 1, 192 * 18, 1);
            put(e, XB, ws + WS_W_EIN + (size_t)j * DIN * D * 2, ws + AR_PROJ, nullptr, 192, 18, 0, DIN, EPI_BF16, 0.f); e += 1;
            phase(L * 9 + 1, e, 0, 2 * 256, 2 * 256, 2 * 256, 0, 0, 1, 1);
            phase(L * 9 + 2, e, 1, 2 * 1024, 2 * 1024, 2 * 1024, 192 * 4, 1, 768, 1);
            put(e, ws + AR_OME, ws + WS_W_EOUT + (size_t)j * D * D * 2, Z32, RESID_BF16 ? (void*)XB : (void*)X32, 192, 4, 0, D, EPI_RESID, 0.f); e += 1;
        } else {
            phase(L * 9 + 0, e, 6, 2 * 1024, 2 * 1024, 2 * 1024, 3 * 192 * 4 + 3 * 192, 3, 768, 192);
            int us = 0;
            for (int p = 0; p < 3; ++p) { put(e + p, ws + AR_XM + (size_t)p * NTOK * D * 2, ws + WS_W_RKV + (size_t)(j * 3 + p) * D * D * 2, ws + (p == 2 ? AR_V : AR_RKV + (size_t)p * NTOK * D * 2), nullptr, 192, 4, us, D, EPI_BF16, 0.f); us += 768; }
            for (int p = 0; p < 3; ++p) { put(e + 3 + p, ws + AR_XM + (size_t)(3 + p) * NTOK * D * 2, ws + WS_W_L1 + (size_t)(j * 3 + p) * 256 * D * 2, ws + AR_H1 + (size_t)p * 256 * 2, nullptr, 192, 1, us, 768, EPI_BF16 | ((p == 0 ? 1 : p == 2 ? 2 : 0) << 8), 0.f); us += 192; }
            e += 6;
            phase(L * 9 + 1, e, 3, 2 * 256, 2 * 768, 2 * 256, 192 * 8 + 192 * 8 + 192 * 4, 2, 1536, 768);
            put(e + 0, ws + AR_H1 + 0, ws + WS_W_L2W + (size_t)j * 2048 * 256 * 2, ws + AR_LW, nullptr, 192, 8, 0, 2048, EPI_BF16, 0.f);
            put(e + 1, ws + AR_H1 + 256 * 2, ws + WS_W_L2A + (size_t)j * 2048 * 256 * 2, ws + AR_LA, nullptr, 192, 8, 192 * 8, 2048, EPI_BF16, 0.f);
            put(e + 2, ws + AR_H1 + 512 * 2, ws + WS_W_L2G + (size_t)j * 1024 * 256 * 2, ws + AR_GG, nullptr, 192, 4, 192 * 16, D, EPI_BF16, 0.f);
            e += 3;
            phase(L * 9 + 2, e, 1, 2 * 1024, 2 * 1024, 2 * 1024, 192 * 4, 1, 768, 1);
            put(e, ws + AR_OMO, ws + WS_W_OOUT + (size_t)j * D * D * 2, Z32, RESID_BF16 ? (void*)XB : (void*)X32, 192, 4, 0, D, EPI_RESID, 0.f); e += 1;
        }
        phase(L * 9 + 3, e, 80, 2 * 1024, 2 * 1024, 2 * 1024, 768, 16, 16, 8);
        { int us = 0; for (int s = 0; s < NSEQ; ++s) for (int h = 0; h < 4; ++h) { const int r0 = s < 4 ? s * 4096 : NP + (s - 4) * 2048, mt = (s < 4 ? 4096 : 2048) / 256;
            put(e, XB + (size_t)r0 * D, ws + WS_MQ + ((((size_t)L * 20 + s) * 4 + h) * 256 * 1024) * 2, ws + AR_P + ((size_t)r0 * D + h * 256) * 2, nullptr, mt, 1, us, D, EPI_SOFTMAX, 0.0625f); us += mt; ++e; } }
        phase(L * 9 + 4, e, 0, 2 * 256, 2 * 256, 2 * 256, 0, 0, 1, 1);
        phase(L * 9 + 5, e, 0, 2 * 256, 2 * 256, 2 * 256, 0, 0, 1, 1);
        phase(L * 9 + 6, e, 20, 2 * 1024, 2 * 1024, 2 * 1024, 768, 4, 64, 32);
        { int us = 0; for (int s = 0; s < NSEQ; ++s) { const int r0 = s < 4 ? s * 4096 : NP + (s - 4) * 2048, mt = (s < 4 ? 4096 : 2048) / 256;
            put(e, ws + AR_P + (size_t)r0 * D * 2, ws + WS_VW + (((size_t)L * 20 + s) * 1024 * 1024) * 2, (unsigned char*)Z32 + (size_t)r0 * D * (Z_BF16 ? 2 : 4), XB + (size_t)r0 * D, mt, 4, us, D, EPI_RESID, 0.f); us += mt * 4; ++e; } }
        phase(L * 9 + 7, e, 32, MOE_FP8 ? 1024 : 2048, MOE_FP8 ? 1024 : 2048, MOE_FP8 ? 1024 : 2048, 384 * 16, 16, 128, 256);
        { int us = 0; for (int g = 0; g < 2; ++g) for (int x = 0; x < 16; ++x) { const int sb = g ? NP * 2 + x * 4096 : x * 2048, mt = g ? 16 : 8;
            put(e, ws + AR_XE + (MOE_GATHER_FUSED ? 0 : (size_t)sb * D * (MOE_FP8 ? 1 : 2)), ws + WS_W_MIN + ((size_t)(L * 16 + x) * 4096 * D) * (MOE_FP8 ? 1 : 2), ws + AR_HACT + (size_t)sb * 2048 * (MOE_FP8 ? 1 : 2), MOE_GATHER_FUSED ? (const void*)(ws + WS_IDX + (size_t)sb * 4) : nullptr, mt, 16, us, 2048, EPI_SWIGLU, 0.f); us += mt * 16; ++e; } }
        phase(L * 9 + 8, e, 32, MOE_FP8 ? 2048 : 4096, MOE_FP8 ? 2048 : 4096, MOE_FP8 ? 2048 : 4096, 384 * 4, 16, 32, 64);
        { int us = 0; for (int g = 0; g < 2; ++g) for (int x = 0; x < 16; ++x) { const int sb = g ? NP * 2 + x * 4096 : x * 2048, mt = g ? 16 : 8;
            put(e, ws + AR_HACT + (size_t)sb * 2048 * (MOE_FP8 ? 1 : 2), ws + WS_W_MOUT + ((size_t)(L * 16 + x) * D * 2048) * (MOE_FP8 ? 1 : 2), ws + AR_YE + (size_t)sb * D * 2, ws + WS_GATE + (size_t)sb * 4, mt, 4, us, D, EPI_ROWSCALE, 0.f); us += mt * 4; ++e; } }
    } else {
        int e = 1024; int us = 0;
        for (int L = 0; L < 4; ++L) { put(e, ws + WS_MEMB, ws + WS_W_CKV + (size_t)L * 2048 * D * 2, ws + WS_KMEM + (size_t)L * 5120 * D * 2, nullptr, 20, 4, us, D, EPI_BF16, 0.f); us += 80; ++e; }
        for (int L = 0; L < 4; ++L) { put(e, ws + WS_MEMB, ws + WS_W_CKV + ((size_t)L * 2048 + 1024) * D * 2, ws + WS_VMEM + (size_t)L * 5120 * D * 2, nullptr, 20, 4, us, D, EPI_BF16, 0.f); us += 80; ++e; }
        phase(GPH_PRO, 1024, 8, 2 * 1024, 2 * 1024, 2 * 1024, us, 8, 80, 1);
        const int e2 = e; us = 0;
        for (int L = 0; L < 4; ++L) for (int s = 0; s < NSEQ; ++s) for (int h = 0; h < 4; ++h) {
            put(e, ws + WS_KMEM + (((size_t)L * 5120 + s * 256) * D + h * 256) * 2, ws + WS_WQN + ((size_t)L * D * D + h * 256) * 2, ws + WS_MQ + ((((size_t)L * 20 + s) * 4 + h) * 256 * 1024) * 2, nullptr, 1, 4, us, D, EPI_BF16, 0.f); us += 4; ++e; }
        for (int L = 0; L < 4; ++L) for (int s = 0; s < NSEQ; ++s) for (int h = 0; h < 4; ++h) {
            put(e, ws + WS_W_CO + ((size_t)L * D * D + h * 256) * 2, ws + WS_VMEM + (((size_t)L * 5120 + s * 256) * D + h * 256) * 2, ws + WS_VW + ((((size_t)L * 20 + s) * 1024) * 1024 + h * 256) * 2, nullptr, 4, 1, us, D, EPI_BF16, 0.f); us += 4; ++e; }
        phase(GPH_PRO2, e2, 640, 2 * 256, 2 * 1024, 2 * 1024, us, 640, 4, 1);
    }
}

__device__ __forceinline__ void moe_weights(const Args& args, int L, LAS float* scr, int gw, int NGW, int lane) {
    unsigned char* ws = opaque_ptr(args.ws);
    constexpr size_t ESZ = MOE_FP8 ? 1 : 2;
    transpose_batch(args.in[I_MWIN] + (size_t)L * 16 * D * 4096, (size_t)D * 4096, 16, D, 4096, 4096, (bf16*)(ws + WS_W_MIN + (size_t)L * 16 * 4096 * D * ESZ), (size_t)4096 * D, D, 0, 1, scr, gw, NGW, lane, MOE_FP8 ? 32.f : 0.f);
    transpose_batch(args.in[I_MWOUT] + (size_t)L * 16 * 2048 * D, (size_t)2048 * D, 16, 2048, D, D, (bf16*)(ws + WS_W_MOUT + (size_t)L * 16 * D * 2048 * ESZ), (size_t)D * 2048, 2048, 0, 0, scr, gw, NGW, lane, MOE_FP8 ? 128.f : 0.f);
}
__device__ __forceinline__ void prologue(const Args& args, LAS uchar* lds, int gw, int NGW, int wave, int lane) {
    unsigned char* ws = opaque_ptr(args.ws);
    LAS float* scr = (LAS float*)(lds + wave * 16384);
    if (opaque_bx() == 0 && lane == 0 && wave < 5) build_tables(args, wave);
    int rot = 0;
    transpose_batch_r(args.in[I_EWIN], (size_t)D * DIN, 2, D, DIN, DIN, (bf16*)(ws + WS_W_EIN), (size_t)DIN * D, D, 0, 0, scr, gw, NGW, lane, rot);
    transpose_batch_r(args.in[I_EWOUT], (size_t)D * D, 2, D, D, D, (bf16*)(ws + WS_W_EOUT), (size_t)D * D, D, 0, 0, scr, gw, NGW, lane, rot);
    transpose_batch_r(args.in[I_ORKV], (size_t)D * D, 6, D, D, D, (bf16*)(ws + WS_W_RKV), (size_t)D * D, D, 0, 0, scr, gw, NGW, lane, rot);
    for (int j = 0; j < 2; ++j) {
        bf16* l1 = (bf16*)(ws + WS_W_L1) + (size_t)j * 3 * 256 * D;
        transpose_batch_r(args.in[I_OW1] + (size_t)j * 2 * D * 64, (size_t)D * 64, 2, D, 64, 64, l1, (size_t)64 * D, D, 0, 0, scr, gw, NGW, lane, rot);
        transpose_batch_r(args.in[I_OA1] + (size_t)j * 2 * D * 64, (size_t)D * 64, 2, D, 64, 64, l1 + (size_t)256 * D, (size_t)64 * D, D, 0, 0, scr, gw, NGW, lane, rot);
        transpose_batch_r(args.in[I_OG1] + (size_t)j * D * 128, 0, 1, D, 128, 128, l1 + (size_t)512 * D, 0, D, 0, 0, scr, gw, NGW, lane, rot);
        for (int dir = 0; dir < 2; ++dir) {
            transpose_batch_r(args.in[I_OW2] + ((size_t)j * 2 + dir) * 64 * D, 0, 1, 64, D, D, (bf16*)(ws + WS_W_L2W) + ((size_t)j * 2048 + dir * 1024) * 256, 0, 256, dir * 64, 0, scr, gw, NGW, lane, rot);
            transpose_batch_r(args.in[I_OA2] + ((size_t)j * 2 + dir) * 64 * D, 0, 1, 64, D, D, (bf16*)(ws + WS_W_L2A) + ((size_t)j * 2048 + dir * 1024) * 256, 0, 256, dir * 64, 0, scr, gw, NGW, lane, rot);
        }
        transpose_batch_r(args.in[I_OG2] + (size_t)j * 128 * D, 0, 1, 128, D, D, (bf16*)(ws + WS_W_L2G) + (size_t)j * 1024 * 256, 0, 256, 0, 0, scr, gw, NGW, lane, rot);
    }
    transpose_batch_r(args.in[I_OWOUT], (size_t)D * D, 2, D, D, D, (bf16*)(ws + WS_W_OOUT), (size_t)D * D, D, 0, 0, scr, gw, NGW, lane, rot);
    { const float* wq = args.in[I_CWQ]; bf16* wqn = (bf16*)(ws + WS_WQN);
      for (int r = gw; r < 4 * D; r += NGW) { const f32x4* p = (const f32x4*)(wq + (size_t)r * D + 16 * lane); const f32x4 a = p[0], b = p[1], c = p[2], d = p[3];
          u32x4 o0, o1; o0.x = pk2(a.x, a.y); o0.y = pk2(a.z, a.w); o0.z = pk2(b.x, b.y); o0.w = pk2(b.z, b.w); o1.x = pk2(c.x, c.y); o1.y = pk2(c.z, c.w); o1.z = pk2(d.x, d.y); o1.w = pk2(d.z, d.w);
          u32x4* q = (u32x4*)(wqn + (size_t)r * D + 16 * lane); q[0] = o0; q[1] = o1; } }
    transpose_batch_r(args.in[I_CWKV], (size_t)D * 2048, 4, D, 2048, 2048, (bf16*)(ws + WS_W_CKV), (size_t)2048 * D, D, 0, 0, scr, gw, NGW, lane, rot);
    transpose_batch_r(args.in[I_CWO], (size_t)D * D, 4, D, D, D, (bf16*)(ws + WS_W_CO), (size_t)D * D, D, 0, 0, scr, gw, NGW, lane, rot);
    {
        const int gt = gw * 64 + lane, NT = NGW * 64; const u32x4 z = (u32x4){0u, 0u, 0u, 0u};
        for (int i = gt; i < 6 * 128 * 128; i += NT) { const int blk = i / (128 * 128), r = i % (128 * 128); *(u32x4*)((bf16*)(ws + WS_W_L1) + ((size_t)blk * 256 + 128 + r / 128) * D + (r % 128) * 8) = z; }
        for (int i = gt; i < 2 * 2 * 2048 * 32; i += NT) { const int t = i / (2 * 2048 * 32), r = i % (2 * 2048 * 32), n = (r / 32) % 2048, k8 = r % 32, lo = (n >= 1024) ? 8 : 0;
            if (k8 < lo || k8 >= lo + 8) *(u32x4*)((bf16*)(ws + (t ? WS_W_L2A : WS_W_L2W)) + (size_t)(r / 32) * 256 + k8 * 8) = z; }
        for (int i = gt; i < 2 * 1024 * 16; i += NT) { *(u32x4*)((bf16*)(ws + WS_W_L2G) + (size_t)(i / 16) * 256 + 128 + (i % 16) * 8) = z; }
        float2* rot = (float2*)(ws + WS_ROT);
        for (int i = gt; i < 4096 * 64; i += NT) { const int t = i >> 6, k = i & 63; const float xf = (float)k / 63.0f; const float th = (float)(1.0 / exp((double)xf * 9.210340371976184)); const float ang = (float)t * th;
            float c, s; sincos_acc(ang, c, s); rot[i] = make_float2(c, s); }
    }
    {
        float* X32 = (float*)(ws + WS_X32); bf16* XB = (bf16*)(ws + WS_XB); bf16* MB = (bf16*)(ws + WS_MEMB);
        for (int r = gw; r < NTOK; r += NGW) { const float* src = r < NP ? args.in[I_XP] + (size_t)r * D : args.in[I_XS] + (size_t)(r - NP) * D;
#pragma unroll
            for (int jj = 0; jj < 4; ++jj) { const f32x4 v = *((const f32x4*)src + lane + 64 * jj); if (!RESID_BF16) *((f32x4*)(X32 + (size_t)r * D) + lane + 64 * jj) = v;
                u32x2 o; o.x = pk2(v.x, v.y); o.y = pk2(v.z, v.w); *((u32x2*)(XB + (size_t)r * D) + lane + 64 * jj) = o; } }
        for (int r = gw; r < 5120; r += NGW) { const float* src = r < 1024 ? args.in[I_MP] + (size_t)r * D : args.in[I_MS] + (size_t)(r - 1024) * D;
#pragma unroll
            for (int jj = 0; jj < 4; ++jj) { const f32x4 v = *((const f32x4*)src + lane + 64 * jj); u32x2 o; o.x = pk2(v.x, v.y); o.y = pk2(v.z, v.w); *((u32x2*)(MB + (size_t)r * D) + lane + 64 * jj) = o; } }
    }
}

#define LN_COL(jj) ((((jj) >> 1) * 512) + lane * 8 + (((jj) & 1) * 4))
#define LN_UNPK(dst, q_, hh) do { dst[2 * (hh)] = (f32x4){bflo((q_).x), bfhi((q_).x), bflo((q_).y), bfhi((q_).y)}; dst[2 * (hh) + 1] = (f32x4){bflo((q_).z), bfhi((q_).z), bflo((q_).w), bfhi((q_).w)}; } while (0)
#define LN_ACC(dst, q_, hh) do { dst[2 * (hh)].x += bflo((q_).x); dst[2 * (hh)].y += bfhi((q_).x); dst[2 * (hh)].z += bflo((q_).y); dst[2 * (hh)].w += bfhi((q_).y); dst[2 * (hh) + 1].x += bflo((q_).z); dst[2 * (hh) + 1].y += bfhi((q_).z); dst[2 * (hh) + 1].z += bflo((q_).w); dst[2 * (hh) + 1].w += bfhi((q_).w); } while (0)
__device__ __forceinline__ void ln_phase(const Args& args, LAS uchar* lds, int layer, int which, int mode, bool final_out, int gw, int NGW, int wave, int lane) {
    const int wave_sgpr_ = wave;
    unsigned char* ws = opaque_ptr(args.ws);
    float* X32 = (float*)(ws + WS_X32); const float* Z32 = (const float*)(ws + WS_Z32); bf16* XB = (bf16*)(ws + WS_XB);
    const float* lw = args.in[I_LNW] + (size_t)(layer * 3 + which) * D; const float* lb = args.in[I_LNB] + (size_t)(layer * 3 + which) * D;
    LAS float* wrT = (LAS float*)lds;
    if (mode == 1) {
        const float* wr = args.in[I_MR] + (size_t)layer * D * 16;
        for (int i = opaque_tid(); i < D * 16; i += 512) { const int col = i >> 4, jj = ((col >> 9) << 1) + ((col >> 2) & 1), ln_ = (col & 511) >> 3;
            wrT[(i & 15) * 1024 + (jj * 64 + ln_) * 4 + (col & 3)] = wr[i]; }
        __syncthreads();
    }
    f32x4 gw4[4], gb4[4];
#pragma unroll
    for (int j = 0; j < 4; ++j) { gw4[j] = *(const f32x4*)(lw + LN_COL(j)); gb4[j] = *(const f32x4*)(lb + LN_COL(j)); }
    f32x4 nx[4]; int ninv = -1;
#define LN_LOADROW(r_) do { if (mode == 2 && RESID_BF16) { _Pragma("unroll") for (int hh = 0; hh < 2; ++hh) { const u32x4 w_ = *(const u32x4*)(XB + (size_t)(r_) * D + hh * 512 + lane * 8); LN_UNPK(nx, w_, hh); } } \
        else if (Z_BF16 && mode != 2) { _Pragma("unroll") for (int hh = 0; hh < 2; ++hh) { const u32x4 w_ = *(const u32x4*)((const bf16*)Z32 + (size_t)(r_) * D + hh * 512 + lane * 8); LN_UNPK(nx, w_, hh); } } \
        else { const float* src_ = (mode == 2 ? (const float*)X32 : Z32) + (size_t)(r_) * D; _Pragma("unroll") for (int j = 0; j < 4; ++j) nx[j] = *(const f32x4*)(src_ + LN_COL(j)); } \
        if (mode == 2) ninv = ((const int*)(ws + WS_INV))[(size_t)(r_) * 16 + (lane & 15)]; } while (0)
    static_assert(RESID_BF16 == 1, "mode 2 below reads the residual row from XB");
    u32x4 pre[4][2]; unsigned prest = 0u;
#define YE_PREF(rr_, inv_) do { unsigned long long m_ = __builtin_amdgcn_ballot_w64(lane < 16 && (inv_) >= 0); const int g_ = (rr_) >= NP; \
        _Pragma("unroll") for (int p = 0; p < 4; ++p) { \
            if (m_ != 0ull) { const int e_ = __builtin_ctzll(m_); m_ &= m_ - 1ull; const int sl_ = __builtin_amdgcn_readlane((inv_), e_); \
                const bf16* ye_ = (const bf16*)(ws + AR_YE) + (size_t)((g_ ? NP * 2 + e_ * 4096 : e_ * 2048) + sl_) * D; \
                _Pragma("unroll") for (int hh = 0; hh < 2; ++hh) pre[p][hh] = *(const u32x4*)(ye_ + hh * 512 + lane * 8); } \
            else { _Pragma("unroll") for (int hh = 0; hh < 2; ++hh) pre[p][hh] = (u32x4){0u, 0u, 0u, 0u}; } } \
        prest = (unsigned)m_; } while (0)
    int inv1 = -1;
    static_assert(Z_BF16 == 1, "modes 0/1 below prefetch the bf16 pre-LayerNorm rows two iterations ahead");
    u32x4 zq2[2] = {(u32x4){0u, 0u, 0u, 0u}, (u32x4){0u, 0u, 0u, 0u}};
#define LN_LOADQ2(r_) do { _Pragma("unroll") for (int hh = 0; hh < 2; ++hh) zq2[hh] = *(const u32x4*)((const bf16*)Z32 + (size_t)(r_) * D + hh * 512 + lane * 8); } while (0)
    if (gw < NTOK && mode != 2) { const int rn = gw + NGW < NTOK ? gw + NGW : gw; LN_LOADQ2(rn); }
    if (gw < NTOK) { LN_LOADROW(gw);
        if (mode == 2) { if (gw + NGW < NTOK) inv1 = ((const int*)(ws + WS_INV))[(size_t)(gw + NGW) * 16 + (lane & 15)]; YE_PREF(gw, ninv); } }
    for (int r = gw; r < NTOK; r += NGW) {
        f32x4 v[4];
#pragma unroll
        for (int j = 0; j < 4; ++j) v[j] = nx[j];
        if (mode == 2) {
            const int myinv = ninv; const unsigned myrest = prest;
            u32x4 cur[4][2];
#pragma unroll
            for (int p = 0; p < 4; ++p)
#pragma unroll
                for (int hh = 0; hh < 2; ++hh) cur[p][hh] = pre[p][hh];
            if (r + NGW < NTOK) {
#pragma unroll
                for (int hh = 0; hh < 2; ++hh) { const u32x4 w_ = *(const u32x4*)(XB + (size_t)(r + NGW) * D + hh * 512 + lane * 8); LN_UNPK(nx, w_, hh); }
                ninv = inv1; YE_PREF(r + NGW, ninv);
                if (r + 2 * NGW < NTOK) inv1 = ((const int*)(ws + WS_INV))[(size_t)(r + 2 * NGW) * 16 + (lane & 15)];
            }
#pragma unroll
            for (int j = 0; j < 4; ++j) v[j] = v[j] * DN_ALPHA;
#pragma unroll
            for (int p = 0; p < 4; ++p)
#pragma unroll
                for (int hh = 0; hh < 2; ++hh) { const u32x4 w = cur[p][hh]; LN_ACC(v, w, hh); }
            const int g = r >= NP;
            for (unsigned mr = myrest; mr != 0u; mr &= mr - 1u) {
                const int e = __builtin_ctz(mr); const int sl = __builtin_amdgcn_readlane(myinv, e);
                const bf16* ye = (const bf16*)(ws + AR_YE) + (size_t)((g ? NP * 2 + e * 4096 : e * 2048) + sl) * D;
#pragma unroll
                for (int hh = 0; hh < 2; ++hh) { const u32x4 w = *(const u32x4*)(ye + hh * 512 + lane * 8); LN_ACC(v, w, hh); }
            }
        } else {
            LN_UNPK(nx, zq2[0], 0); LN_UNPK(nx, zq2[1], 1);
            { const int rn = r + 2 * NGW < NTOK ? r + 2 * NGW : r; LN_LOADQ2(rn); }
        }
        float s = 0.f;
#pragma unroll
        for (int j = 0; j < 4; ++j) s += (v[j].x + v[j].y) + (v[j].z + v[j].w);
        const float mean = wave_sum(s) * (1.f / D); float s2 = 0.f;
#pragma unroll
        for (int j = 0; j < 4; ++j) { v[j] = v[j] - mean; s2 += (v[j].x * v[j].x + v[j].y * v[j].y) + (v[j].z * v[j].z + v[j].w * v[j].w); }
        const float rstd = 1.f / sqrtf(wave_sum(s2) * (1.f / D) + LN_EPS);
#pragma unroll
        for (int j = 0; j < 4; ++j) v[j] = v[j] * rstd * gw4[j] + gb4[j];
        if (final_out) {
#pragma unroll
            for (int j = 0; j < 4; ++j) *(f32x4*)(args.out + (size_t)r * D + LN_COL(j)) = v[j];
        } else {
#pragma unroll
            for (int hh = 0; hh < 2; ++hh) { if (!RESID_BF16) { *(f32x4*)(X32 + (size_t)r * D + LN_COL(2 * hh)) = v[2 * hh]; *(f32x4*)(X32 + (size_t)r * D + LN_COL(2 * hh + 1)) = v[2 * hh + 1]; }
                u32x4 o; o.x = pk2(v[2 * hh].x, v[2 * hh].y); o.y = pk2(v[2 * hh].z, v[2 * hh].w); o.z = pk2(v[2 * hh + 1].x, v[2 * hh + 1].y); o.w = pk2(v[2 * hh + 1].z, v[2 * hh + 1].w);
                *(u32x4*)(XB + (size_t)r * D + hh * 512 + lane * 8) = o;
                if (MOE_GATHER_FUSED && mode == 1) { u32x2 q; q.x = pk4_fp8(v[2 * hh].x, v[2 * hh].y, v[2 * hh].z, v[2 * hh].w); q.y = pk4_fp8(v[2 * hh + 1].x, v[2 * hh + 1].y, v[2 * hh + 1].z, v[2 * hh + 1].w);
                    *(u32x2*)(ws + AR_XE + (size_t)r * D + hh * 512 + lane * 8) = q; } }
        }
        if (mode == 1) {
            asm volatile("" ::: "memory");
            float pa[16];
#pragma unroll
            for (int e = 0; e < 16; ++e) { float a = 0.f;
#pragma unroll
                for (int j = 0; j < 4; ++j) { const f32x4 w = *((const LAS f32x4*)(wrT + e * 1024) + lane + 64 * j); a += (v[j].x * w.x + v[j].y * w.y) + (v[j].z * w.z + v[j].w * w.w); }
                pa[e] = a; }
            const bool b5 = (lane & 32) != 0, b4 = (lane & 16) != 0, b3 = (lane & 8) != 0, b2 = (lane & 4) != 0;
            float p8[8], p4[4], p2[2];
#pragma unroll
            for (int k = 0; k < 8; ++k) p8[k] = (b5 ? pa[8 + k] : pa[k]) + shx(b5 ? pa[k] : pa[8 + k], 32, lane);
#pragma unroll
            for (int k = 0; k < 4; ++k) p4[k] = (b4 ? p8[4 + k] : p8[k]) + shx(b4 ? p8[k] : p8[4 + k], 16, lane);
#pragma unroll
            for (int k = 0; k < 2; ++k) p2[k] = (b3 ? p4[2 + k] : p4[k]) + shx(b3 ? p4[k] : p4[2 + k], 8, lane);
            float lgv = (b2 ? p2[1] : p2[0]) + shx(b2 ? p2[0] : p2[1], 4, lane);
            lgv += shx(lgv, 2, lane); lgv += shx(lgv, 1, lane);
            float mx = lgv; mx = fmaxf(mx, shx(mx, 4, lane)); mx = fmaxf(mx, shx(mx, 8, lane)); mx = fmaxf(mx, shx(mx, 16, lane)); mx = fmaxf(mx, shx(mx, 32, lane));
            const float ex = exp_(lgv - mx);
            float tot = ex; tot += shx(tot, 4, lane); tot += shx(tot, 8, lane); tot += shx(tot, 16, lane); tot += shx(tot, 32, lane);
            if ((lane & 3) == 0) ((float*)(ws + WS_AFF))[(size_t)(lane >> 2) * NTOK + r] = ex * (1.f / tot);
        }
    }
}

struct CV { float q, k, lf; };
__device__ __forceinline__ CV chanvals(int type, const bf16* prow, int h, int k, int dir, float lbv, float lg, const float2* rot) {
    CV o;
    if (type == 0) {
        const float aq = bf2f(prow[h * 128 + k]); o.q = siluf_(aq);
        const float z = bf2f(prow[1024 + dir * 512 + h * 128 + k]);
        const float f = lbv + (1.f - lbv) * sigmoidf_(z);
        o.k = 1.f - f; o.lf = log_(f);
    } else {
        const int c0 = h * 128 + k, c1 = h * 128 + (k ^ 1);
        const float2 cs = rot[k >> 1];
        const float xq = bf2f(prow[2560 + c0]), xq2 = bf2f(prow[2560 + c1]), xk = bf2f(prow[3072 + c0]), xk2 = bf2f(prow[3072 + c1]);
        if (k & 1) { o.q = xq * cs.x + xq2 * cs.y; o.k = xk * cs.x + xk2 * cs.y; } else { o.q = xq * cs.x - xq2 * cs.y; o.k = xk * cs.x - xk2 * cs.y; }
        o.k *= 0.08838834764831845f; o.lf = lg;
    }
    return o;
}
__device__ __forceinline__ void even_setup(const Args& args, int j, int type, int h, int k, int dir, float& lbv, float& lg) {
    lbv = 0.f; lg = 0.f;
    if (type == 0) { if (j == 1) { const float* l = args.in[I_ELB] + (size_t)dir * 2 * 512; lbv = sigmoidf_(l[512 + h * 128 + k] - l[h * 128 + k]); } }
    else lg = logf(1.f - exp2f(-5.f - (float)h));
}
__device__ __forceinline__ bf16x8 load_vfrag(const bf16* base, int ld) {
    bf16x8 r;
#pragma unroll
    for (int e = 0; e < 8; ++e) r[e] = (short)base[(size_t)e * ld];
    return r;
}
__device__ __forceinline__ void even_stage_load(u32x4 (&rg)[4][2], const bf16* PROJ, int type, int h, int row0, int tid) {
#pragma unroll
    for (int i = 0; i < 4; ++i) {
        if (i == 2 && type != 0) continue;
        const int col0 = (i == 3 ? (type == 0 ? 512 : 3584) : type == 0 ? (i == 0 ? 0 : i == 1 ? 1024 : 1536) : (i == 0 ? 2560 : 3072)) + h * 128;
#pragma unroll
        for (int c2 = 0; c2 < 2; ++c2) { const int c = tid + 512 * c2, row = c >> 4, c16 = c & 15; rg[i][c2] = *(const u32x4*)(PROJ + (size_t)(row0 + row) * DIN + col0 + c16 * 8); }
    }
}
__device__ __forceinline__ void even_stage_commit(const u32x4 (&rg)[4][2], LAS uchar* raw, LAS uchar* vtile, int type, int tid) {
#pragma unroll
    for (int i = 0; i < 4; ++i) {
        if (i == 2 && type != 0) continue;
#pragma unroll
        for (int c2 = 0; c2 < 2; ++c2) { const int c = tid + 512 * c2, row = c >> 4, c16 = c & 15; *(LAS u32x4*)((i == 3 ? vtile : raw + i * 17408) + row * 272 + c16 * 16) = rg[i][c2]; }
    }
}
__device__ __forceinline__ bf16x8 lds_vfrag(const LAS uchar* vtile, int tok0, int ch) {
    bf16x8 r;
#pragma unroll
    for (int e = 0; e < 8; ++e) r[e] = (short)*(const LAS bf16*)(vtile + (tok0 + e) * 272 + ch * 2);
    return r;
}
__device__ __forceinline__ void even_elem(const Args& args, int j, int type, int h, int row0, int pos0, const bf16* PROJ, const float2* ROT, LAS uchar* raw, LAS float* HS, int tid,
                                          float (&qv)[32], float (&kv)[32], float (&lf)[32], float& start, float& ref, float& total) {
    const int k = tid & 127, dir = (tid >> 7) & 1, half = tid >> 8;
    float lbv, lg; even_setup(args, j, type, h, k, dir, lbv, lg);
    __syncthreads();
    float sum = 0.f;
    if (type == 0) {
        const LAS bf16* R0 = (const LAS bf16*)raw; const LAS bf16* RZ = (const LAS bf16*)(raw + (1 + dir) * 17408);
#pragma unroll
        for (int i = 0; i < 32; ++i) { const int t = 32 * half + i;
            const float aq = bf2f(R0[t * 136 + k]), z = bf2f(RZ[t * 136 + k]);
            const float f = lbv + (1.f - lbv) * sigmoidf_(z);
            qv[i] = siluf_(aq); kv[i] = 1.f - f; lf[i] = log_(f); sum += lf[i]; }
    } else {
        const LAS bf16* R0 = (const LAS bf16*)raw; const LAS bf16* R1 = (const LAS bf16*)(raw + 17408);
        const float2 dcs = ROT[64 + (k >> 1)];
        float2 cs = ROT[(size_t)(pos0 + 32 * half) * 64 + (k >> 1)]; const float2 cs16 = ROT[(size_t)(pos0 + 32 * half + 16) * 64 + (k >> 1)];
#pragma unroll
        for (int i = 0; i < 32; ++i) { const int t = 32 * half + i;
            if (i == 16) cs = cs16; else if (i > 0) { const float c_ = cs.x * dcs.x - cs.y * dcs.y, s_ = cs.y * dcs.x + cs.x * dcs.y; cs.x = c_; cs.y = s_; }
            const float xq = bf2f(R0[t * 136 + k]), xq2 = bf2f(R0[t * 136 + (k ^ 1)]), xk = bf2f(R1[t * 136 + k]), xk2 = bf2f(R1[t * 136 + (k ^ 1)]);
            float q_, k_;
            if (k & 1) { q_ = xq * cs.x + xq2 * cs.y; k_ = xk * cs.x + xk2 * cs.y; } else { q_ = xq * cs.x - xq2 * cs.y; k_ = xk * cs.x - xk2 * cs.y; }
            qv[i] = q_; kv[i] = k_ * 0.08838834764831845f; lf[i] = lg; sum += lg; }
    }
    HS[(dir * 2 + half) * 128 + k] = sum;
    __syncthreads();
    const float other = HS[(dir * 2 + (half ^ 1)) * 128 + k];
    const bool first = dir ? (half == 1) : (half == 0);
    start = first ? 0.f : other; ref = first ? sum : other; total = sum + other;
}
__device__ __forceinline__ void even_elem_c(const Args& args, int j, int type, int h, int row0, int pos0, const bf16* PROJ, const float2* ROT, LAS uchar* raw, LAS float* HS, int tid,
                                            LAS bf16* qx, LAS bf16* kx, float (&lf)[32], float& start, float& ref, float& total) {
    const int k = tid & 127, dir = (tid >> 7) & 1, half = tid >> 8;
    float lbv, lg; even_setup(args, j, type, h, k, dir, lbv, lg);
    __syncthreads();
    float sum = 0.f;
    if (type == 0) {
        const LAS bf16* R0 = (const LAS bf16*)raw + (32 * half) * 136 + k; const LAS bf16* RZ = (const LAS bf16*)(raw + (1 + dir) * 17408) + (32 * half) * 136 + k;
#pragma unroll
        for (int i = 0; i < 32; ++i) {
            const float aq = bf2f(R0[i * 136]), z = bf2f(RZ[i * 136]);
            const float f = lbv + (1.f - lbv) * sigmoidf_(z);
            qx[i * 136] = f2bf_hw(siluf_(aq)); kx[i * 136] = f2bf_hw(1.f - f); lf[i] = log_(f); sum += lf[i]; }
    } else {
        const LAS bf16* R0 = (const LAS bf16*)raw + (32 * half) * 136; const LAS bf16* R1 = (const LAS bf16*)(raw + 17408) + (32 * half) * 136;
        const float2* rot = ROT + (size_t)(pos0 + 32 * half) * 64 + (k >> 1);
        const float2 dcs = ROT[64 + (k >> 1)]; float2 cs = rot[0]; const float2 cs16 = rot[16 * 64];
#pragma unroll
        for (int i = 0; i < 32; ++i) {
            if (i == 16) cs = cs16; else if (i > 0) { const float c_ = cs.x * dcs.x - cs.y * dcs.y, s_ = cs.y * dcs.x + cs.x * dcs.y; cs.x = c_; cs.y = s_; }
            const float xq = bf2f(R0[i * 136 + k]), xq2 = bf2f(R0[i * 136 + (k ^ 1)]), xk = bf2f(R1[i * 136 + k]), xk2 = bf2f(R1[i * 136 + (k ^ 1)]);
            float q_, k_;
            if (k & 1) { q_ = xq * cs.x + xq2 * cs.y; k_ = xk * cs.x + xk2 * cs.y; } else { q_ = xq * cs.x - xq2 * cs.y; k_ = xk * cs.x - xk2 * cs.y; }
            qx[i * 136] = f2bf_hw(q_); kx[i * 136] = f2bf_hw(k_ * 0.08838834764831845f); lf[i] = lg; sum += lg; }
    }
    HS[(dir * 2 + half) * 128 + k] = sum;
    __syncthreads();
    const float other = HS[(dir * 2 + (half ^ 1)) * 128 + k];
    const bool first = dir ? (half == 1) : (half == 0);
    start = first ? 0.f : other; ref = first ? sum : other; total = sum + other;
}
__device__ __forceinline__ void even_cumul(int dir, float start, float (&lf)[32]) {
    float run = start;
    if (dir == 0) {
#pragma unroll
        for (int i = 0; i < 32; ++i) { run += lf[i]; lf[i] = run; }
    } else {
#pragma unroll
        for (int i = 31; i >= 0; --i) { run += lf[i]; lf[i] = run; }
    }
}
__device__ __forceinline__ void even_phase_a(const Args& args, LAS uchar* lds, int j, int G, int wave_sgpr_) {
    unsigned char* ws = opaque_ptr(args.ws);
    const bf16* PROJ = (const bf16*)(ws + AR_PROJ); bf16* ST = (bf16*)(ws + AR_ST); float* DEC = (float*)(ws + AR_DEC); const float2* ROT = (const float2*)(ws + WS_ROT);
    const int tid = opaque_tid(), wave = uni(tid >> 6), lane = tid & 63, fr = lane & 15, fq = lane >> 4;
    LAS bf16* KT = (LAS bf16*)lds;
    LAS uchar* RAW = lds + 36864;
    LAS float* HS = (LAS float*)(lds + 36864 + 3 * 17408);
    LAS uchar* VTL = lds + 36864 + 3 * 17408 + 2048;
    u32x4 rg[4][2];
#pragma unroll
    for (int i = 0; i < 4; ++i) { rg[i][0] = (u32x4){0u, 0u, 0u, 0u}; rg[i][1] = rg[i][0]; }
    { const int u = opaque_bx(); if (u < 2 * NCHUNK * 4) even_stage_load(rg, PROJ, u / (NCHUNK * 4), u & 3, ((u % (NCHUNK * 4)) >> 2) * 64, tid); }
    for (int u = opaque_bx(); u < 2 * NCHUNK * 4; u += G) {
        const int type = u / (NCHUNK * 4), rem = u % (NCHUNK * 4), cg = rem >> 2, h = rem & 3, row0 = cg * 64, pos0 = row_pos(row0);
        __syncthreads();
        even_stage_commit(rg, RAW, VTL, type, tid);
        { const int un = u + G; if (un < 2 * NCHUNK * 4) even_stage_load(rg, PROJ, un / (NCHUNK * 4), un & 3, ((un % (NCHUNK * 4)) >> 2) * 64, tid); }
        {
            float qv[32], kv[32], lf[32], start, ref, total;
            even_elem(args, j, type, h, row0, pos0, PROJ, ROT, RAW, HS, tid, qv, kv, lf, start, ref, total);
            const int k = tid & 127, dir = (tid >> 7) & 1, half = tid >> 8;
            if (half == 0) DEC[((size_t)((type * 2 + dir) * NCHUNK + cg) * 4 + h) * 128 + k] = exp_(total);
            even_cumul(uni(dir), start, lf);
            float val[32];
#pragma unroll
            for (int i = 0; i < 32; ++i) val[i] = kv[i] * exp_(total - lf[i]);
            LAS bf16* kt = KT + ((size_t)dir * 128 + k) * 72 + 32 * half;
#pragma unroll
            for (int g8 = 0; g8 < 4; ++g8) { u32x4 o; o.x = pk2(val[8 * g8 + 0], val[8 * g8 + 1]); o.y = pk2(val[8 * g8 + 2], val[8 * g8 + 3]); o.z = pk2(val[8 * g8 + 4], val[8 * g8 + 5]); o.w = pk2(val[8 * g8 + 6], val[8 * g8 + 7]);
                *(LAS u32x4*)(kt + 8 * g8) = o; }
        }
        __syncthreads();
        bf16x8 vf[2];
#pragma unroll
        for (int ks = 0; ks < 2; ++ks) vf[ks] = lds_vfrag(VTL, 32 * ks + 8 * fq, 16 * wave + fr);
#pragma unroll
        for (int dir = 0; dir < 2; ++dir) {
            bf16* st = ST + ((size_t)((type * 2 + dir) * NCHUNK + cg) * 4 + h) * 16384 + (size_t)(16 * wave + fr) * 128;
#pragma unroll
            for (int nb = 0; nb < 8; ++nb) {
                f32x4 acc = (f32x4){0.f, 0.f, 0.f, 0.f};
#pragma unroll
                for (int ks = 0; ks < 2; ++ks) { const bf16x8 kf = *(const LAS bf16x8*)(KT + ((size_t)dir * 128 + 16 * nb + fr) * 72 + 32 * ks + 8 * fq);
                    acc = __builtin_amdgcn_mfma_f32_16x16x32_bf16(kf, vf[ks], acc, 0, 0, 0); }
                { u32x2 o_; o_.x = pk2(acc[0], acc[1]); o_.y = pk2(acc[2], acc[3]); *(u32x2*)(st + 16 * nb + 4 * fq) = o_; }
            }
        }
    }
}
__device__ __forceinline__ void even_phase_b(const Args& args, int G, int wave_sgpr_) {
    unsigned char* ws = opaque_ptr(args.ws); bf16* ST = (bf16*)(ws + AR_ST); const float* DEC = (const float*)(ws + AR_DEC);
    const int gt = opaque_bx() * 512 + opaque_tid(), NT = G * 512;
    for (int it = gt; it < 4 * NSEQ * 4 * 2048; it += NT) {
        const int e8 = it & 2047, h = (it >> 11) & 3, rest = it >> 13, s = rest % NSEQ, td = rest / NSEQ, dir = td & 1;
        const int nc = s < 4 ? 64 : 32, cg0 = s < 4 ? s * 64 : 256 + (s - 4) * 32;
        float run[8];
#pragma unroll
        for (int i = 0; i < 8; ++i) run[i] = 0.f;
        for (int c0 = 0; c0 < nc; c0 += 8) {
            u32x4 uu[8]; f32x4 d0[8], d1[8];
#pragma unroll
            for (int e = 0; e < 8; ++e) { const int c = c0 + e, cg = dir ? cg0 + nc - 1 - c : cg0 + c;
                uu[e] = *((const u32x4*)(ST + ((size_t)(td * NCHUNK + cg) * 4 + h) * 16384) + e8);
                const f32x4* dp = (const f32x4*)(DEC + ((size_t)(td * NCHUNK + cg) * 4 + h) * 128) + 2 * (e8 & 15); d0[e] = dp[0]; d1[e] = dp[1]; }
#pragma unroll
            for (int e = 0; e < 8; ++e) { const int c = c0 + e, cg = dir ? cg0 + nc - 1 - c : cg0 + c;
                u32x4 o; o.x = pk2(run[0], run[1]); o.y = pk2(run[2], run[3]); o.z = pk2(run[4], run[5]); o.w = pk2(run[6], run[7]);
                *((u32x4*)(ST + ((size_t)(td * NCHUNK + cg) * 4 + h) * 16384) + e8) = o;
                run[0] = d0[e].x * run[0] + bflo(uu[e].x); run[1] = d0[e].y * run[1] + bfhi(uu[e].x); run[2] = d0[e].z * run[2] + bflo(uu[e].y); run[3] = d0[e].w * run[3] + bfhi(uu[e].y);
                run[4] = d1[e].x * run[4] + bflo(uu[e].z); run[5] = d1[e].y * run[5] + bfhi(uu[e].z); run[6] = d1[e].z * run[6] + bflo(uu[e].w); run[7] = d1[e].w * run[7] + bfhi(uu[e].w); }
        }
    }
}
__device__ __forceinline__ void even_phase_c(const Args& args, LAS uchar* lds, int j, int G, int wave_sgpr_) {
    unsigned char* ws = opaque_ptr(args.ws);
    const bf16* PROJ = (const bf16*)(ws + AR_PROJ); const bf16* ST = (const bf16*)(ws + AR_ST); const float2* ROT = (const float2*)(ws + WS_ROT); bf16* OM = (bf16*)(ws + AR_OME);
    const int tid = opaque_tid(), wave = uni(tid >> 6), lane = tid & 63, fr = lane & 15, fq = lane >> 4;
    constexpr int TP = 136;
    LAS bf16* QX = (LAS bf16*)lds;
    LAS bf16* KX = QX + 2 * 64 * TP;
    LAS bf16* QI = KX + 2 * 64 * TP;
    LAS bf16* PT = QI + 2 * 64 * TP;
    LAS f32x2* STAT = (LAS f32x2*)(PT + 64 * 72);
    LAS uchar* RAW = lds + 69632;
    LAS float* HS = (LAS float*)(lds + 69632 + 3 * 17408);
    LAS uchar* VTL = lds + MISC_OFF + 64;
    static_assert(69632 + 3 * 17408 + 2048 <= XLDS_OFF && MISC_OFF + 64 + 17408 <= LDS_BYTES, "even_phase_c LDS map");
    u32x4 rg[4][2];
#pragma unroll
    for (int i = 0; i < 4; ++i) { rg[i][0] = (u32x4){0u, 0u, 0u, 0u}; rg[i][1] = rg[i][0]; }
    { const int u = opaque_bx(); if (u < 2 * NCHUNK * 4) even_stage_load(rg, PROJ, u / (NCHUNK * 4), u & 3, ((u % (NCHUNK * 4)) >> 2) * 64, tid); }
    for (int u = opaque_bx(); u < 2 * NCHUNK * 4; u += G) {
        const int type = u / (NCHUNK * 4), rem = u % (NCHUNK * 4), cg = rem >> 2, h = rem & 3, row0 = cg * 64, pos0 = row_pos(row0);
        bf16x8 sfq[2][4]; u32x2 gwq[4];
        {
#pragma unroll
            for (int dir = 0; dir < 2; ++dir) { const bf16* st = ST + ((size_t)((type * 2 + dir) * NCHUNK + cg) * 4 + h) * 16384 + (size_t)(16 * wave + fr) * 128;
#pragma unroll
                for (int ks = 0; ks < 4; ++ks) sfq[dir][ks] = *(const bf16x8*)(st + 32 * ks + 8 * fq); }
            const int gcol = (type == 0 ? 2048 : 4096) + h * 128 + 16 * wave + 4 * fq;
#pragma unroll
            for (int mb = 0; mb < 4; ++mb) gwq[mb] = *(const u32x2*)(PROJ + (size_t)(row0 + 16 * mb + fr) * DIN + gcol);
        }
        __syncthreads();
        even_stage_commit(rg, RAW, VTL, type, tid);
        { const int un = u + G; if (un < 2 * NCHUNK * 4) even_stage_load(rg, PROJ, un / (NCHUNK * 4), un & 3, ((un % (NCHUNK * 4)) >> 2) * 64, tid); }
        {
            float lf[32], start, ref, total;
            const int k = tid & 127, dir = (tid >> 7) & 1, half = tid >> 8;
            LAS bf16* qx = QX + ((size_t)dir * 64 + 32 * half) * TP + k; LAS bf16* kx = KX + ((size_t)dir * 64 + 32 * half) * TP + k; LAS bf16* qi = QI + ((size_t)dir * 64 + 32 * half) * TP + k;
            even_elem_c(args, j, type, h, row0, pos0, PROJ, ROT, RAW, HS, tid, qx, kx, lf, start, ref, total);
            even_cumul(uni(dir), start, lf);
            const float eref = exp_(ref);
#pragma unroll
            for (int i = 0; i < 32; ++i) {
                const float e1 = exp_(lf[i] - ref), q_ = bf2f(qx[i * TP]), k_ = bf2f(kx[i * TP]);
                qx[i * TP] = f2bf_hw(q_ * e1);
                kx[i * TP] = f2bf_hw(k_ * __builtin_amdgcn_rcpf(e1));
                qi[i * TP] = f2bf_hw(q_ * e1 * eref); }
        }
        __syncthreads();
        {
            const int mb = wave >> 1;
#pragma unroll
            for (int nn = 0; nn < 2; ++nn) {
                const int nbk = 2 * (wave & 1) + nn;
                f32x4 af = (f32x4){0.f, 0.f, 0.f, 0.f}, ab = af;
#pragma unroll
                for (int ks = 0; ks < 4; ++ks) {
                    const bf16x8 kf = *(const LAS bf16x8*)(KX + ((size_t)0 * 64 + 16 * nbk + fr) * TP + 32 * ks + 8 * fq), qf = *(const LAS bf16x8*)(QX + ((size_t)0 * 64 + 16 * mb + fr) * TP + 32 * ks + 8 * fq);
                    af = __builtin_amdgcn_mfma_f32_16x16x32_bf16(kf, qf, af, 0, 0, 0);
                    const bf16x8 kb = *(const LAS bf16x8*)(KX + ((size_t)1 * 64 + 16 * nbk + fr) * TP + 32 * ks + 8 * fq), qb = *(const LAS bf16x8*)(QX + ((size_t)1 * 64 + 16 * mb + fr) * TP + 32 * ks + 8 * fq);
                    ab = __builtin_amdgcn_mfma_f32_16x16x32_bf16(kb, qb, ab, 0, 0, 0);
                }
                const int t = 16 * mb + fr; float p[4];
#pragma unroll
                for (int r = 0; r < 4; ++r) { const int s = 16 * nbk + 4 * fq + r; const float vf_ = (s <= t) ? af[r] : 0.f; const float vb_ = (type == 0 ? (s >= t) : (s > t)) ? ab[r] : 0.f; p[r] = vf_ + vb_; }
                u32x2 o; o.x = pk2(p[0], p[1]); o.y = pk2(p[2], p[3]);
                *(LAS u32x2*)(PT + (size_t)t * 72 + 16 * nbk + 4 * fq) = o;
            }
        }
        __syncthreads();
#ifndef E2C_DBG
#define E2C_DBG 0
#endif
        f32x4 acc[4];
#pragma unroll
        for (int mb = 0; mb < 4; ++mb) acc[mb] = (f32x4){0.f, 0.f, 0.f, 0.f};
        {
            bf16x8 vfq[2];
#pragma unroll
            for (int ks = 0; ks < 2; ++ks) vfq[ks] = lds_vfrag(VTL, 32 * ks + 8 * fq, 16 * wave + fr);
#pragma unroll
            for (int ks = 0; ks < 2; ++ks) {
#pragma unroll
                for (int mb = 0; mb < 4; ++mb) { const bf16x8 pf = *(const LAS bf16x8*)(PT + (size_t)(16 * mb + fr) * 72 + 32 * ks + 8 * fq); acc[mb] = __builtin_amdgcn_mfma_f32_16x16x32_bf16(vfq[ks], pf, acc[mb], 0, 0, 0); } }
#pragma unroll
            for (int dir = 0; dir < 2; ++dir) {
#pragma unroll
                for (int ks = 0; ks < 4; ++ks) {
#pragma unroll
                    for (int mb = 0; mb < 4; ++mb) { const bf16x8 qf = *(const LAS bf16x8*)(QI + ((size_t)dir * 64 + 16 * mb + fr) * TP + 32 * ks + 8 * fq); acc[mb] = __builtin_amdgcn_mfma_f32_16x16x32_bf16(sfq[dir][ks], qf, acc[mb], 0, 0, 0); } }
            }
        }
#pragma unroll
        for (int mb = 0; mb < 4; ++mb) { float s1 = (acc[mb][0] + acc[mb][1]) + (acc[mb][2] + acc[mb][3]); float s2 = (acc[mb][0] * acc[mb][0] + acc[mb][1] * acc[mb][1]) + (acc[mb][2] * acc[mb][2] + acc[mb][3] * acc[mb][3]);
            s1 = xor32_sum(xor16_sum(s1)); s2 = xor32_sum(xor16_sum(s2));
            if (fq == 0) STAT[(16 * mb + fr) * 8 + wave] = (f32x2){s1, s2}; }
        __syncthreads();
        {
            const float* gain = (type == 0 ? args.in[I_ENA] : args.in[I_ENB]) + (size_t)j * 512 + h * 128 + 16 * wave + 4 * fq;
            const f32x4 gn = *(const f32x4*)gain;
#pragma unroll
            for (int mb = 0; mb < 4; ++mb) {
                const int t = 16 * mb + fr; float S1 = 0.f, S2 = 0.f;
#pragma unroll
                for (int w = 0; w < 8; ++w) { const f32x2 a = STAT[t * 8 + w]; S1 += a.x; S2 += a.y; }
                const float mean = (type == 0) ? 0.f : ldexpf(S1, -7);
                const float var = ldexpf(S2, -7) - mean * mean;
                const float rstd = 1.f / sqrtf(fmaxf(var, 0.f) + 1e-6f);
                const u32x2 gw = gwq[mb];
                const float g0 = siluf_(bflo(gw.x)), g1 = siluf_(bfhi(gw.x)), g2 = siluf_(bflo(gw.y)), g3 = siluf_(bfhi(gw.y));
                const float o0 = (acc[mb][0] - mean) * rstd * gn.x * g0, o1 = (acc[mb][1] - mean) * rstd * gn.y * g1, o2 = (acc[mb][2] - mean) * rstd * gn.z * g2, o3 = (acc[mb][3] - mean) * rstd * gn.w * g3;
                u32x2 o; o.x = pk2(o0, o1); o.y = pk2(o2, o3);
                if (E2C_DBG) { o.x = pk2(acc[mb][0], acc[mb][1]); o.y = pk2(acc[mb][2], acc[mb][3]); }
                *(u32x2*)(OM + (size_t)(row0 + t) * D + type * 512 + h * 128 + 16 * wave + 4 * fq) = o;
            }
        }
    }
}

__device__ __forceinline__ void unpack8(const u32x4 a, float (&o)[8]) {
    o[0] = bflo(a.x); o[1] = bfhi(a.x); o[2] = bflo(a.y); o[3] = bfhi(a.y); o[4] = bflo(a.z); o[5] = bfhi(a.z); o[6] = bflo(a.w); o[7] = bfhi(a.w);
}
__device__ __forceinline__ u32x4 pack8(const float (&v)[8]) { u32x4 a; a.x = pk2(v[0], v[1]); a.y = pk2(v[2], v[3]); a.z = pk2(v[4], v[5]); a.w = pk2(v[6], v[7]); return a; }
__device__ __forceinline__ void load8f(const float* p, float (&o)[8]) { const f32x4 a = *(const f32x4*)p, b = *((const f32x4*)p + 1); o[0] = a.x; o[1] = a.y; o[2] = a.z; o[3] = a.w; o[4] = b.x; o[5] = b.y; o[6] = b.z; o[7] = b.w; }
__device__ __forceinline__ float oct_sum(float v) {
    v = quad_sum(v);
    v += __builtin_bit_cast(float, __builtin_amdgcn_mov_dpp(__builtin_bit_cast(int, v), 0x141, 0xF, 0xF, true));
    return v;
}
__device__ __forceinline__ void odd_shiftmix(const Args& args, int j, int gw, int NGW, int lane) {
    unsigned char* ws = opaque_ptr(args.ws); const bf16* XBr = (const bf16*)(ws + WS_XB); bf16* XM = (bf16*)(ws + AR_XM);
    const float* mu = args.in[I_OMU] + (size_t)j * 6 * D + 16 * lane;
    const int per = (NTOK + NGW - 1) / NGW, rb = gw * per, re = rb + per < NTOK ? rb + per : NTOK;
    if (rb >= re) return;
    float m[6][2][8];
#pragma unroll
    for (int p = 0; p < 6; ++p) { load8f(mu + (size_t)p * D, m[p][0]); load8f(mu + (size_t)p * D + 8, m[p][1]); }
    const u32x4 z4 = (u32x4){0u, 0u, 0u, 0u};
    u32x4 pv[2] = {z4, z4}, cu[2], nx[2] = {z4, z4};
#define SM_LD(dst_, rr_) do { const u32x4* p_ = (const u32x4*)(XBr + (size_t)(rr_) * D + 16 * lane); dst_[0] = p_[0]; dst_[1] = p_[1]; } while (0)
    if (rb > 0) SM_LD(pv, rb - 1);
    SM_LD(cu, rb);
    if (rb + 1 < NTOK) SM_LD(nx, rb + 1);
    for (int r = rb; r < re; ++r) {
        u32x4 n2[2] = {z4, z4};
        if (r + 1 < re && r + 2 < NTOK) SM_LD(n2, r + 2);
        const int pos = row_pos(r), T = row_T(r);
        const bool hp = pos > 0, hn = pos < T - 1;
#pragma unroll
        for (int hh = 0; hh < 2; ++hh) {
            float x[8], xp[8], xn[8], xx[8];
            unpack8(cu[hh], x); unpack8(pv[hh], xp); unpack8(nx[hh], xn);
#pragma unroll
            for (int i = 0; i < 8; ++i) xx[i] = ((hp ? xp[i] : 0.f) + (hn ? xn[i] : 0.f)) * 0.5f - x[i];
#pragma unroll
            for (int p = 0; p < 6; ++p) { float v[8];
#pragma unroll
                for (int i = 0; i < 8; ++i) v[i] = x[i] + xx[i] * m[p][hh][i];
                *((u32x4*)(XM + ((size_t)p * NTOK + r) * D + 16 * lane) + hh) = pack8(v); }
        }
        pv[0] = cu[0]; pv[1] = cu[1]; cu[0] = nx[0]; cu[1] = nx[1]; nx[0] = n2[0]; nx[1] = n2[1];
    }
#undef SM_LD
}
__device__ __forceinline__ void unpack16(const bf16* p, float (&o)[16]) {
    const u32x4 a = *(const u32x4*)p, b = *((const u32x4*)p + 1);
    o[0] = bflo(a.x); o[1] = bfhi(a.x); o[2] = bflo(a.y); o[3] = bfhi(a.y); o[4] = bflo(a.z); o[5] = bfhi(a.z); o[6] = bflo(a.w); o[7] = bfhi(a.w);
    o[8] = bflo(b.x); o[9] = bfhi(b.x); o[10] = bflo(b.y); o[11] = bfhi(b.y); o[12] = bflo(b.z); o[13] = bfhi(b.z); o[14] = bflo(b.w); o[15] = bfhi(b.w);
}
__device__ __forceinline__ void load16f(const float* p, float (&o)[16]) {
#pragma unroll
    for (int i = 0; i < 4; ++i) { const f32x4 v = *((const f32x4*)p + i); o[4 * i] = v.x; o[4 * i + 1] = v.y; o[4 * i + 2] = v.z; o[4 * i + 3] = v.w; }
}
__device__ __forceinline__ void store16bf(void* p, const float (&v)[16]) {
    u32x4 a, b; a.x = pk2(v[0], v[1]); a.y = pk2(v[2], v[3]); a.z = pk2(v[4], v[5]); a.w = pk2(v[6], v[7]); b.x = pk2(v[8], v[9]); b.y = pk2(v[10], v[11]); b.z = pk2(v[12], v[13]); b.w = pk2(v[14], v[15]);
    *(u32x4*)p = a; *((u32x4*)p + 1) = b;
}
__device__ __forceinline__ void odd_prep(const Args& args, int j, int gw, int NGW, int lane) {
    unsigned char* ws = opaque_ptr(args.ws);
    const bf16* R = (const bf16*)(ws + AR_RKV); const bf16* Kk = R + (size_t)NTOK * D; const bf16* LW = (const bf16*)(ws + AR_LW); const bf16* LA = (const bf16*)(ws + AR_LA);
    unsigned char* SCN = ws + AR_SCN; float* CB = (float*)(ws + AR_CB);
    const int hf = gw & 1, c0 = hf * 512 + 8 * lane, h = hf * 8 + (lane >> 3), sub = lane & 7;
    float k_k[8], k_a[8], r_k[8], w0v[2][8], a0v[2][8];
    load8f(args.in[I_OKK] + (size_t)j * D + c0, k_k); load8f(args.in[I_OKA] + (size_t)j * D + c0, k_a); load8f(args.in[I_ORK] + (size_t)j * D + c0, r_k);
#pragma unroll
    for (int dir = 0; dir < 2; ++dir) { load8f(args.in[I_OW0] + (size_t)j * 2 * D + dir * D + c0, w0v[dir]); load8f(args.in[I_OA0] + (size_t)j * 2 * D + dir * D + c0, a0v[dir]); }
    const int rstep = NGW >> 1;
    u32x4 nxt[6];
#define PREP_LD(rr_) do { const size_t r_ = (size_t)(rr_); nxt[0] = *(const u32x4*)(R + r_ * D + c0); nxt[1] = *(const u32x4*)(Kk + r_ * D + c0); \
        nxt[2] = *(const u32x4*)(LW + r_ * 2048 + c0); nxt[3] = *(const u32x4*)(LW + r_ * 2048 + 1024 + c0); nxt[4] = *(const u32x4*)(LA + r_ * 2048 + c0); nxt[5] = *(const u32x4*)(LA + r_ * 2048 + 1024 + c0); } while (0)
    if ((gw >> 1) < NTOK) PREP_LD(gw >> 1);
    for (int r = gw >> 1; r < NTOK; r += rstep) {
        u32x4 cur[6];
#pragma unroll
        for (int i = 0; i < 6; ++i) cur[i] = nxt[i];
        if (r + rstep < NTOK) PREP_LD(r + rstep);
        float rv[8], kv[8], kk[8];
        unpack8(cur[0], rv); unpack8(cur[1], kv);
        float ss = 0.f;
#pragma unroll
        for (int i = 0; i < 8; ++i) { kk[i] = kv[i] * k_k[i]; ss += kk[i] * kk[i]; }
        ss = oct_sum(ss);
        const float inv = 1.f / fmaxf(sqrtf(ss), 1e-12f);
#pragma unroll
        for (int i = 0; i < 8; ++i) kk[i] *= inv;
        unsigned char* row = SCN + ((size_t)r * 16 + h) * 1280;
        *(u32x4*)(row + sub * 16) = cur[0]; *(u32x4*)(row + 128 + sub * 16) = pack8(kk);
        float cbp = 0.f;
#pragma unroll
        for (int dir = 0; dir < 2; ++dir) {
            float lw[8], la[8], kd[8], bb[8], dec[8];
            unpack8(cur[2 + dir], lw); unpack8(cur[4 + dir], la);
#pragma unroll
            for (int i = 0; i < 8; ++i) {
                const float nx = -(w0v[dir][i] + lw[i]); const float sp = fmaxf(nx, 0.f) + log_(1.f + exp_(-fabsf(nx)));
                dec[i] = exp_(-exp_(-sp - 0.5f));
                const float a = sigmoidf_(a0v[dir][i] + la[i]);
                kd[i] = kv[i] * (1.f + (a - 1.f) * k_a[i]); bb[i] = kk[i] * a;
                cbp += rv[i] * r_k[i] * kd[i];
            }
            *(u32x4*)(row + 256 + dir * 512 + sub * 16) = pack8(kd); *(u32x4*)(row + 384 + dir * 512 + sub * 16) = pack8(bb);
            *(f32x4*)(row + 512 + dir * 512 + sub * 32) = (f32x4){dec[0], dec[1], dec[2], dec[3]}; *(f32x4*)(row + 512 + dir * 512 + sub * 32 + 16) = (f32x4){dec[4], dec[5], dec[6], dec[7]};
        }
        cbp = oct_sum(cbp);
        if (sub == 0) CB[(size_t)r * 16 + h] = cbp;
    }
#undef PREP_LD
}
__device__ __forceinline__ f32x2 oct_sum2(f32x2 v) { f32x2 r; r.x = oct_sum(v.x); r.y = oct_sum(v.y); return r; }
__device__ __forceinline__ void odd_scan_unit(const Args& args, LAS uchar* wl  , int s_, int h_, int dir_, int q16_, int lane) {
    const int s = uni(s_), h = uni(h_), dir = uni(dir_), q16 = uni(q16_);
    unsigned char* ws = opaque_ptr(args.ws); const unsigned char* SCN = ws + AR_SCN; const bf16* V = (const bf16*)(ws + AR_V); bf16* Y = (bf16*)(ws + (dir ? AR_YB : AR_YF));
    const int T = seq_T(s), r0 = seq_row0(s), rp = lane >> 3, c8 = lane & 7, i0 = q16 * 16 + 2 * rp;
    constexpr int TS = 8;
    f32x2 S[2][4];
#pragma unroll
    for (int r = 0; r < 2; ++r)
#pragma unroll
        for (int c = 0; c < 4; ++c) S[r][c] = (f32x2){0.f, 0.f};
    const int soff = lane < 32 ? 8 * lane : (256 + dir * 512) + 8 * (lane - 32);
    const int soffw = lane < 16 ? (512 + dir * 512) + 16 * lane : (int)0xfffffff0u;
    u32x2 pre[2][TS]; u32x4 prew[2][TS]; unsigned vpre[2][TS];
    const int nblk = T / TS;
    const __amdgpu_buffer_rsrc_t rsrc = __builtin_amdgcn_make_buffer_rsrc((void*)ws, 0, 0xffffffff, 0x00020000);
    const unsigned sstep = dir ? 0u - 20480u : 20480u, vstep = dir ? 0u - 2048u : 2048u;
    const unsigned scn_base = (unsigned)AR_SCN + (unsigned)h * 1280u, v_base = (unsigned)AR_V + (unsigned)h * 128u;
    const int voff_v = i0 * 2, voff_y = c8 == 0 ? i0 * 2 : (int)0xfffffff0u;
    const unsigned y_base = (unsigned)(dir ? AR_YB : AR_YF) + (unsigned)h * 128u;
    unsigned ysoff = y_base + (unsigned)(r0 + (dir ? T - 1 : 0)) * 2048u; const unsigned ystep = dir ? 0u - 2048u : 2048u;
#define SCAN_ISSUE(set_, blk_) do { const int t0_ = dir ? T - 1 - (blk_) * TS : (blk_) * TS; const unsigned row0_ = (unsigned)(r0 + t0_); \
        unsigned so_ = scn_base + row0_ * 20480u, vo_ = v_base + row0_ * 2048u;     \
        _Pragma("unroll") for (int e = 0; e < TS; ++e) { \
            pre[set_][e] = __builtin_bit_cast(u32x2, __builtin_amdgcn_raw_buffer_load_b64(rsrc, soff, (int)so_, 0)); prew[set_][e] = __builtin_amdgcn_raw_buffer_load_b128(rsrc, soffw, (int)so_, 0); \
            vpre[set_][e] = __builtin_amdgcn_raw_buffer_load_b32(rsrc, voff_v, (int)vo_, 0); so_ += sstep; vo_ += vstep; } } while (0)
    const int cvec = lane >> 4, cdst = (cvec == 0 ? 256 : cvec == 1 ? 0 : cvec == 2 ? 512 : 768) + (lane & 15) * 16;
#define SCAN_COMMIT(set_, buf_) do { LAS uchar* base_ = wl + (buf_) * (TS * 1280); \
        _Pragma("unroll") for (int e = 0; e < TS; ++e) { const u32x2 w_ = pre[set_][e]; *(LAS f32x4*)(base_ + e * 1280 + cdst) = (f32x4){bflo(w_.x), bfhi(w_.x), bflo(w_.y), bfhi(w_.y)}; } \
        if (lane < 16) { _Pragma("unroll") for (int e = 0; e < TS; ++e) *(LAS u32x4*)(base_ + e * 1280 + 1024 + lane * 16) = prew[set_][e]; } } while (0)
    f32x4 okk[2][2], orr[2], okd[2], obb[2], oww[2];
#define SCAN_LOADKK(buf_, stp_) do { const LAS uchar* sp_ = (stp_); okk[buf_][0] = *(const LAS f32x4*)(sp_); okk[buf_][1] = *(const LAS f32x4*)(sp_ + 16); } while (0)
#define SCAN_LOADREST(stp_) do { const LAS uchar* sp_ = (stp_); _Pragma("unroll") for (int c4 = 0; c4 < 2; ++c4) { \
        okd[c4] = *(const LAS f32x4*)(sp_ + 512 + c4 * 16); obb[c4] = *(const LAS f32x4*)(sp_ + 768 + c4 * 16); oww[c4] = *(const LAS f32x4*)(sp_ + 1024 + c4 * 16); orr[c4] = *(const LAS f32x4*)(sp_ + 256 + c4 * 16); } } while (0)
    unsigned vcur[TS];
    SCAN_ISSUE(0, 0); SCAN_COMMIT(0, 0);
#pragma unroll
    for (int e = 0; e < TS; ++e) vcur[e] = vpre[0][e];
    SCAN_ISSUE(1, 1);
    SCAN_LOADKK(0, wl + c8 * 32);
    for (int blk2 = 0; blk2 < nblk; blk2 += 2) {
#pragma unroll
        for (int par = 0; par < 2; ++par) {
            const int blk = blk2 + par;
            if (blk + 2 < nblk) SCAN_ISSUE(par, blk + 2);
            LAS uchar* base = wl + par * (TS * 1280);
#pragma unroll
            for (int e = 0; e < TS; ++e) {
                const int cb = e & 1;
                SCAN_LOADREST(base + e * 1280 + c8 * 32);
                if (e + 1 < TS) SCAN_LOADKK(cb ^ 1, base + (e + 1) * 1280 + c8 * 32);
                const float vr[2] = {bflo(vcur[e]), bfhi(vcur[e])};
                const f32x2 kkp[4] = {(f32x2){okk[cb][0].x, okk[cb][0].y}, (f32x2){okk[cb][0].z, okk[cb][0].w}, (f32x2){okk[cb][1].x, okk[cb][1].y}, (f32x2){okk[cb][1].z, okk[cb][1].w}};
                float sa[2];
#pragma unroll
                for (int r = 0; r < 2; ++r) { f32x2 a = S[r][0] * kkp[0]; a = __builtin_elementwise_fma(S[r][1], kkp[1], a); a = __builtin_elementwise_fma(S[r][2], kkp[2], a); a = __builtin_elementwise_fma(S[r][3], kkp[3], a);
                    sa[r] = oct_sum(a.x + a.y); }
                const f32x2 kdp[4] = {(f32x2){okd[0].x, okd[0].y}, (f32x2){okd[0].z, okd[0].w}, (f32x2){okd[1].x, okd[1].y}, (f32x2){okd[1].z, okd[1].w}};
                const f32x2 bbp[4] = {(f32x2){obb[0].x, obb[0].y}, (f32x2){obb[0].z, obb[0].w}, (f32x2){obb[1].x, obb[1].y}, (f32x2){obb[1].z, obb[1].w}};
                const f32x2 wwp[4] = {(f32x2){oww[0].x, oww[0].y}, (f32x2){oww[0].z, oww[0].w}, (f32x2){oww[1].x, oww[1].y}, (f32x2){oww[1].z, oww[1].w}};
                const f32x2 rrp[4] = {(f32x2){orr[0].x, orr[0].y}, (f32x2){orr[0].z, orr[0].w}, (f32x2){orr[1].x, orr[1].y}, (f32x2){orr[1].z, orr[1].w}};
                float yy[2];
#pragma unroll
                for (int r = 0; r < 2; ++r) {
                    const f32x2 nsa = (f32x2){-sa[r], -sa[r]}, vv = (f32x2){vr[r], vr[r]};
                    f32x2 y = (f32x2){0.f, 0.f};
#pragma unroll
                    for (int c = 0; c < 4; ++c) { const f32x2 t = __builtin_elementwise_fma(nsa, bbp[c], vv * kdp[c]); S[r][c] = __builtin_elementwise_fma(S[r][c], wwp[c], t); y = __builtin_elementwise_fma(S[r][c], rrp[c], y); }
                    yy[r] = oct_sum(y.x + y.y);
                }
                asm volatile("" : "+v"(yy[0]), "+v"(yy[1]));
                __builtin_amdgcn_raw_buffer_store_b32(pk2(yy[0], yy[1]), rsrc, voff_y, (int)ysoff, 0);
                ysoff += ystep;
            }
            if (blk + 1 < nblk) {
                SCAN_COMMIT(par ^ 1, par ^ 1);
#pragma unroll
                for (int e = 0; e < TS; ++e) vcur[e] = vpre[par ^ 1][e];
                SCAN_LOADKK(0, wl + (par ^ 1) * (TS * 1280) + c8 * 32);
            }
        }
    }
}
__device__ __forceinline__ void odd_scan(const Args& args, LAS uchar* lds, int G, int wave, int lane, bool only0 = false) {
    const int c = blockIdx.x;
    volatile LAS unsigned* st = (volatile LAS unsigned*)(lds + MISC_OFF) + 8;
    unsigned st0 = 0u, st1 = 0u;
    if (wave == 0 && lane == 0) { st0 = st[0]; st1 = st[1]; }
    __syncthreads();
    if (c < 256 && !(only0 && wave != 0)) {
        LAS uchar* wl = lds + wave * 20480;
        if (wave < 2) { const int unit = 2 * c + wave;
            odd_scan_unit(args, wl, unit >> 7, (unit >> 3) & 15, (unit >> 2) & 1, unit & 3, lane);
        } else { const int k0 = wave < 4 ? 2 * (wave - 2) : wave, nk = wave < 4 ? 2 : 1;
            for (int uu = 0; uu < nk; ++uu) { const int u = 8 * c + k0 + uu; odd_scan_unit(args, wl, 4 + (u >> 7), (u >> 3) & 15, (u >> 2) & 1, u & 3, lane); }
        }
    }
    __syncthreads();
    if (wave == 0 && lane == 0) { st[0] = st0; st[1] = st1; }
}
__device__ __forceinline__ void unpack16r(const u32x4 a, const u32x4 b, float (&o)[16]) {
    o[0] = bflo(a.x); o[1] = bfhi(a.x); o[2] = bflo(a.y); o[3] = bfhi(a.y); o[4] = bflo(a.z); o[5] = bfhi(a.z); o[6] = bflo(a.w); o[7] = bfhi(a.w);
    o[8] = bflo(b.x); o[9] = bfhi(b.x); o[10] = bflo(b.y); o[11] = bfhi(b.y); o[12] = bflo(b.z); o[13] = bfhi(b.z); o[14] = bflo(b.w); o[15] = bfhi(b.w);
}
__device__ __forceinline__ void odd_post(const Args& args, int j, int gw, int NGW, int lane) {
    unsigned char* ws = opaque_ptr(args.ws);
    const bf16* YF = (const bf16*)(ws + AR_YF); const bf16* YB = (const bf16*)(ws + AR_YB); const bf16* V = (const bf16*)(ws + AR_V); const bf16* GG = (const bf16*)(ws + AR_GG);
    const float* CB = (const float*)(ws + AR_CB); bf16* OM = (bf16*)(ws + AR_OMO);
    const int c0 = 16 * lane, h = lane >> 2;
    float lw[16], lb[16];
    load16f(args.in[I_OLNW] + (size_t)j * D + c0, lw); load16f(args.in[I_OLNB] + (size_t)j * D + c0, lb);
    u32x4 nxt[8]; float ncb = 0.f;
#define POST_LD(rr_) do { const size_t o_ = (size_t)(rr_) * D + c0; nxt[0] = *(const u32x4*)(YF + o_); nxt[1] = *((const u32x4*)(YF + o_) + 1); nxt[2] = *(const u32x4*)(YB + o_); nxt[3] = *((const u32x4*)(YB + o_) + 1); \
        nxt[4] = *(const u32x4*)(V + o_); nxt[5] = *((const u32x4*)(V + o_) + 1); nxt[6] = *(const u32x4*)(GG + o_); nxt[7] = *((const u32x4*)(GG + o_) + 1); ncb = CB[(size_t)(rr_) * 16 + h]; } while (0)
    if (gw < NTOK) POST_LD(gw);
    for (int r = gw; r < NTOK; r += NGW) {
        const size_t o = (size_t)r * D + c0;
        float yf[16], yb[16], vv[16], gg[16], y[16], on[16];
        unpack16r(nxt[0], nxt[1], yf); unpack16r(nxt[2], nxt[3], yb); unpack16r(nxt[4], nxt[5], vv); unpack16r(nxt[6], nxt[7], gg);
        const float cb = ncb;
        if (r + NGW < NTOK) POST_LD(r + NGW);
        float s1 = 0.f;
#pragma unroll
        for (int i = 0; i < 16; ++i) { y[i] = yf[i] + yb[i]; s1 += y[i]; }
        const float mean = quad_sum(s1) * (1.f / 64.f);
        float s2 = 0.f;
#pragma unroll
        for (int i = 0; i < 16; ++i) { y[i] -= mean; s2 += y[i] * y[i]; }
        const float rstd = 1.f / sqrtf(quad_sum(s2) * (1.f / 64.f) + 64e-5f);
#pragma unroll
        for (int i = 0; i < 16; ++i) on[i] = ((y[i] * rstd) * lw[i] + lb[i] + cb * vv[i]) * gg[i];
        store16bf(OM + o, on);
    }
#undef POST_LD
}

typedef short bf16x4 __attribute__((ext_vector_type(4)));
__device__ __forceinline__ u32x2 pk4bf(float a, float b, float c, float d) { u32x2 w; w.x = pk2(a, b); w.y = pk2(c, d); return w; }
#define ROW_SHR_ADD(x_, n_) ((x_) + __builtin_bit_cast(float, __builtin_amdgcn_update_dpp(0, __builtin_bit_cast(int, (x_)), 0x110 + (n_), 0xF, 0xF, true)))
__device__ __forceinline__ void odd_prepc(const Args& args, LAS uchar* lds, int gw, int NGW, int wave, int lane) {
    unsigned char* ws = opaque_ptr(args.ws); const unsigned char* SCN = ws + AR_SCN;
    LAS float* KKs = (LAS float*)(lds + (wave < 7 ? wave * 19456 : MISC_OFF + 64));
    static_assert(7 * 19456 <= MISC_OFF && MISC_OFF + 64 + 18944 <= LDS_BYTES, "odd_prepc LDS areas");
    LAS float* RRs = KKs + 16 * 68; LAS float* BIs = RRs + 16 * 68; LAS float* KIs = BIs + 16 * 68;
    LAS float* Gs = KIs + 16 * 68;
    LAS float* As = Gs + 64;
    const int tau = lane & 15, jq = lane >> 4;
    for (int it = gw; it < (NTOK / 16) * 32; it += NGW) {
        const int dir = it & 1, h = (it >> 1) & 15, cg = it >> 5;
        const int tok = cg * 16 + (dir ? 15 - tau : tau);
        const unsigned char* row = SCN + ((size_t)tok * 16 + h) * 1280;
        const u32x4 r0 = *(const u32x4*)(row + jq * 32), r1 = *(const u32x4*)(row + jq * 32 + 16);
        const u32x4 k0 = *(const u32x4*)(row + 128 + jq * 32), k1 = *(const u32x4*)(row + 128 + jq * 32 + 16);
        const u32x4 d0 = *(const u32x4*)(row + 256 + dir * 512 + jq * 32), d1 = *(const u32x4*)(row + 256 + dir * 512 + jq * 32 + 16);
        const u32x4 b0 = *(const u32x4*)(row + 384 + dir * 512 + jq * 32), b1 = *(const u32x4*)(row + 384 + dir * 512 + jq * 32 + 16);
        f32x4 wv[4];
#pragma unroll
        for (int i = 0; i < 4; ++i) wv[i] = *(const f32x4*)(row + 512 + dir * 512 + jq * 64 + 16 * i);
        float rv[16], kkv[16], kdv[16], bv[16];
        unpack16r(r0, r1, rv); unpack16r(k0, k1, kkv); unpack16r(d0, d1, kdv); unpack16r(b0, b1, bv);
        LDS_WAIT(); asm volatile("" ::: "memory");
#pragma unroll
        for (int i = 0; i < 4; ++i) { f32x4 okk, orr, obi, oki, og;
#pragma unroll
            for (int e = 0; e < 4; ++e) { const int c = 4 * i + e;
                const float lw = log_(wv[i][e]);
                float cum = lw; cum = ROW_SHR_ADD(cum, 1); cum = ROW_SHR_ADD(cum, 2); cum = ROW_SHR_ADD(cum, 4); cum = ROW_SHR_ADD(cum, 8);
                const float ecum = exp_(cum), eexc = exp_(cum - lw), inv = __builtin_amdgcn_rcpf(ecum);
                okk[e] = kkv[c] * eexc; orr[e] = rv[c] * ecum; obi[e] = bv[c] * inv; oki[e] = kdv[c] * inv; og[e] = ecum; }
            *(LAS f32x4*)(KKs + tau * 68 + 16 * jq + 4 * i) = okk; *(LAS f32x4*)(RRs + tau * 68 + 16 * jq + 4 * i) = orr;
            *(LAS f32x4*)(BIs + tau * 68 + 16 * jq + 4 * i) = obi; *(LAS f32x4*)(KIs + tau * 68 + 16 * jq + 4 * i) = oki;
            if (tau == 15) *(LAS f32x4*)(Gs + 16 * jq + 4 * i) = og; }
        LDS_WAIT(); asm volatile("" ::: "memory");
        unsigned char* rec = ws + (dir ? AR_CH1 : AR_CH0) + ((size_t)cg * 16 + h) * CH_REC;
        f32x4 aab = (f32x4){0.f, 0.f, 0.f, 0.f}, aak = aab, arb = aab, ark = aab;
#pragma unroll
        for (int jt = 0; jt < 4; ++jt) {
            const f32x4 kf = *(const LAS f32x4*)(KKs + tau * 68 + 16 * jt + 4 * jq), rf = *(const LAS f32x4*)(RRs + tau * 68 + 16 * jt + 4 * jq);
            const f32x4 bf_ = *(const LAS f32x4*)(BIs + tau * 68 + 16 * jt + 4 * jq), kif = *(const LAS f32x4*)(KIs + tau * 68 + 16 * jt + 4 * jq);
            const u32x2 kkp = pk4bf(kf.x, kf.y, kf.z, kf.w), rrp = pk4bf(rf.x, rf.y, rf.z, rf.w), bip = pk4bf(bf_.x, bf_.y, bf_.z, bf_.w), kip = pk4bf(kif.x, kif.y, kif.z, kif.w);
            aab = __builtin_amdgcn_mfma_f32_16x16x16bf16_1k(__builtin_bit_cast(bf16x4, bip), __builtin_bit_cast(bf16x4, kkp), aab, 0, 0, 0);
            aak = __builtin_amdgcn_mfma_f32_16x16x16bf16_1k(__builtin_bit_cast(bf16x4, kip), __builtin_bit_cast(bf16x4, kkp), aak, 0, 0, 0);
            arb = __builtin_amdgcn_mfma_f32_16x16x16bf16_1k(__builtin_bit_cast(bf16x4, bip), __builtin_bit_cast(bf16x4, rrp), arb, 0, 0, 0);
            ark = __builtin_amdgcn_mfma_f32_16x16x16bf16_1k(__builtin_bit_cast(bf16x4, kip), __builtin_bit_cast(bf16x4, rrp), ark, 0, 0, 0);
            *(u32x2*)(rec + CH_KK + (jt * 64 + lane) * 8) = kkp; *(u32x2*)(rec + CH_RR + (jt * 64 + lane) * 8) = rrp;
        }
#pragma unroll
        for (int e = 0; e < 4; ++e) { const int sg = 4 * jq + e; if (!(sg < tau)) { aab[e] = 0.f; aak[e] = 0.f; } if (!(sg <= tau)) { arb[e] = 0.f; ark[e] = 0.f; } }
        *(LAS f32x4*)(As + tau * 20 + 4 * jq) = (f32x4){aab[0], aab[1], aab[2], aab[3]};
        *(u32x2*)(rec + CH_MAT + (0 * 64 + lane) * 8) = pk4bf(aak[0], aak[1], aak[2], aak[3]);
        *(u32x2*)(rec + CH_MAT + (2 * 64 + lane) * 8) = pk4bf(-arb[0], -arb[1], -arb[2], -arb[3]);
        *(u32x2*)(rec + CH_MAT + (3 * 64 + lane) * 8) = pk4bf(ark[0], ark[1], ark[2], ark[3]);
#pragma unroll
        for (int jt = 0; jt < 4; ++jt) {
            const int j = 16 * jt + tau; const float g = Gs[j]; float nb[4], kt[4];
#pragma unroll
            for (int e = 0; e < 4; ++e) { nb[e] = -BIs[(4 * jq + e) * 68 + j] * g; kt[e] = KIs[(4 * jq + e) * 68 + j] * g; }
            *(u32x2*)(rec + CH_NBT + (jt * 64 + lane) * 8) = pk4bf(nb[0], nb[1], nb[2], nb[3]); *(u32x2*)(rec + CH_KT + (jt * 64 + lane) * 8) = pk4bf(kt[0], kt[1], kt[2], kt[3]);
        }
        if (lane < 16) *(f32x4*)(rec + CH_G + lane * 16) = *(const LAS f32x4*)(Gs + 4 * lane);
        LDS_WAIT(); asm volatile("" ::: "memory");
        float X[16];
#pragma unroll
        for (int t = 0; t < 16; ++t) { float x = (t == tau) ? 1.f : 0.f;
#pragma unroll
            for (int s4 = 0; s4 < (t + 3) / 4; ++s4) { const f32x4 l4 = *(const LAS f32x4*)(As + t * 20 + 4 * s4);
#pragma unroll
                for (int e = 0; e < 4; ++e) if (4 * s4 + e < t) x -= l4[e] * X[4 * s4 + e]; }
            X[t] = x; }
        LDS_WAIT(); asm volatile("" ::: "memory");
#pragma unroll
        for (int t = 0; t < 16; ++t) As[t * 20 + tau] = X[t];
        LDS_WAIT(); asm volatile("" ::: "memory");
        { const f32x4 ti = *(const LAS f32x4*)(As + tau * 20 + 4 * jq); *(u32x2*)(rec + CH_MAT + (1 * 64 + lane) * 8) = pk4bf(ti.x, ti.y, ti.z, ti.w); }
    }
}
#define ROW_SHL_ADD(x_, n_) ((x_) + __builtin_bit_cast(float, __builtin_amdgcn_update_dpp(0, __builtin_bit_cast(int, (x_)), 0x100 + (n_), 0xF, 0xF, true)))
__device__ __forceinline__ void odd_prepm(const Args& args, LAS uchar* lds, int j, int gw, int NGW, int wave, int lane) {
    unsigned char* ws = opaque_ptr(args.ws);
    const bf16* R = (const bf16*)(ws + AR_RKV); const bf16* Kk = R + (size_t)NTOK * D; const bf16* LW = (const bf16*)(ws + AR_LW); const bf16* LA = (const bf16*)(ws + AR_LA); float* CB = (float*)(ws + AR_CB);
    LAS float* KKs = (LAS float*)(lds + wave * 20480);
    LAS float* RRs = KKs + 16 * 68; LAS float* BIs = RRs + 16 * 68; LAS float* KIs = BIs + 16 * 68;
    LAS float* As = KIs + 16 * 68;
    LAS float* Gs = As;
    LAS float* W0s = As + 16 * 20;
    LAS float* A0s = W0s + 128; LAS float* PKs = A0s + 128;
    const int tau = lane & 15, jq = lane >> 4;
    const int h = gw & 15, ch0 = h * 64 + 16 * jq;
    { const int dd = lane >> 5, cc = (lane & 31) * 2;
      const float* w0 = args.in[I_OW0] + (size_t)j * 2 * D + dd * D + h * 64 + cc; const float* a0 = args.in[I_OA0] + (size_t)j * 2 * D + dd * D + h * 64 + cc;
      W0s[dd * 64 + cc] = w0[0]; W0s[dd * 64 + cc + 1] = w0[1]; A0s[dd * 64 + cc] = a0[0]; A0s[dd * 64 + cc + 1] = a0[1];
      PKs[lane] = args.in[I_OKK][(size_t)j * D + h * 64 + lane]; PKs[64 + lane] = args.in[I_OKA][(size_t)j * D + h * 64 + lane]; PKs[128 + lane] = args.in[I_ORK][(size_t)j * D + h * 64 + lane]; }
    LDS_WAIT(); asm volatile("" ::: "memory");
    const int cgs = NGW >> 4, np = ((NTOK / 16 - (gw >> 4) + cgs - 1) / cgs) * 2;
    u32x4 nr0, nr1, nk0, nk1, nlw0, nlw1, nla0, nla1;
#define PM_LOAD(p_) do { const int pc_ = (p_) < np ? (p_) : np - 1; const int cg_ = (gw >> 4) + (pc_ >> 1) * cgs, d_ = pc_ & 1; const size_t tk_ = (size_t)(cg_ * 16 + tau); \
        const u32x4* pr_ = (const u32x4*)(R + tk_ * D + ch0); const u32x4* pk_ = (const u32x4*)(Kk + tk_ * D + ch0); nr0 = pr_[0]; nr1 = pr_[1]; nk0 = pk_[0]; nk1 = pk_[1]; \
        const u32x4* pw_ = (const u32x4*)(LW + tk_ * 2048 + d_ * 1024 + ch0); const u32x4* pa_ = (const u32x4*)(LA + tk_ * 2048 + d_ * 1024 + ch0); nlw0 = pw_[0]; nlw1 = pw_[1]; nla0 = pa_[0]; nla1 = pa_[1]; } while (0)
    if (np > 0) PM_LOAD(0);
    float cbp = 0.f;
#pragma unroll 1
    for (int p = 0; p < np; ++p) {
        const int cg = (gw >> 4) + (p >> 1) * cgs, dir = p & 1;
        const int tok = cg * 16 + tau;
        {
            const u32x4 r0 = nr0, r1 = nr1, k0 = nk0, k1 = nk1, lw0 = nlw0, lw1 = nlw1, la0 = nla0, la1 = nla1;
            PM_LOAD(p + 1);
            if (dir == 0) cbp = 0.f;
            float rv[16], kv[16], kkv[16];
            unpack16r(r0, r1, rv); unpack16r(k0, k1, kv);
            float ss = 0.f;
#pragma unroll
            for (int i = 0; i < 4; ++i) { const f32x4 kk4 = *(const LAS f32x4*)(PKs + 16 * jq + 4 * i);
#pragma unroll
                for (int e = 0; e < 4; ++e) { const int c = 4 * i + e; kkv[c] = kv[c] * kk4[e]; ss += kkv[c] * kkv[c]; } }
            ss = xor32_sum(xor16_sum(ss));
            { const float inv = 1.f / fmaxf(sqrtf(ss), 1e-12f);
#pragma unroll
              for (int c = 0; c < 16; ++c) kkv[c] *= inv; }
            float lwv[16], lav[16];
            unpack16r(lw0, lw1, lwv); unpack16r(la0, la1, lav);
            const int prow = dir ? 15 - tau : tau;
            LDS_WAIT(); asm volatile("" ::: "memory");
#pragma unroll
            for (int i = 0; i < 4; ++i) { f32x4 okk, orr, obi, oki, og;
                const f32x4 w04 = *(const LAS f32x4*)(W0s + dir * 64 + 16 * jq + 4 * i), a04 = *(const LAS f32x4*)(A0s + dir * 64 + 16 * jq + 4 * i);
                const f32x4 ka4 = *(const LAS f32x4*)(PKs + 64 + 16 * jq + 4 * i), rk4 = *(const LAS f32x4*)(PKs + 128 + 16 * jq + 4 * i);
#pragma unroll
                for (int e = 0; e < 4; ++e) { const int c = 4 * i + e;
                    const float nx = -(w04[e] + lwv[c]); const float tq = exp_(-fabsf(nx));
                    const float lw = -0.6065306597126334f * ((nx >= 0.f ? tq : 1.f) * __builtin_amdgcn_rcpf(1.f + tq));
                    const float a = sigmoidf_(a04[e] + lav[c]);
                    const float kd = kv[c] * (1.f + (a - 1.f) * ka4[e]), b = kkv[c] * a;
                    cbp += rv[c] * rk4[e] * kd;
                    float cum = lw;
                    if (dir == 0) { cum = ROW_SHR_ADD(cum, 1); cum = ROW_SHR_ADD(cum, 2); cum = ROW_SHR_ADD(cum, 4); cum = ROW_SHR_ADD(cum, 8); }
                    else { cum = ROW_SHL_ADD(cum, 1); cum = ROW_SHL_ADD(cum, 2); cum = ROW_SHL_ADD(cum, 4); cum = ROW_SHL_ADD(cum, 8); }
                    const float ecum = exp_(cum), eexc = exp_(cum - lw), inv = __builtin_amdgcn_rcpf(ecum);
                    okk[e] = kkv[c] * eexc; orr[e] = rv[c] * ecum; obi[e] = b * inv; oki[e] = kd * inv; og[e] = ecum; }
                *(LAS f32x4*)(KKs + prow * 68 + 16 * jq + 4 * i) = okk; *(LAS f32x4*)(RRs + prow * 68 + 16 * jq + 4 * i) = orr;
                *(LAS f32x4*)(BIs + prow * 68 + 16 * jq + 4 * i) = obi; *(LAS f32x4*)(KIs + prow * 68 + 16 * jq + 4 * i) = oki;
                if (prow == 15) *(LAS f32x4*)(Gs + 16 * jq + 4 * i) = og; }
            LDS_WAIT(); asm volatile("" ::: "memory");
            unsigned char* rec = ws + (dir ? AR_CH1 : AR_CH0) + ((size_t)cg * 16 + h) * CH_REC;
            f32x4 aab = (f32x4){0.f, 0.f, 0.f, 0.f}, aak = aab, arb = aab, ark = aab;
#pragma unroll
            for (int jt = 0; jt < 4; ++jt) {
                const f32x4 kf = *(const LAS f32x4*)(KKs + tau * 68 + 16 * jt + 4 * jq), rf = *(const LAS f32x4*)(RRs + tau * 68 + 16 * jt + 4 * jq);
                const f32x4 bf_ = *(const LAS f32x4*)(BIs + tau * 68 + 16 * jt + 4 * jq), kif = *(const LAS f32x4*)(KIs + tau * 68 + 16 * jt + 4 * jq);
                const u32x2 kkp = pk4bf(kf.x, kf.y, kf.z, kf.w), rrp = pk4bf(rf.x, rf.y, rf.z, rf.w), bip = pk4bf(bf_.x, bf_.y, bf_.z, bf_.w), kip = pk4bf(kif.x, kif.y, kif.z, kif.w);
                aab = __builtin_amdgcn_mfma_f32_16x16x16bf16_1k(__builtin_bit_cast(bf16x4, bip), __builtin_bit_cast(bf16x4, kkp), aab, 0, 0, 0);
                aak = __builtin_amdgcn_mfma_f32_16x16x16bf16_1k(__builtin_bit_cast(bf16x4, kip), __builtin_bit_cast(bf16x4, kkp), aak, 0, 0, 0);
                arb = __builtin_amdgcn_mfma_f32_16x16x16bf16_1k(__builtin_bit_cast(bf16x4, bip), __builtin_bit_cast(bf16x4, rrp), arb, 0, 0, 0);
                ark = __builtin_amdgcn_mfma_f32_16x16x16bf16_1k(__builtin_bit_cast(bf16x4, kip), __builtin_bit_cast(bf16x4, rrp), ark, 0, 0, 0);
                *(u32x2*)(rec + CH_KK + (jt * 64 + lane) * 8) = kkp; *(u32x2*)(rec + CH_RR + (jt * 64 + lane) * 8) = rrp;
                const int jj = 16 * jt + tau; const float g = Gs[jj]; float nb[4], kt[4];
#pragma unroll
                for (int e = 0; e < 4; ++e) { nb[e] = -BIs[(4 * jq + e) * 68 + jj] * g; kt[e] = KIs[(4 * jq + e) * 68 + jj] * g; }
                *(u32x2*)(rec + CH_NBT + (jt * 64 + lane) * 8) = pk4bf(nb[0], nb[1], nb[2], nb[3]); *(u32x2*)(rec + CH_KT + (jt * 64 + lane) * 8) = pk4bf(kt[0], kt[1], kt[2], kt[3]);
            }
            if (lane < 16) *(f32x4*)(rec + CH_G + lane * 16) = *(const LAS f32x4*)(Gs + 4 * lane);
#pragma unroll
            for (int e = 0; e < 4; ++e) { const int sg = 4 * jq + e; if (!(sg < tau)) { aab[e] = 0.f; aak[e] = 0.f; } if (!(sg <= tau)) { arb[e] = 0.f; ark[e] = 0.f; } }
            *(u32x2*)(rec + CH_MAT + (0 * 64 + lane) * 8) = pk4bf(aak[0], aak[1], aak[2], aak[3]);
            *(u32x2*)(rec + CH_MAT + (2 * 64 + lane) * 8) = pk4bf(-arb[0], -arb[1], -arb[2], -arb[3]);
            *(u32x2*)(rec + CH_MAT + (3 * 64 + lane) * 8) = pk4bf(ark[0], ark[1], ark[2], ark[3]);
            LDS_WAIT(); asm volatile("" ::: "memory");
            *(LAS f32x4*)(As + tau * 20 + 4 * jq) = aab;
            LDS_WAIT(); asm volatile("" ::: "memory");
            float X[16];
#pragma unroll
            for (int t = 0; t < 16; ++t) { float x = (t == tau) ? 1.f : 0.f;
#pragma unroll
                for (int s4 = 0; s4 < (t + 3) / 4; ++s4) { const f32x4 l4 = *(const LAS f32x4*)(As + t * 20 + 4 * s4);
#pragma unroll
                    for (int e = 0; e < 4; ++e) if (4 * s4 + e < t) x -= l4[e] * X[4 * s4 + e]; }
                X[t] = x; }
            LDS_WAIT(); asm volatile("" ::: "memory");
#pragma unroll
            for (int t = 0; t < 16; ++t) As[t * 20 + tau] = X[t];
            LDS_WAIT(); asm volatile("" ::: "memory");
            { const f32x4 ti = *(const LAS f32x4*)(As + tau * 20 + 4 * jq); *(u32x2*)(rec + CH_MAT + (1 * 64 + lane) * 8) = pk4bf(ti.x, ti.y, ti.z, ti.w); }
        }
        if (dir == 1) { const float cbt = xor32_sum(xor16_sum(cbp)); if (jq == 0) CB[(size_t)tok * 16 + h] = cbt; }
    }
#undef PM_LOAD
}
constexpr int SC_SLOT = 11264 + 2048;
template <int NQ, int DEPTH> __device__ __forceinline__ void odd_scanc_unit(const Args& args, LAS uchar* ring, int s_, int h_, int dir_, int q0_, int lane) {
    const int s = uni(s_), h = uni(h_), dir = uni(dir_), q0 = uni(q0_);
    unsigned char* ws = opaque_ptr(args.ws);
    const int T = seq_T(s), r0 = seq_row0(s), nch = T / 16, cg0 = r0 / 16, fr = lane & 15, fq = lane >> 4;
    const __amdgpu_buffer_rsrc_t rsrc = __builtin_amdgcn_make_buffer_rsrc((void*)ws, 0, 0xffffffff, 0x00020000);
    const unsigned ch_base = (unsigned)(dir ? AR_CH1 : AR_CH0) + (unsigned)h * (unsigned)CH_REC, v_base = (unsigned)AR_V + (unsigned)h * 128u;
    const int voff_rec = lane * 16, voff_v = (lane >> 3) * 2048 + (lane & 7) * 16, voff_last = lane < 16 ? lane * 16 : (int)0xfffffff0u;
    bf16* Y = (bf16*)(ws + (dir ? AR_YB : AR_YF));
    f32x4 ST[NQ][4];
#pragma unroll
    for (int qi = 0; qi < NQ; ++qi)
#pragma unroll
        for (int jt = 0; jt < 4; ++jt) ST[qi][jt] = (f32x4){0.f, 0.f, 0.f, 0.f};
#define SC_DMA(c_) do { const int cl_ = (c_) < nch ? (c_) : nch - 1; const int cc_ = dir ? nch - 1 - cl_ : cl_; LAS uchar* slot_ = ring + ((c_) % DEPTH) * SC_SLOT; \
        const unsigned so_ = ch_base + (unsigned)(cg0 + cc_) * (unsigned)(16 * CH_REC); \
        _Pragma("unroll") for (int i = 0; i < 11; ++i) __builtin_amdgcn_raw_ptr_buffer_load_lds(rsrc, (LAS void*)(slot_ + i * 1024), 16, i < 10 ? voff_rec : voff_last, (int)(so_ + (unsigned)i * 1024u), 0, 0); \
        const unsigned sv_ = v_base + (unsigned)(r0 + 16 * cc_) * 2048u; \
        _Pragma("unroll") for (int k = 0; k < 2; ++k) __builtin_amdgcn_raw_ptr_buffer_load_lds(rsrc, (LAS void*)(slot_ + 11264 + k * 1024), 16, voff_v, (int)(sv_ + (unsigned)k * 16384u), 0, 0); } while (0)
#define SC_MFMA(a_, b_, c_) __builtin_amdgcn_mfma_f32_16x16x16bf16_1k(__builtin_bit_cast(bf16x4, (a_)), __builtin_bit_cast(bf16x4, (b_)), (c_), 0, 0, 0)
    static_assert(DEPTH >= 3 && (DEPTH - 1) * 13 <= 63, "ring depth: the counted wait must fit the 6-bit vmcnt");
#pragma unroll
    for (int c = 0; c < DEPTH - 1; ++c) SC_DMA(c);
    for (int c = 0; c < nch; ++c) {
        SC_DMA(c + DEPTH - 1);
        if constexpr (DEPTH == 5) asm volatile("s_waitcnt vmcnt(52)" ::: "memory");
        else if constexpr (DEPTH == 4) asm volatile("s_waitcnt vmcnt(39)" ::: "memory");
        else asm volatile("s_waitcnt vmcnt(26)" ::: "memory");
        const LAS uchar* slot = ring + (c % DEPTH) * SC_SLOT;
        u32x2 okk[4], orr[4], onb[4], okt[4], omat[4]; f32x4 og[4];
#pragma unroll
        for (int jt = 0; jt < 4; ++jt) { okk[jt] = *(const LAS u32x2*)(slot + CH_KK + jt * 512 + lane * 8); orr[jt] = *(const LAS u32x2*)(slot + CH_RR + jt * 512 + lane * 8); onb[jt] = *(const LAS u32x2*)(slot + CH_NBT + jt * 512 + lane * 8);
            okt[jt] = *(const LAS u32x2*)(slot + CH_KT + jt * 512 + lane * 8); omat[jt] = *(const LAS u32x2*)(slot + CH_MAT + jt * 512 + lane * 8); og[jt] = *(const LAS f32x4*)(slot + CH_G + (16 * jt + 4 * fq) * 4); }
        u32x2 vb[NQ];
#pragma unroll
        for (int qi = 0; qi < NQ; ++qi) { unsigned v_[4];
#pragma unroll
            for (int e = 0; e < 4; ++e) { const int t_ = 4 * fq + e; v_[e] = *(const LAS bf16*)(slot + 11264 + (dir ? 15 - t_ : t_) * 128 + (16 * (q0 + qi) + fr) * 2); }
            vb[qi].x = v_[0] | (v_[1] << 16); vb[qi].y = v_[2] | (v_[3] << 16); }
        LDS_WAIT(); asm volatile("" ::: "memory");
        LAS uchar* yst = (LAS uchar*)slot + 11264;
#pragma unroll
        for (int qi = 0; qi < NQ; ++qi) {
            u32x2 sb[4];
#pragma unroll
            for (int jt = 0; jt < 4; ++jt) sb[jt] = pk4bf(ST[qi][jt][0], ST[qi][jt][1], ST[qi][jt][2], ST[qi][jt][3]);
            f32x4 pa = (f32x4){0.f, 0.f, 0.f, 0.f}, pr = pa;
#pragma unroll
            for (int jt = 0; jt < 4; ++jt) { pa = SC_MFMA(okk[jt], sb[jt], pa); pr = SC_MFMA(orr[jt], sb[jt], pr); }
            const f32x4 x = SC_MFMA(omat[0], vb[qi], pa);
            const u32x2 xb = pk4bf(x[0], x[1], x[2], x[3]);
            const f32x4 u = SC_MFMA(omat[1], xb, ((f32x4){0.f, 0.f, 0.f, 0.f}));
            const u32x2 ub = pk4bf(u[0], u[1], u[2], u[3]);
            f32x4 y = SC_MFMA(omat[2], ub, pr); y = SC_MFMA(omat[3], vb[qi], y);
#pragma unroll
            for (int jt = 0; jt < 4; ++jt) { f32x4 t = ST[qi][jt] * og[jt]; t = SC_MFMA(onb[jt], ub, t); ST[qi][jt] = SC_MFMA(okt[jt], vb[qi], t); }
#pragma unroll
            for (int e = 0; e < 4; ++e) { const int t_ = 4 * fq + e; *(LAS bf16*)(yst + (dir ? 15 - t_ : t_) * 128 + (16 * (q0 + qi) + fr) * 2) = (bf16)(pk2(y[e], 0.f) & 0xffffu); }
        }
        LDS_WAIT(); asm volatile("" ::: "memory");
        { const int cc = dir ? nch - 1 - c : c;
          if (NQ == 4) { const u32x4 a = *(const LAS u32x4*)(yst + (lane >> 2) * 128 + (lane & 3) * 32), b = *(const LAS u32x4*)(yst + (lane >> 2) * 128 + (lane & 3) * 32 + 16);
              u32x4* dst = (u32x4*)(Y + (size_t)(r0 + 16 * cc + (lane >> 2)) * D + h * 64 + (lane & 3) * 16); dst[0] = a; dst[1] = b; }
          else { const u32x4 a = *(const LAS u32x4*)(yst + (lane >> 2) * 128 + q0 * 32 + (lane & 3) * 16);
              *(u32x4*)(Y + (size_t)(r0 + 16 * cc + (lane >> 2)) * D + h * 64 + q0 * 16 + (lane & 3) * 8) = a; } }
    }
    asm volatile("s_waitcnt vmcnt(0)" ::: "memory");
#undef SC_DMA
#undef SC_MFMA
}
__device__ __forceinline__ void odd_scanc(const Args& args, LAS uchar* lds, int wave, int lane) {
    const int bx = blockIdx.x;
    volatile LAS unsigned* st = (volatile LAS unsigned*)(lds + MISC_OFF) + 8;
    unsigned st0 = 0u, st1 = 0u;
    if (wave == 0 && lane == 0) { st0 = st[0]; st1 = st[1]; }
    __syncthreads();
    if (bx < 256 && wave < 3) {
        if (wave == 0) { const int sidp = (bx >> 4) * 8 + (bx & 7), half = (bx >> 3) & 1;
            odd_scanc_unit<2, 5>(args, lds, sidp >> 5, (sidp >> 1) & 15, sidp & 1, 2 * half, lane); }
        else { const int sid = 2 * bx + (wave - 1); odd_scanc_unit<4, 3>(args, lds + 5 * SC_SLOT + (wave - 1) * (3 * SC_SLOT), 4 + (sid >> 5), (sid >> 1) & 15, sid & 1, 0, lane); }
    }
    __syncthreads();
    if (wave == 0 && lane == 0) { st[0] = st0; st[1] = st1; }
}
static_assert(11 * SC_SLOT <= LDS_BYTES, "scan rings");

__device__ __forceinline__ void moe_topk(const Args& args, LAS uchar* lds, int layer, int G, int wave_sgpr_) {
    if (opaque_bx() >= 32) {
        { const int tz = opaque_tid(), wv = uni(tz >> 6); moe_weights(args, layer, (LAS float*)(lds + wv * 16384), (opaque_bx() - 32) * NWAVES + wv, (G - 32) * NWAVES, tz & 63); }
        return;
    }
    unsigned char* ws = opaque_ptr(args.ws);
    const int g = opaque_bx() >> 4, e = opaque_bx() & 15, n = g ? NS : NP, cap = n / 8, base = g ? NP : 0, slotbase = g ? NP * 2 + e * 4096 : e * 2048;
    const float* aff = (const float*)(ws + WS_AFF) + (size_t)e * NTOK + base;
    int* IDX = (int*)(ws + WS_IDX) + slotbase; float* GATE = (float*)(ws + WS_GATE) + slotbase; int* INV = (int*)(ws + WS_INV);
    LAS unsigned* keys = (LAS unsigned*)lds;
    LAS unsigned* hist = (LAS unsigned*)(lds + XLDS_OFF);
    LAS unsigned* sh = hist + 256;
    const int tid = opaque_tid(), wave = tid >> 6, lane = tid & 63;
    for (int i = tid; i < n / 4; i += 512) ((LAS u32x4*)keys)[i] = ((const u32x4*)aff)[i];
    unsigned prefix = 0u, mask = 0u; int need = cap;
    for (int pass = 0; pass < 4; ++pass) {
        const int shift = 24 - 8 * pass;
        if (tid < 256) hist[tid] = 0u;
        __syncthreads();
        for (int i = tid; i < n; i += 512) { const unsigned k = keys[i]; if ((k & mask) == prefix) __hip_atomic_fetch_add(&hist[(k >> shift) & 255u], 1u, __ATOMIC_RELAXED, __HIP_MEMORY_SCOPE_WORKGROUP); }
        __syncthreads();
        if (wave == 0) {
            const int b0 = 255 - 4 * lane;
            const int h0 = (int)hist[b0], h1 = (int)hist[b0 - 1], h2 = (int)hist[b0 - 2], h3 = (int)hist[b0 - 3];
            const int tot = h0 + h1 + h2 + h3; int inc = tot;
#pragma unroll
            for (int d = 1; d < 64; d <<= 1) { const int t = __builtin_amdgcn_ds_bpermute(((lane - d) & 63) << 2, inc); if (lane >= d) inc += t; }
            const unsigned long long hitm = __ballot(inc >= need);
            const int Lh = hitm ? (int)__builtin_ctzll(hitm) : 63;
            if (lane == Lh) { int cum = inc - tot, b = b0;
                if (cum + h0 < need) { cum += h0; b = b0 - 1; if (cum + h1 < need) { cum += h1; b = b0 - 2; if (cum + h2 < need) { cum += h2; b = b0 - 3; } } }
                sh[0] = prefix | ((unsigned)b << shift); sh[1] = (unsigned)(need - cum); }
        }
        __syncthreads();
        prefix = sh[0]; need = (int)sh[1]; mask |= 255u << shift;
        __syncthreads();
    }
    const unsigned T = prefix;
    const int seg = n / 8, s0 = wave * seg;
    int cgt = 0, ceq = 0;
    for (int i = s0 + lane; i < s0 + seg; i += 64) { const unsigned k = keys[i]; cgt += (k > T); ceq += (k == T); }
    cgt = (int)wave_sum((float)cgt); ceq = (int)wave_sum((float)ceq);
    if (lane == 0) { sh[8 + wave] = (unsigned)cgt; sh[24 + wave] = (unsigned)ceq; }
    __syncthreads();
    int gtb = 0, eqb = 0;
    for (int w = 0; w < wave; ++w) { gtb += (int)sh[8 + w]; eqb += (int)sh[24 + w]; }
    for (int i0 = s0; i0 < s0 + seg; i0 += 64) {
        const int i = i0 + lane; const unsigned k = keys[i];
        const bool isgt = k > T, iseq = k == T;
        const unsigned long long mg = __ballot(isgt), me = __ballot(iseq);
        const unsigned long long lt = (lane == 0) ? 0ull : (~0ull >> (64 - lane));
        const int gbef = gtb + __popcll(mg & lt), ebef = eqb + __popcll(me & lt);
        const bool sel = isgt || (iseq && ebef < need);
        const int slot = gbef + (ebef < need ? ebef : need);
        if (sel) { IDX[slot] = base + i; GATE[slot] = __uint_as_float(k); }
        INV[(size_t)(base + i) * 16 + e] = sel ? slot : -1;
        gtb += __popcll(mg); eqb += __popcll(me);
    }
}
__device__ __forceinline__ void moe_gather(const Args& args, int gw, int NGW, int lane) {
    unsigned char* ws = opaque_ptr(args.ws); const int* IDX = (const int*)(ws + WS_IDX); const bf16* XB = (const bf16*)(ws + WS_XB); uchar* XE = ws + AR_XE;
    if (!MOE_FP8) { for (int sl = gw; sl < NSLOT; sl += NGW) { const int r = IDX[sl];
        const u32x4 a = *((const u32x4*)(XB + (size_t)r * D) + lane), b = *((const u32x4*)(XB + (size_t)r * D) + 64 + lane);
        *((u32x4*)((bf16*)XE + (size_t)sl * D) + lane) = a; *((u32x4*)((bf16*)XE + (size_t)sl * D) + 64 + lane) = b; } return; }
    constexpr int NG4 = NSLOT / 4;
    i32x4 nid = (i32x4){0, 0, 0, 0};
    if (gw < NG4) nid = *((const i32x4*)IDX + gw);
    for (int gi = gw; gi < NG4; gi += NGW) {
        const i32x4 id = nid;
        u32x4 a[4][2];
#pragma unroll
        for (int k = 0; k < 4; ++k) { const u32x4* p = (const u32x4*)(XB + (size_t)id[k] * D + 16 * lane); a[k][0] = p[0]; a[k][1] = p[1]; }
        if (gi + NGW < NG4) nid = *((const i32x4*)IDX + gi + NGW);
#pragma unroll
        for (int k = 0; k < 4; ++k) { float v[16]; unpack16r(a[k][0], a[k][1], v);
            u32x4 o; o.x = pk4_fp8(v[0], v[1], v[2], v[3]); o.y = pk4_fp8(v[4], v[5], v[6], v[7]); o.z = pk4_fp8(v[8], v[9], v[10], v[11]); o.w = pk4_fp8(v[12], v[13], v[14], v[15]);
            *((u32x4*)(XE + (size_t)(4 * gi + k) * D) + lane) = o; }
    }
}

constexpr int N_PHASES = 3 + 2 * (6 + 8) + 2 * (8 + 8) - 4 * MOE_GATHER_FUSED;
#ifndef MK_STOP
#define MK_STOP 0
#endif
__global__ void __launch_bounds__(NWAVES * 64, 2) enc_fwd(Args args) {
    extern __shared__ __attribute__((aligned(16))) unsigned char lds_raw[];
    LAS uchar* lds = (LAS uchar*)lds_raw;
    volatile LAS unsigned* MISC = (volatile LAS unsigned*)(lds + MISC_OFF);
    const int tid = threadIdx.x, lane = tid & 63, wave = uni(tid >> 6);
    const int wave_sgpr_ = wave;
    const int G = gridDim.x; const int bx = blockIdx.x; const int vcu = (G % 8 == 0) ? (bx % 8) * (G / 8) + bx / 8 : bx;
    const int gw = vcu * NWAVES + wave, NGW = G * NWAVES;
    unsigned char* ws = opaque_ptr(args.ws);
    if (tid < 16) MISC[tid] = 0u;
    __syncthreads();
    XcdBarrier bar; bar.bar = (unsigned*)(ws + WS_CTL) + CW_BAR; bar.x = 0; bar.st = nullptr;
    const int lo = args.ph_lo, hi = args.ph_hi;
    if (hi - lo > 1) bar = xcd_barrier_post((unsigned*)(ws + WS_CTL) + CW_BAR, MISC + 8);
    const GPhase* gph = (const GPhase*)(ws + WS_GPH); const GP* gpt = (const GP*)(ws + WS_GPT);
    int ph = 0;
#ifndef ONLY
#define ONLY 0
#endif
#ifndef REP_MASK
#define REP_MASK 0
#endif
#define REPS(K) (((REP_MASK >> (K)) & 1) ? 2 : 1)
#define PHASE_BEGIN if (lo <= ph && ph < hi) { const int tz_ = opaque_tid(); const int lane = tz_ & 63, wave = uni(tz_ >> 6), gw = vcu * NWAVES + wave; (void)lane; (void)gw;
#define PHASE_END   if (ph + 1 < hi) xcd_barrier(bar, opaque_tid() == 0); } ++ph;
#define GEMM(kind, id) pg8::gemm_phase<kind, false>(lds, lds + XLDS_OFF, gph + (id), gpt, G, opaque_bx(), ws, wave_sgpr_)
#define GEMM8(kind, id) pg8::gemm_phase<kind, true>(lds, lds + XLDS_OFF, gph + (id), gpt, G, opaque_bx(), ws, wave_sgpr_)

    PHASE_BEGIN if (ONLY == 0 || ONLY == 1) for (int rep_ = 0; rep_ < REPS(1); ++rep_) { prologue(args, lds, gw, NGW, wave, lane); } PHASE_END
    PHASE_BEGIN if (ONLY == 0 || ONLY == 2 || ONLY == 13) for (int rep_ = 0; rep_ < REPS(2); ++rep_) { GEMM(EPI_BF16, GPH_PRO); } PHASE_END
    PHASE_BEGIN if (ONLY == 0 || ONLY == 2 || ONLY == 13) for (int rep_ = 0; rep_ < REPS(2); ++rep_) { GEMM(EPI_BF16, GPH_PRO2); } PHASE_END
#pragma unroll 1
    for (int L = 0; L < 4; ++L) {
        const int j = L >> 1;
        if ((L & 1) == 0) {
            PHASE_BEGIN if (ONLY == 0 || ONLY == 2) for (int rep_ = 0; rep_ < REPS(2); ++rep_) { GEMM(EPI_BF16, L * 9 + 0); } PHASE_END
            PHASE_BEGIN if (ONLY == 0 || ONLY == 3) for (int rep_ = 0; rep_ < REPS(3); ++rep_) { even_phase_a(args, lds, j, G, wave_sgpr_); } PHASE_END
            PHASE_BEGIN if (ONLY == 0 || ONLY == 4) even_phase_b(args, G, wave_sgpr_); PHASE_END
            PHASE_BEGIN if (ONLY == 0 || ONLY == 5) for (int rep_ = 0; rep_ < REPS(5); ++rep_) { even_phase_c(args, lds, j, G, wave_sgpr_); } PHASE_END
            PHASE_BEGIN if (ONLY == 0 || ONLY == 2) for (int rep_ = 0; rep_ < REPS(16); ++rep_) { GEMM(EPI_RESID, L * 9 + 2); } PHASE_END
            PHASE_BEGIN if (ONLY == 0 || ONLY == 6) for (int rep_ = 0; rep_ < REPS(6); ++rep_) { ln_phase(args, lds, L, 0, 0, false, gw, NGW, wave, lane); } PHASE_END
        } else {
            PHASE_BEGIN if (ONLY == 0 || ONLY == 7) for (int rep_ = 0; rep_ < REPS(7); ++rep_) { odd_shiftmix(args, j, gw, NGW, lane); } PHASE_END
            PHASE_BEGIN if (ONLY == 0 || ONLY == 2) for (int rep_ = 0; rep_ < REPS(2); ++rep_) { GEMM(EPI_BF16, L * 9 + 0); } PHASE_END
            PHASE_BEGIN if (ONLY == 0 || ONLY == 2) for (int rep_ = 0; rep_ < REPS(2); ++rep_) { GEMM(EPI_BF16, L * 9 + 1); } PHASE_END
#if !SCAN_CHUNKED
            PHASE_BEGIN if (ONLY == 0 || ONLY == 8) for (int rep_ = 0; rep_ < REPS(8); ++rep_) { odd_prep(args, j, gw, NGW, lane); } PHASE_END
#endif
#if SCAN_CHUNKED
            PHASE_BEGIN if (ONLY == 0 || ONLY == 9) for (int rep_ = 0; rep_ < REPS(9); ++rep_) {
                volatile LAS unsigned* st_ = (volatile LAS unsigned*)(lds + MISC_OFF) + 8; unsigned st0_ = 0u, st1_ = 0u;
                if (tid == 0) { st0_ = st_[0]; st1_ = st_[1]; }
                __syncthreads();
                odd_prepm(args, lds, j, gw, NGW, wave, lane);
                __syncthreads();
                if (tid == 0) { st_[0] = st0_; st_[1] = st1_; } } PHASE_END
            PHASE_BEGIN if (ONLY == 0 || ONLY == 9) for (int rep_ = 0; rep_ < REPS(19); ++rep_) { odd_scanc(args, lds, wave, lane); } PHASE_END
#else
            PHASE_BEGIN if (ONLY == 0 || ONLY == 9) for (int rep_ = 0; rep_ < REPS(9); ++rep_) { odd_scan(args, lds, G, wave, lane, rep_ == 1); } PHASE_END
#endif
            PHASE_BEGIN if (ONLY == 0 || ONLY == 10) for (int rep_ = 0; rep_ < REPS(10); ++rep_) { odd_post(args, j, gw, NGW, lane); } PHASE_END
            PHASE_BEGIN if (ONLY == 0 || ONLY == 2) for (int rep_ = 0; rep_ < REPS(16); ++rep_) { GEMM(EPI_RESID, L * 9 + 2); } PHASE_END
            PHASE_BEGIN if (ONLY == 0 || ONLY == 6) for (int rep_ = 0; rep_ < REPS(6); ++rep_) { ln_phase(args, lds, L, 0, 0, false, gw, NGW, wave, lane); } PHASE_END
        }
        PHASE_BEGIN if (ONLY == 0 || ONLY == 2) for (int rep_ = 0; rep_ < REPS(17); ++rep_) { GEMM(EPI_SOFTMAX, L * 9 + 3); } PHASE_END
        PHASE_BEGIN if (ONLY == 0 || ONLY == 2) for (int rep_ = 0; rep_ < REPS(16); ++rep_) { GEMM(EPI_RESID, L * 9 + 6); } PHASE_END
        PHASE_BEGIN if (ONLY == 0 || ONLY == 6) for (int rep_ = 0; rep_ < REPS(6); ++rep_) { ln_phase(args, lds, L, 1, 1, false, gw, NGW, wave, lane); } PHASE_END
        PHASE_BEGIN if (ONLY == 0 || ONLY == 11) for (int rep_ = 0; rep_ < REPS(11); ++rep_) { moe_topk(args, lds, L, G, wave_sgpr_); } PHASE_END
#if !MOE_GATHER_FUSED
        PHASE_BEGIN if (ONLY == 0 || ONLY == 12) for (int rep_ = 0; rep_ < REPS(12); ++rep_) { moe_gather(args, gw, NGW, lane); } PHASE_END
#endif
        PHASE_BEGIN if (ONLY == 0 || ONLY == 2 || ONLY == 14) for (int rep_ = 0; rep_ < REPS(18); ++rep_) { if (MOE_FP8) GEMM8(EPI_SWIGLU, L * 9 + 7); else GEMM(EPI_SWIGLU, L * 9 + 7); } PHASE_END
        PHASE_BEGIN if (ONLY == 0 || ONLY == 2 || ONLY == 15) for (int rep_ = 0; rep_ < REPS(18); ++rep_) { if (MOE_FP8) GEMM8(EPI_ROWSCALE, L * 9 + 8); else GEMM(EPI_ROWSCALE, L * 9 + 8); } PHASE_END
        PHASE_BEGIN if (ONLY == 0 || ONLY == 6) ln_phase(args, lds, L, 2, 2, L == 3, gw, NGW, wave, lane); PHASE_END
    }
}

extern "C" void kernel_launch(void* const* d_in, const int* in_sizes, int n_in, void* d_out, int out_size, void* d_ws, size_t ws_size, hipStream_t stream) {
    static int grid = 0;
    if (grid == 0) {
        if (n_in != 33 || out_size != NTOK * D || ws_size < WS_END) { fprintf(stderr, "kernel_launch: unexpected shapes (n_in %d out %d ws %zu need %zu)\n", n_in, out_size, ws_size, (size_t)WS_END); grid = -1; return; }
        int dev = 0, cus = 0, per_cu = 0;
        if (hipGetDevice(&dev) != hipSuccess || hipDeviceGetAttribute(&cus, hipDeviceAttributeMultiprocessorCount, dev) != hipSuccess) { grid = -1; return; }
        if (hipFuncSetAttribute((const void*)enc_fwd, hipFuncAttributeMaxDynamicSharedMemorySize, LDS_BYTES) != hipSuccess) { fprintf(stderr, "kernel_launch: hipFuncSetAttribute failed\n"); grid = -1; return; }
        if (hipOccupancyMaxActiveBlocksPerMultiprocessor(&per_cu, (const void*)enc_fwd, NWAVES * 64, LDS_BYTES) != hipSuccess || per_cu < 1) fprintf(stderr, "kernel_launch: occupancy query says %d\n", per_cu);
        (void)hipGetLastError();
        grid = cus;
        if (grid != 256) fprintf(stderr, "kernel_launch: %d CUs (built for 256)\n", grid);
    }
    if (grid < 0) return;
    if (hipMemsetAsync((char*)d_ws + WS_CTL, 0, CTL_ZERO_BYTES, stream) != hipSuccess) return;
    Args a{};
    for (int i = 0; i < 33; ++i) a.in[i] = (const float*)d_in[i];
    a.out = (float*)d_out; a.ws = (unsigned char*)d_ws;
#if MK_PER_PHASE
    for (int p = 0; p < N_PHASES; ++p) { a.ph_lo = p; a.ph_hi = p + 1; hipLaunchKernelGGL(enc_fwd, dim3(grid), dim3(NWAVES * 64), LDS_BYTES, stream, a); }
#else
    a.ph_lo = 0; a.ph_hi = N_PHASES;
    hipLaunchKernelGGL(enc_fwd, dim3(grid), dim3(NWAVES * 64), LDS_BYTES, stream, a);
#endif
}
```

```cpp
#include <hip/hip_runtime.h>
#include <cstdio>
#include <cstdint>

#ifndef MOE_FP8
#define MOE_FP8 1
#endif
#ifndef RESID_BF16
#define RESID_BF16 1
#endif
#ifndef Z_BF16
#define Z_BF16 1
#endif
#ifndef SCAN_CHUNKED
#define SCAN_CHUNKED 1
#endif
#ifndef MOE_GATHER_FUSED
#define MOE_GATHER_FUSED 1
#endif
#ifndef MK_PER_PHASE
#define MK_PER_PHASE 0
#endif

#define GAS __attribute__((address_space(1)))
#define LAS __attribute__((address_space(3)))
typedef unsigned short bf16;
typedef unsigned char uchar;
typedef unsigned u32x4 __attribute__((ext_vector_type(4)));
typedef int i32x4 __attribute__((ext_vector_type(4)));
typedef unsigned u32x2 __attribute__((ext_vector_type(2)));
typedef float f32x4 __attribute__((ext_vector_type(4)));
typedef float f32x2 __attribute__((ext_vector_type(2)));
typedef short bf16x8 __attribute__((ext_vector_type(8)));
typedef int v4i_t __attribute__((ext_vector_type(4)));
typedef int v8i_t __attribute__((ext_vector_type(8)));

constexpr int D = 1024, NP = 16384, NS = 32768, NTOK = NP + NS;
constexpr int NSEQ = 20, NCHUNK = NTOK / 64;
constexpr int DIN = 4608;
constexpr int NSLOT = 2 * NTOK;
constexpr float DN_ALPHA = 1.6817928305074292f;
constexpr float LN_EPS = 1e-5f;
constexpr int NWAVES = 8;

constexpr size_t MiB = 1u << 20;
constexpr size_t WS_CTL = 0, CTL_ZERO_BYTES = 1 * MiB;
constexpr size_t WS_GPH = 1 * MiB;
constexpr size_t WS_GPT = 1 * MiB + 65536;
constexpr size_t WS_ROT = 2 * MiB;
constexpr size_t WS_W_EIN = 4 * MiB;
constexpr size_t SZ_W_EIN = (size_t)2 * DIN * D * 2;
constexpr size_t WS_W_EOUT = WS_W_EIN + SZ_W_EIN;
constexpr size_t WS_W_RKV = WS_W_EOUT + (size_t)2 * D * D * 2;
constexpr size_t WS_W_L1 = WS_W_RKV + (size_t)6 * D * D * 2;
constexpr size_t WS_W_L2W = WS_W_L1 + (size_t)6 * 256 * D * 2;
constexpr size_t WS_W_L2A = WS_W_L2W + (size_t)2 * 2048 * 256 * 2;
constexpr size_t WS_W_L2G = WS_W_L2A + (size_t)2 * 2048 * 256 * 2;
constexpr size_t WS_W_OOUT = WS_W_L2G + (size_t)2 * 1024 * 256 * 2;
constexpr size_t WS_W_CQ = WS_W_OOUT + (size_t)2 * D * D * 2;
constexpr size_t WS_W_CKV = WS_W_CQ + (size_t)4 * D * D * 2;
constexpr size_t WS_W_CO = WS_W_CKV + (size_t)4 * 2048 * D * 2;
constexpr size_t WS_W_MIN = WS_W_CO + (size_t)4 * D * D * 2;
constexpr size_t WS_W_MOUT = WS_W_MIN + (size_t)64 * 4096 * D * 2;
constexpr size_t WS_MEMB = WS_W_MOUT + (size_t)64 * D * 2048 * 2;
constexpr size_t WS_KMEM = WS_MEMB + (size_t)5120 * D * 2;
constexpr size_t WS_VT = WS_KMEM + (size_t)4 * 5120 * D * 2;
constexpr size_t WS_X32 = WS_VT + (size_t)4 * 20 * 1024 * 256 * 2;
constexpr size_t WS_Z32 = WS_X32 + (size_t)NTOK * D * 4;
constexpr size_t WS_XB = WS_Z32 + (size_t)NTOK * D * 4;
constexpr size_t WS_AFF = WS_XB + (size_t)NTOK * D * 2;
constexpr size_t WS_IDX = WS_AFF + (size_t)16 * NTOK * 4;
constexpr size_t WS_GATE = WS_IDX + (size_t)NSLOT * 4;
constexpr size_t WS_INV = WS_GATE + (size_t)NSLOT * 4;
constexpr size_t WS_ARENA = WS_INV + (size_t)NTOK * 16 * 4;
static_assert(MOE_FP8 == 1 && RESID_BF16 == 1, "the folded cross-attention operands live in the halves of the MoE weight regions that fp8 leaves free and in the unused f32 residual buffer");
constexpr size_t WS_MQ = WS_W_MIN + (size_t)64 * 4096 * D;
constexpr size_t WS_WQN = WS_W_MOUT + (size_t)64 * D * 2048;
constexpr size_t WS_VW = WS_X32;
constexpr size_t WS_VMEM = WS_VT;
constexpr size_t AR_PROJ = WS_ARENA;
constexpr size_t AR_ST = AR_PROJ + (size_t)NTOK * DIN * 2;
constexpr size_t AR_DEC = AR_ST + (size_t)4 * NCHUNK * 4 * 16384 * 4;
constexpr size_t AR_OME = AR_DEC + (size_t)4 * NCHUNK * 4 * 128 * 4;
constexpr size_t AR_EVEN_END = AR_OME + (size_t)NTOK * D * 2;
constexpr size_t AR_XM = WS_ARENA;
constexpr size_t AR_H1 = AR_XM + (size_t)6 * NTOK * D * 2;
constexpr size_t AR_SCN = WS_ARENA;
constexpr size_t AR_RKV = AR_SCN + (size_t)NTOK * 16 * 1280;
constexpr size_t AR_LW = AR_RKV + (size_t)2 * NTOK * D * 2;
constexpr size_t AR_LA = AR_LW + (size_t)NTOK * 2048 * 2;
constexpr size_t AR_V = AR_LA + (size_t)NTOK * 2048 * 2;
constexpr size_t AR_GG = AR_V + (size_t)NTOK * D * 2;
constexpr size_t AR_YF = AR_GG + (size_t)NTOK * D * 2;
constexpr size_t AR_YB = AR_YF + (size_t)NTOK * D * 2;
constexpr size_t AR_CB = AR_YB + (size_t)NTOK * D * 2;
constexpr size_t AR_OMO = AR_CB + (size_t)NTOK * 16 * 4;
constexpr size_t CH_KK = 0, CH_RR = 2048, CH_NBT = 4096, CH_KT = 6144, CH_MAT = 8192, CH_G = 10240, CH_REC = 10496;
constexpr size_t AR_CH0 = AR_OMO + (size_t)NTOK * D * 2;
constexpr size_t AR_CH1 = AR_SCN;
constexpr size_t CH_BYTES = (size_t)(NTOK / 16) * 16 * CH_REC;
static_assert(AR_CH1 + CH_BYTES <= AR_RKV, "direction-1 chunk records fit in the SCN area");
constexpr size_t AR_ODD_END = AR_CH0 + CH_BYTES;
static_assert(AR_ODD_END < ((size_t)1 << 32), "32-bit buffer offsets");
static_assert(AR_H1 + (size_t)NTOK * 768 * 2 <= AR_RKV, "XM+H1 inside the SCN overlay region");
constexpr size_t AR_Q = WS_ARENA;
constexpr size_t AR_P = AR_Q + (size_t)NTOK * D * 2;
constexpr size_t AR_O = AR_P + (size_t)NTOK * D * 2;
constexpr size_t AR_XE = WS_ARENA;
constexpr size_t AR_HACT = AR_XE + (size_t)NSLOT * D * 2;
constexpr size_t AR_YE = AR_HACT + (size_t)NSLOT * 2048 * 2;
constexpr size_t AR_MOE_END = AR_YE + (size_t)NSLOT * D * 2;
constexpr size_t WS_END = AR_ODD_END > AR_EVEN_END ? (AR_ODD_END > AR_MOE_END ? AR_ODD_END : AR_MOE_END) : (AR_EVEN_END > AR_MOE_END ? AR_EVEN_END : AR_MOE_END);

constexpr int CW_BAR = 4096;

constexpr int RING_BYTES = 131072;
constexpr int XLDS_OFF = RING_BYTES;
constexpr int MISC_OFF = RING_BYTES + 8192;
constexpr int LDS_BYTES = 163840;

__device__ __forceinline__ float bf2f(unsigned short b) { return __uint_as_float(((unsigned)b) << 16); }
__device__ __forceinline__ float bflo(unsigned w) { return __uint_as_float(w << 16); }
__device__ __forceinline__ float bfhi(unsigned w) { return __uint_as_float(w & 0xffff0000u); }
__device__ __forceinline__ unsigned f2bf(float f) { unsigned u = __float_as_uint(f); return (u + 0x7fffu + ((u >> 16) & 1u)) >> 16; }
__device__ __forceinline__ unsigned short f2bf_hw(float f) { const f32x2 v = {f, 0.f}; typedef __bf16 bfx2_ __attribute__((ext_vector_type(2))); const bfx2_ b = __builtin_convertvector(v, bfx2_); return (unsigned short)__builtin_bit_cast(unsigned, b); }
typedef __bf16 bf16x2_t __attribute__((ext_vector_type(2)));
__device__ __forceinline__ unsigned pk2(float lo, float hi) { const f32x2 v = {lo, hi}; const bf16x2_t b = __builtin_convertvector(v, bf16x2_t); return __builtin_bit_cast(unsigned, b); }
__device__ __forceinline__ unsigned pk4_fp8(float a, float b, float c, float d) { int r = __builtin_amdgcn_cvt_pk_fp8_f32(a, b, 0, false); r = __builtin_amdgcn_cvt_pk_fp8_f32(c, d, r, true); return (unsigned)r; }
__device__ __forceinline__ int uni(int v) { return __builtin_amdgcn_readfirstlane(v); }
__device__ __forceinline__ int lane_id_hw() { return (int)__builtin_amdgcn_mbcnt_hi(~0u, __builtin_amdgcn_mbcnt_lo(~0u, 0u)); }
#define opaque_tid() opaque_tid_(wave_sgpr_)
__device__ __forceinline__ int opaque_tid_(int wave_s) { int l; asm volatile("v_mbcnt_lo_u32_b32 %0, -1, 0\n\tv_mbcnt_hi_u32_b32 %0, -1, %0" : "=v"(l)); return wave_s * 64 + l; }
__device__ __forceinline__ int opaque_bx() { int b = blockIdx.x; asm volatile("" : "+s"(b)); return b; }
__device__ __forceinline__ unsigned char* opaque_ptr(unsigned char* p) { GAS unsigned char* g = (GAS unsigned char*)p; asm volatile("" : "+s"(g)); return (unsigned char*)g; }
template <class T> __device__ __forceinline__ T* uniptr(T* p) { unsigned long long v = (unsigned long long)p; unsigned lo = (unsigned)uni((int)(unsigned)v), hi = (unsigned)uni((int)(unsigned)(v >> 32)); return (T*)(((unsigned long long)hi << 32) | lo); }
typedef unsigned u32x2v_ __attribute__((ext_vector_type(2)));
#ifndef SAFE_SHFL
#define SAFE_SHFL 1
#endif
#if SAFE_SHFL
__device__ __forceinline__ float shx(float v, int o, int lane) { return __builtin_bit_cast(float, __builtin_amdgcn_ds_bpermute((lane ^ o) << 2, __builtin_bit_cast(int, v))); }
#define xor16_sum(v) xor16_sum_((v), lane)
#define xor32_sum(v) xor32_sum_((v), lane)
#define xor16_max(v) xor16_max_((v), lane)
#define xor32_max(v) xor32_max_((v), lane)
#define wave_sum(v) wave_sum_((v), lane)
__device__ __forceinline__ float xor16_sum_(float v, int lane) { return v + shx(v, 16, lane); }
__device__ __forceinline__ float xor32_sum_(float v, int lane) { return v + shx(v, 32, lane); }
__device__ __forceinline__ float xor16_max_(float v, int lane) { return fmaxf(v, shx(v, 16, lane)); }
__device__ __forceinline__ float xor32_max_(float v, int lane) { return fmaxf(v, shx(v, 32, lane)); }
__device__ __forceinline__ float wave_sum_(float v, int lane) {
#pragma unroll
    for (int o = 1; o < 64; o <<= 1) v += shx(v, o, lane);
    return v;
}
#else
__device__ __forceinline__ float xor16_sum(float v) { const unsigned x = __builtin_bit_cast(unsigned, v); const u32x2v_ r = __builtin_amdgcn_permlane16_swap(x, x, false, false); return __builtin_bit_cast(float, r.x) + __builtin_bit_cast(float, r.y); }
__device__ __forceinline__ float xor32_sum(float v) { const unsigned x = __builtin_bit_cast(unsigned, v); const u32x2v_ r = __builtin_amdgcn_permlane32_swap(x, x, false, false); return __builtin_bit_cast(float, r.x) + __builtin_bit_cast(float, r.y); }
__device__ __forceinline__ float xor16_max(float v) { const unsigned x = __builtin_bit_cast(unsigned, v); const u32x2v_ r = __builtin_amdgcn_permlane16_swap(x, x, false, false); return fmaxf(__builtin_bit_cast(float, r.x), __builtin_bit_cast(float, r.y)); }
__device__ __forceinline__ float xor32_max(float v) { const unsigned x = __builtin_bit_cast(unsigned, v); const u32x2v_ r = __builtin_amdgcn_permlane32_swap(x, x, false, false); return fmaxf(__builtin_bit_cast(float, r.x), __builtin_bit_cast(float, r.y)); }
__device__ __forceinline__ float wave_sum(float v) {
    v += __builtin_bit_cast(float, __builtin_amdgcn_mov_dpp(__builtin_bit_cast(int, v), 0xB1, 0xF, 0xF, true));
    v += __builtin_bit_cast(float, __builtin_amdgcn_mov_dpp(__builtin_bit_cast(int, v), 0x4E, 0xF, 0xF, true));
    v += __builtin_bit_cast(float, __builtin_amdgcn_mov_dpp(__builtin_bit_cast(int, v), 0x141, 0xF, 0xF, true));
    v += __builtin_bit_cast(float, __builtin_amdgcn_mov_dpp(__builtin_bit_cast(int, v), 0x140, 0xF, 0xF, true));
    return xor32_sum(xor16_sum(v));
}
#endif
__device__ __forceinline__ float quad_sum(float v) {
    v += __builtin_bit_cast(float, __builtin_amdgcn_mov_dpp(__builtin_bit_cast(int, v), 0xB1, 0xF, 0xF, true));
    v += __builtin_bit_cast(float, __builtin_amdgcn_mov_dpp(__builtin_bit_cast(int, v), 0x4E, 0xF, 0xF, true));
    return v;
}
__device__ __forceinline__ float exp_(float x) { return __builtin_amdgcn_exp2f(x * 1.4426950408889634f); }
__device__ __forceinline__ float log_(float x) { return __builtin_amdgcn_logf(x) * 0.6931471805599453f; }
__device__ __forceinline__ float sigmoidf_(float x) { return __builtin_amdgcn_rcpf(1.f + exp_(-x)); }
__device__ __forceinline__ float siluf_(float x) { return x * __builtin_amdgcn_rcpf(1.f + exp_(-x)); }
__device__ __forceinline__ float tanhf_(float x) { return 1.f - 2.f * __builtin_amdgcn_rcpf(exp_(2.f * x) + 1.f); }
#define LDS_WAIT() asm volatile("s_waitcnt lgkmcnt(0)" ::: "memory")
#define VM_WAIT() asm volatile("s_waitcnt vmcnt(0)" ::: "memory")

__device__ __forceinline__ int row_pos(int r) { return r < NP ? (r & 4095) : ((r - NP) & 2047); }
__device__ __forceinline__ int row_T(int r) { return r < NP ? 4096 : 2048; }
__device__ __forceinline__ int seq_row0(int s) { return s < 4 ? s * 4096 : NP + (s - 4) * 2048; }
__device__ __forceinline__ int seq_T(int s) { return s < 4 ? 4096 : 2048; }

#define XB_TMO      128
#define XB_XCNT(j)  (256  + 64 * (j))
#define XB_XSUB(j)  (1280 + 64 * (j))
#define XB_XGEN(j)  (2304 + 64 * (j))
#define XB_TOP      3328
#define XB_TOPGEN   3392
#define XCD_BAR_WORDS 3456
#define XB_SPIN_CAP (1u << 22)

__device__ __forceinline__ unsigned xb_ld(unsigned* p)              { return __hip_atomic_load(p, __ATOMIC_RELAXED, __HIP_MEMORY_SCOPE_AGENT); }
__device__ __forceinline__ unsigned xb_add(unsigned* p, unsigned v) { return __hip_atomic_fetch_add(p, v, __ATOMIC_RELAXED, __HIP_MEMORY_SCOPE_AGENT); }
__device__ __forceinline__ unsigned xb_xcc_id() { return (unsigned)__builtin_amdgcn_s_getreg((3 << 11) | 20) & 0xFu; }
#define XB_SPIN(cond, bar) do { unsigned _sp = 0; while (cond) { __builtin_amdgcn_s_sleep(1); \
    if ((++_sp & 255u) == 0u) { if (xb_ld(&(bar)[XB_TMO])) break; if (_sp > XB_SPIN_CAP) { atomicAdd(&(bar)[XB_TMO], 1u); break; } } } } while (0)

struct XcdBarrier { unsigned* bar; unsigned x; volatile LAS unsigned* st; };

__device__ __forceinline__ XcdBarrier xcd_barrier_post(unsigned* bar, volatile LAS unsigned* st) {
    XcdBarrier b; b.bar = bar; b.x = xb_xcc_id(); b.st = st;
    if (threadIdx.x == 0) (void)xb_add(&bar[XB_XCNT(b.x)], 1u);
    return b;
}
__device__ __forceinline__ void xcd_barrier_complete(unsigned* bar, unsigned x, unsigned& nloc, unsigned& nx) {
    const unsigned G = gridDim.x * gridDim.y * gridDim.z;
    unsigned sum, cnt, mine, sp = 0u;
    for (;;) {
        sum = 0u; cnt = 0u; mine = 0u;
#pragma unroll
        for (unsigned j = 0; j < 16; ++j) { const unsigned c = xb_ld(&bar[XB_XCNT(j)]); sum += c; cnt += (c > 0u) ? 1u : 0u; mine = (j == x) ? c : mine; }
        if (sum == G) break;
        __builtin_amdgcn_s_sleep(1);
        if ((++sp & 255u) == 0u) { if (xb_ld(&bar[XB_TMO])) break; if (sp > XB_SPIN_CAP) { atomicAdd(&bar[XB_TMO], 1u); break; } }
    }
    nloc = mine > 0u ? mine : 1u; nx = cnt > 0u ? cnt : 1u;
}
__device__ __forceinline__ void xcd_barrier(const XcdBarrier& b, bool is_t0) {
    asm volatile("s_waitcnt vmcnt(0)" ::: "memory");
    __syncthreads();
    if (is_t0) {
        GAS unsigned* barg_ = (GAS unsigned*)b.bar; asm volatile("" : "+s"(barg_)); unsigned* bar = (unsigned*)barg_;
        __builtin_amdgcn_s_waitcnt(0);
        unsigned nloc = b.st[0], nx = b.st[1];
        if (nloc == 0u) { xcd_barrier_complete(bar, b.x, nloc, nx); b.st[0] = nloc; b.st[1] = nx; }
        const unsigned old = xb_add(&bar[XB_XSUB(b.x)], 1u);
        const unsigned gen = old / nloc;
        if (old + 1u == (gen + 1u) * nloc) {
            __builtin_amdgcn_fence(__ATOMIC_RELEASE, "agent");
            asm volatile("s_waitcnt vmcnt(0)" ::: "memory");
            const unsigned og = xb_add(&bar[XB_TOP], 1u);
            const unsigned tg = og / nx;
            if (og + 1u == (tg + 1u) * nx) xb_add(&bar[XB_TOPGEN], 1u);
            else XB_SPIN(xb_ld(&bar[XB_TOPGEN]) == tg, bar);
            __builtin_amdgcn_fence(__ATOMIC_ACQUIRE, "agent");
            xb_add(&bar[XB_XGEN(b.x)], 1u);
            asm volatile("s_waitcnt vmcnt(0)" ::: "memory");
        } else {
            XB_SPIN(xb_ld(&bar[XB_XGEN(b.x)]) == gen, bar);
            __builtin_amdgcn_fence(__ATOMIC_ACQUIRE, "agent");
            asm volatile("s_waitcnt vmcnt(0)" ::: "memory");
        }
    }
    __syncthreads();
}

enum { EPI_BF16 = 0, EPI_RESID = 1, EPI_SWIGLU = 2, EPI_ROWSCALE = 3, EPI_SOFTMAX = 4 };
struct GP { const bf16* A; const bf16* B; void* C; const void* aux; int mt, nt, ustart, ldc, epi; float scale; int pad0, pad1; };
struct GPhase { int first, count, K, lda, ldb, total, cntA, szA, szB, pad0, pad1, pad2, pad3, pad4, pad5, pad6; };
static_assert(sizeof(GP) == 64 && sizeof(GPhase) == 64, "table layout");

namespace pg8 {
constexpr int BM = 256, BK = 64, HALF = 128, HTB = HALF * BK * 2, STAGE_BYTES = 8 * HTB, NXCD = 8, WGM = 16;
__host__ __device__ __forceinline__ int lds_byte(int r, int c) { const int st = (r >> 4) * 2 + (c >> 5), rr = r & 15, cc = c & 31, ob = rr * 64 + cc * 2; return st * 1024 + (ob ^ (((ob >> 9) & 1) << 5)); }
__host__ __device__ __forceinline__ void stage_rc(int b, int& R, int& C) { const int st = b / 1024, sb = b % 1024, swz = sb ^ (((sb >> 9) & 1) << 5); R = (st >> 1) * 16 + swz / 64; C = (st & 1) * 32 + (swz % 64) / 2; }
__host__ __device__ __forceinline__ int perm32(int rho) { const int n = rho >> 4, i = rho & 15; return 8 * (i >> 2) + 4 * n + (i & 3); }
struct Unit { int pm, pn, p; };
#define CAS __attribute__((address_space(4)))
__device__ __forceinline__ int cld32(const void* p) { return *(const CAS int*)p; }
__device__ __forceinline__ unsigned long long cld64(const void* p) { return *(const CAS unsigned long long*)p; }

struct TableOrder {
    const GP* tab; int nprob, total, G, c, cntA, szA, szB;
    __device__ __forceinline__ bool next(int i, Unit& u) const {
        const long L = (long)i * G + c; if (L >= total) return false;
        const int La = cntA * szA; int p, l;
        if ((int)L < La) { p = (int)L / szA; l = (int)L - p * szA; } else { const int q_ = ((int)L - La) / szB; p = cntA + q_; l = (int)L - La - q_ * szB; }
        const int nM = cld32(&tab[p].mt), nN = cld32(&tab[p].nt), nwg = nM * nN;
        int wgid = l; { const int q = nwg / NXCD, r = nwg % NXCD, xcd = wgid % NXCD, off = wgid / NXCD; wgid = (xcd < r ? xcd * (q + 1) : r * (q + 1) + (xcd - r) * q) + off; }
        const int nig = WGM * nN, gid = wgid / nig, fm = gid * WGM, gsz = (nM - fm) < WGM ? (nM - fm) : WGM;
        u.pm = fm + ((wgid % nig) % gsz); u.pn = (wgid % nig) / gsz; u.p = p; return true;
    }
};

template <int KIND, bool FP8> __device__ __forceinline__ void epilogue(const GP* Pp, f32x4 (&acc)[2][2][4][2], const Unit& u, int wr, int wc, int fr, int fq, LAS uchar* xlds) {
    const int epi = cld32(&Pp->epi), kind = KIND, act = epi >> 8, ldc = cld32(&Pp->ldc);
    const int row0 = u.pm * BM + wr * 64 + fr, colL = wc * 32 + 8 * fq, lane = fq * 16 + fr; (void)lane;
    if constexpr (KIND == EPI_BF16) {
        GAS bf16* C = (GAS bf16*)cld64(&Pp->C);
#pragma unroll
        for (int ai = 0; ai < 2; ++ai)
#pragma unroll
            for (int m = 0; m < 4; ++m) { GAS bf16* rowp = C + (size_t)(row0 + ai * HALF + m * 16) * ldc + u.pn * BM + colL;
#pragma unroll
                for (int bj = 0; bj < 2; ++bj) { f32x4 v0 = acc[ai][bj][m][0], v1 = acc[ai][bj][m][1];
                    if (act == 1) {
#pragma unroll
                        for (int j = 0; j < 4; ++j) { v0[j] = tanhf_(v0[j]); v1[j] = tanhf_(v1[j]); } }
                    else if (act == 2) {
#pragma unroll
                        for (int j = 0; j < 4; ++j) { v0[j] = sigmoidf_(v0[j]); v1[j] = sigmoidf_(v1[j]); } }
                    u32x4 w; w.x = pk2(v0[0], v0[1]); w.y = pk2(v0[2], v0[3]); w.z = pk2(v1[0], v1[1]); w.w = pk2(v1[2], v1[3]);
                    *(GAS u32x4*)(rowp + bj * HALF) = w; } }
    } else if constexpr (KIND == EPI_RESID) {
        GAS float* Z = (GAS float*)cld64(&Pp->C);
#if RESID_BF16
        const GAS bf16* X = (const GAS bf16*)cld64(&Pp->aux);
        u32x4 xwa[2][4][2];
#pragma unroll
        for (int ai = 0; ai < 2; ++ai)
#pragma unroll
            for (int m = 0; m < 4; ++m) { const size_t off = (size_t)(row0 + ai * HALF + m * 16) * ldc + u.pn * BM + colL;
#pragma unroll
                for (int bj = 0; bj < 2; ++bj) xwa[ai][m][bj] = *(const GAS u32x4*)(X + off + bj * HALF); }
#pragma unroll
        for (int ai = 0; ai < 2; ++ai)
#pragma unroll
            for (int m = 0; m < 4; ++m) { const size_t off = (size_t)(row0 + ai * HALF + m * 16) * ldc + u.pn * BM + colL;
#pragma unroll
                for (int bj = 0; bj < 2; ++bj) { const u32x4 xw = xwa[ai][m][bj];
                    const f32x4 x0 = (f32x4){bflo(xw.x), bfhi(xw.x), bflo(xw.y), bfhi(xw.y)}, x1 = (f32x4){bflo(xw.z), bfhi(xw.z), bflo(xw.w), bfhi(xw.w)};
                    const f32x4 z0 = x0 * DN_ALPHA + acc[ai][bj][m][0], z1 = x1 * DN_ALPHA + acc[ai][bj][m][1];
#if Z_BF16
                    u32x4 zw; zw.x = pk2(z0[0], z0[1]); zw.y = pk2(z0[2], z0[3]); zw.z = pk2(z1[0], z1[1]); zw.w = pk2(z1[2], z1[3]);
                    *(GAS u32x4*)((GAS bf16*)Z + off + bj * HALF) = zw;
#else
                    *(GAS f32x4*)(Z + off + bj * HALF) = z0; *(GAS f32x4*)(Z + off + bj * HALF + 4) = z1;
#endif
                    } }
#else
        const GAS float* X = (const GAS float*)cld64(&Pp->aux);
#pragma unroll
        for (int ai = 0; ai < 2; ++ai)
#pragma unroll
            for (int m = 0; m < 4; ++m) { const size_t off = (size_t)(row0 + ai * HALF + m * 16) * ldc + u.pn * BM + colL;
#pragma unroll
                for (int bj = 0; bj < 2; ++bj)
#pragma unroll
                    for (int n = 0; n < 2; ++n) { const f32x4 x = *(const GAS f32x4*)(X + off + bj * HALF + 4 * n); *(GAS f32x4*)(Z + off + bj * HALF + 4 * n) = x * DN_ALPHA + acc[ai][bj][m][n]; } }
#endif
    } else if constexpr (KIND == EPI_SWIGLU) {
        if constexpr (FP8) {
            GAS uchar* C = (GAS uchar*)cld64(&Pp->C);
#pragma unroll
            for (int ai = 0; ai < 2; ++ai)
#pragma unroll
                for (int m = 0; m < 4; ++m) { GAS uchar* rowp = C + (size_t)(row0 + ai * HALF + m * 16) * ldc + u.pn * HALF + colL;
                    float h[8];
#pragma unroll
                    for (int n = 0; n < 2; ++n)
#pragma unroll
                        for (int p = 0; p < 2; ++p) {
                            const f32x2 g2 = (f32x2){acc[ai][0][m][n][2 * p], acc[ai][0][m][n][2 * p + 1]}, u2 = (f32x2){acc[ai][1][m][n][2 * p], acc[ai][1][m][n][2 * p + 1]};
                            const f32x2 ea = g2 * (-1.4426950408889634f / 32.f);
                            f32x2 e2; e2.x = __builtin_amdgcn_exp2f(ea.x); e2.y = __builtin_amdgcn_exp2f(ea.y);
                            const f32x2 a2 = e2 + 1.f;
                            f32x2 r2; r2.x = __builtin_amdgcn_rcpf(a2.x); r2.y = __builtin_amdgcn_rcpf(a2.y);
                            f32x2 h2 = (g2 * u2) * r2; h2 = h2 * (1.f / 128.f);
                            asm volatile("" : "+v"(h2));
                            h[4 * n + 2 * p] = h2.x; h[4 * n + 2 * p + 1] = h2.y; }
                    u32x2 w; w.x = pk4_fp8(h[0], h[1], h[2], h[3]); w.y = pk4_fp8(h[4], h[5], h[6], h[7]);
                    *(GAS u32x2*)rowp = w; }
        } else {
        GAS bf16* C = (GAS bf16*)cld64(&Pp->C);
#pragma unroll
        for (int ai = 0; ai < 2; ++ai)
#pragma unroll
            for (int m = 0; m < 4; ++m) { GAS bf16* rowp = C + (size_t)(row0 + ai * HALF + m * 16) * ldc + u.pn * HALF + colL;
                f32x4 h0, h1;
#pragma unroll
                for (int j = 0; j < 4; ++j) { h0[j] = siluf_(acc[ai][0][m][0][j]) * acc[ai][1][m][0][j]; h1[j] = siluf_(acc[ai][0][m][1][j]) * acc[ai][1][m][1][j]; }
                u32x4 w; w.x = pk2(h0[0], h0[1]); w.y = pk2(h0[2], h0[3]); w.z = pk2(h1[0], h1[1]); w.w = pk2(h1[2], h1[3]);
                *(GAS u32x4*)rowp = w; }
        }
    } else if constexpr (KIND == EPI_ROWSCALE) {
        GAS bf16* C = (GAS bf16*)cld64(&Pp->C); const GAS float* gate = (const GAS float*)cld64(&Pp->aux);
        float ga[2][4];
#pragma unroll
        for (int ai = 0; ai < 2; ++ai)
#pragma unroll
            for (int m = 0; m < 4; ++m) ga[ai][m] = gate[row0 + ai * HALF + m * 16];
#pragma unroll
        for (int ai = 0; ai < 2; ++ai)
#pragma unroll
            for (int m = 0; m < 4; ++m) { const int row = row0 + ai * HALF + m * 16; const float g = ga[ai][m] * (FP8 ? (1.0f / 1024.0f) : 1.0f); GAS bf16* rowp = C + (size_t)row * ldc + u.pn * BM + colL;
#pragma unroll
                for (int bj = 0; bj < 2; ++bj) { const f32x4 v0 = acc[ai][bj][m][0] * g, v1 = acc[ai][bj][m][1] * g;
                    u32x4 w; w.x = pk2(v0[0], v0[1]); w.y = pk2(v0[2], v0[3]); w.z = pk2(v1[0], v1[1]); w.w = pk2(v1[2], v1[3]);
                    *(GAS u32x4*)(rowp + bj * HALF) = w; } }
    } else {
        GAS bf16* C = (GAS bf16*)cld64(&Pp->C);
        const float sc = __uint_as_float((unsigned)cld32(&Pp->scale)) * 1.4426950408889634f;
        LAS f32x2* SMX = (LAS f32x2*)xlds;
        float mloc[2][4];
#pragma unroll
        for (int ai = 0; ai < 2; ++ai)
#pragma unroll
            for (int m = 0; m < 4; ++m) {
                float mx = -3.0e38f;
#pragma unroll
                for (int bj = 0; bj < 2; ++bj)
#pragma unroll
                    for (int n = 0; n < 2; ++n)
#pragma unroll
                        for (int j = 0; j < 4; ++j) mx = fmaxf(mx, acc[ai][bj][m][n][j]);
                mx = xor32_max(xor16_max(mx));
                const float nmx = -mx * sc;
                float s = 0.f;
#pragma unroll
                for (int bj = 0; bj < 2; ++bj)
#pragma unroll
                    for (int n = 0; n < 2; ++n)
#pragma unroll
                        for (int j = 0; j < 4; ++j) { const float e = __builtin_amdgcn_exp2f(__builtin_fmaf(acc[ai][bj][m][n][j], sc, nmx)); acc[ai][bj][m][n][j] = e; s += e; }
                s = xor32_sum(xor16_sum(s));
                mloc[ai][m] = mx;
                if (fq == 0) SMX[(ai * HALF + wr * 64 + m * 16 + fr) * 4 + wc] = (f32x2){mx, s};
            }
        LDS_WAIT(); __builtin_amdgcn_s_barrier(); asm volatile("" ::: "memory");
#pragma unroll
        for (int ai = 0; ai < 2; ++ai)
#pragma unroll
            for (int m = 0; m < 4; ++m) {
                const int rt = ai * HALF + wr * 64 + m * 16 + fr;
                const f32x2 a = SMX[rt * 4 + 0], b = SMX[rt * 4 + 1], c = SMX[rt * 4 + 2], d = SMX[rt * 4 + 3];
                const float M = fmaxf(fmaxf(a.x, b.x), fmaxf(c.x, d.x));
                const float tot = a.y * __builtin_amdgcn_exp2f((a.x - M) * sc) + b.y * __builtin_amdgcn_exp2f((b.x - M) * sc) + c.y * __builtin_amdgcn_exp2f((c.x - M) * sc) + d.y * __builtin_amdgcn_exp2f((d.x - M) * sc);
                const float f = __builtin_amdgcn_exp2f((mloc[ai][m] - M) * sc) * __builtin_amdgcn_rcpf(tot);
                GAS bf16* rowp = C + (size_t)(row0 + ai * HALF + m * 16) * ldc + u.pn * BM + colL;
#pragma unroll
                for (int bj = 0; bj < 2; ++bj) { const f32x4 v0 = acc[ai][bj][m][0] * f, v1 = acc[ai][bj][m][1] * f;
                    u32x4 w; w.x = pk2(v0[0], v0[1]); w.y = pk2(v0[2], v0[3]); w.z = pk2(v1[0], v1[1]); w.w = pk2(v1[2], v1[3]);
                    *(GAS u32x4*)(rowp + bj * HALF) = w; }
            }
        LDS_WAIT(); __builtin_amdgcn_s_barrier(); asm volatile("" ::: "memory");
    }
}

template <int KIND, bool FP8 = false> __device__ __forceinline__ void gemm_phase(LAS uchar* lds, LAS uchar* xlds, const GPhase* php, const GP* tab_all, int G, int c, const unsigned char* wsb, int wave_sgpr_) {
    const int tid = opaque_tid(), wid = uni(tid >> 6), lane = tid & 63, wr = wid >> 2, wc = wid & 3, fr = lane & 15, fq = lane >> 4;
    const int K = uni(php->K), lda = uni(php->lda), ldb = uni(php->ldb), nt = K / 128;
    TableOrder S; S.tab = tab_all + uni(php->first); S.nprob = uni(php->count); S.total = uni(php->total); S.G = G; S.c = c; S.cntA = uni(php->cntA); S.szA = uni(php->szA); S.szB = uni(php->szB);
    constexpr bool GATH = MOE_GATHER_FUSED && FP8 && KIND == EPI_SWIGLU;
    unsigned voffA[2], voffB[2], voffA1[2], nvP0 = 0u, nvP1 = 0u;
#pragma unroll
    for (int i = 0; i < 2; ++i) { int R, C; stage_rc(tid * 16 + i * 8192, R, C); const int Rb = (R & ~31) + perm32(R & 31);
        voffA[i] = (unsigned)(R * lda + C * 2); voffB[i] = (unsigned)(Rb * ldb + C * 2); voffA1[i] = voffA[i]; }
    const __amdgpu_buffer_rsrc_t rsrc = __builtin_amdgcn_make_buffer_rsrc((void*)wsb, 0, 0xffffffff, 0x00020000);
    const unsigned kstep = (unsigned)(BK * 2);
    const unsigned hstepA = (unsigned)HALF * lda, hstepB = (unsigned)HALF * ldb;
    const unsigned tstepA = 2 * hstepA, tstepB = 2 * hstepB;
    const unsigned ldsw = (unsigned)wid * 1024u;
    const int aoff = lds_byte(wr * 64 + fr, fq * 8), boff = lds_byte(wc * 32 + fr, fq * 8);
#define PG8_SA(b, h) (((b) * 2 + (h)) * HTB)
#define PG8_SB(b, h) ((4 + (b) * 2 + (h)) * HTB)
#ifndef USE_BUFLD
#define USE_BUFLD 1
#endif
#if USE_BUFLD
#define PG8_STAGE(bufoff, gbase, voff) do { _Pragma("unroll") for (int _i = 0; _i < 2; ++_i) \
        __builtin_amdgcn_raw_ptr_buffer_load_lds(rsrc, (LAS void*)(lds + (bufoff) + ldsw + _i * 8192), 16, (int)(voff)[_i], (int)(gbase), 0, 0); } while (0)
#else
#define PG8_STAGE(bufoff, gbase, voff) do { _Pragma("unroll") for (int _i = 0; _i < 2; ++_i) \
        __builtin_amdgcn_global_load_lds((const unsigned*)((const char*)wsb + (size_t)(gbase) + (voff)[_i]), (LAS unsigned*)(lds + (bufoff) + ldsw + _i * 8192), 16, 0, 0); } while (0)
#endif
#define PG8_LD8(ptr_) __builtin_shufflevector(*(const LAS v4i_t*)(ptr_), *(const LAS v4i_t*)((ptr_) + 1024), 0, 1, 2, 3, 4, 5, 6, 7)
#define PG8_LDA(dst, b, h) do { _Pragma("unroll") for (int m = 0; m < 4; ++m) { if constexpr (FP8) dst##8[m] = PG8_LD8(lds + PG8_SA(b, h) + aoff + m * 2048); \
        else { _Pragma("unroll") for (int k = 0; k < 2; ++k) dst[m][k] = *(const LAS bf16x8*)(lds + PG8_SA(b, h) + aoff + m * 2048 + k * 1024); } } } while (0)
#define PG8_LDB(dst, b, h) do { _Pragma("unroll") for (int n = 0; n < 2; ++n) { if constexpr (FP8) dst##8[n] = PG8_LD8(lds + PG8_SB(b, h) + boff + n * 2048); \
        else { _Pragma("unroll") for (int k = 0; k < 2; ++k) dst[n][k] = *(const LAS bf16x8*)(lds + PG8_SB(b, h) + boff + n * 2048 + k * 1024); } } } while (0)
#define PG8_MMA(ai, bj, At, Bt) do { __builtin_amdgcn_s_setprio(1); _Pragma("unroll") for (int m = 0; m < 4; ++m) _Pragma("unroll") for (int n = 0; n < 2; ++n) { \
        if constexpr (FP8) acc[ai][bj][m][n] = __builtin_amdgcn_mfma_scale_f32_16x16x128_f8f6f4(Bt##8[n], At##8[m], acc[ai][bj][m][n], 0, 0, 0, 0, 0, 0); \
        else { _Pragma("unroll") for (int k = 0; k < 2; ++k) acc[ai][bj][m][n] = __builtin_amdgcn_mfma_f32_16x16x32_bf16(Bt[n][k], At[m][k], acc[ai][bj][m][n], 0, 0, 0); } } \
        __builtin_amdgcn_s_setprio(0); } while (0)
#define PG8_WAIT_V(n) asm volatile("s_waitcnt vmcnt(" #n ")" ::: "memory")
#define PG8_WAIT_L(n) asm volatile("s_waitcnt lgkmcnt(" #n ")" ::: "memory")
#define PG8_BAR __builtin_amdgcn_s_barrier()
#define PG8_SCHED __builtin_amdgcn_sched_barrier(0)
    Unit cur, nxt; int ui = 0;
    if (!S.next(0, cur)) return;
    f32x4 acc[2][2][4][2];
#pragma unroll
    for (int a = 0; a < 2; ++a)
#pragma unroll
        for (int b = 0; b < 2; ++b)
#pragma unroll
            for (int m = 0; m < 4; ++m)
#pragma unroll
                for (int n = 0; n < 2; ++n) acc[a][b][m][n] = (f32x4){0.f, 0.f, 0.f, 0.f};
    bf16x8 At[4][2], B0[2][2], B1[2][2]; v8i_t At8[4], B08[2], B18[2]; (void)At; (void)B0; (void)B1; (void)At8; (void)B08; (void)B18;
#define PG8_OFF(p_) ((unsigned)(cld64(&(p_)) - (unsigned long long)wsb))
    const unsigned hsA = GATH ? 0u : hstepA;
#define PG8_GATHP(u_, p0_, p1_) do { const GAS int* ip_ = (const GAS int*)cld64(&S.tab[(u_).p].aux) + (u_).pm * 256; const int tz_ = opaque_tid(); int Ra_, Rb_, C_; \
        stage_rc(tz_ * 16, Ra_, C_); stage_rc(tz_ * 16 + 8192, Rb_, C_); \
        (p0_) = (unsigned)ip_[Ra_] | ((unsigned)ip_[Rb_] << 16); (p1_) = (unsigned)ip_[128 + Ra_] | ((unsigned)ip_[128 + Rb_] << 16); } while (0)
#define PG8_EXPAND(p0_, p1_) do { voffA[0] = (((p0_) & 0xffffu) << 10) | (voffA[0] & 1023u); voffA[1] = (((p0_) >> 16) << 10) | (voffA[1] & 1023u); \
        voffA1[0] = (((p1_) & 0xffffu) << 10) | (voffA1[0] & 1023u); voffA1[1] = (((p1_) >> 16) << 10) | (voffA1[1] & 1023u); } while (0)
    static_assert(!MOE_GATHER_FUSED || NTOK <= 65536, "16-bit row ids");
    if constexpr (GATH) { PG8_GATHP(cur, nvP0, nvP1); PG8_EXPAND(nvP0, nvP1); }
    unsigned cA = PG8_OFF(S.tab[cur.p].A) + (GATH ? 0u : (unsigned)cur.pm * tstepA), cB = PG8_OFF(S.tab[cur.p].B) + (unsigned)cur.pn * tstepB;
    PG8_STAGE(PG8_SB(0, 0), cB, voffB); PG8_STAGE(PG8_SB(0, 1), cB + hstepB, voffB); PG8_STAGE(PG8_SA(0, 0), cA, voffA); PG8_STAGE(PG8_SA(0, 1), cA + hsA, voffA1);
    if (wr == 1) PG8_BAR;
    PG8_WAIT_V(2); PG8_BAR;
    PG8_STAGE(PG8_SB(1, 0), cB + kstep, voffB); PG8_STAGE(PG8_SA(1, 0), cA + kstep, voffA); PG8_STAGE(PG8_SB(1, 1), cB + hstepB + kstep, voffB);
    PG8_WAIT_V(6); PG8_BAR;
    for (;;) {
        const bool has_next = S.next(ui + 1, nxt);
        if constexpr (GATH) {
            if (has_next && wid == 0) __builtin_amdgcn_raw_ptr_buffer_load_lds(rsrc, (LAS void*)xlds, 16, (int)(lane * 16), (int)(PG8_OFF(S.tab[nxt.p].aux) + (unsigned)nxt.pm * 1024u), 0, 0); }
        const unsigned nA = has_next ? PG8_OFF(S.tab[nxt.p].A) + (GATH ? 0u : (unsigned)nxt.pm * tstepA) : cA, nB = has_next ? PG8_OFF(S.tab[nxt.p].B) + (unsigned)nxt.pn * tstepB : cB;
        for (int t = 0; t < nt; t += 2) {
            const bool last = (t == nt - 2);
            const unsigned a1 = cA + (unsigned)(t + 1) * kstep;
            const unsigned a2 = last ? nA : cA + (unsigned)(t + 2) * kstep, b2 = last ? nB : cB + (unsigned)(t + 2) * kstep;
            const unsigned a3 = a2 + kstep, b3 = b2 + kstep;
            PG8_LDB(B0, 0, 0); PG8_LDB(B1, 0, 1); PG8_SCHED; PG8_LDA(At, 0, 0); PG8_STAGE(PG8_SA(1, 1), a1 + hsA, voffA1);
            if constexpr (GATH) { if (last && has_next) {
                const LAS int* il_ = (const LAS int*)xlds; const int tz_ = opaque_tid(); int Ra_, Rb_, C_; stage_rc(tz_ * 16, Ra_, C_); stage_rc(tz_ * 16 + 8192, Rb_, C_);
                nvP0 = (unsigned)il_[Ra_] | ((unsigned)il_[Rb_] << 16); nvP1 = (unsigned)il_[128 + Ra_] | ((unsigned)il_[128 + Rb_] << 16);
                PG8_EXPAND(nvP0, nvP1); } }
            PG8_WAIT_V(8); PG8_WAIT_L(0); PG8_BAR; PG8_MMA(0, 0, At, B0); PG8_MMA(0, 1, At, B1); PG8_BAR; PG8_SCHED;
            PG8_LDA(At, 0, 1); PG8_STAGE(PG8_SB(0, 0), b2, voffB); PG8_STAGE(PG8_SB(0, 1), b2 + hstepB, voffB); PG8_STAGE(PG8_SA(0, 0), a2, voffA);
            PG8_WAIT_V(8); PG8_WAIT_L(0); PG8_BAR; PG8_MMA(1, 0, At, B0); PG8_MMA(1, 1, At, B1); PG8_BAR; PG8_SCHED;
            PG8_LDB(B0, 1, 0); PG8_LDB(B1, 1, 1); PG8_SCHED; PG8_LDA(At, 1, 0); PG8_STAGE(PG8_SA(0, 1), a2 + hsA, voffA1);
            PG8_WAIT_V(8); PG8_WAIT_L(0); PG8_BAR; PG8_MMA(0, 0, At, B0); PG8_MMA(0, 1, At, B1); PG8_BAR; PG8_SCHED;
            PG8_LDA(At, 1, 1); PG8_STAGE(PG8_SB(1, 0), b3, voffB); PG8_STAGE(PG8_SB(1, 1), b3 + hstepB, voffB); PG8_STAGE(PG8_SA(1, 0), a3, voffA);
            PG8_WAIT_V(8); PG8_WAIT_L(0); PG8_BAR; PG8_MMA(1, 0, At, B0); PG8_MMA(1, 1, At, B1); PG8_BAR; PG8_SCHED;
        }
        if (wr == 0) PG8_BAR;
        { const int tz2 = opaque_tid(), wid2 = uni(tz2 >> 6), lane2 = tz2 & 63;
          epilogue<KIND, FP8>(S.tab + cur.p, acc, cur, wid2 >> 2, wid2 & 3, lane2 & 15, lane2 >> 4, xlds); }
        if (!has_next) break;
#pragma unroll
        for (int a = 0; a < 2; ++a)
#pragma unroll
            for (int b = 0; b < 2; ++b)
#pragma unroll
                for (int m = 0; m < 4; ++m)
#pragma unroll
                    for (int n = 0; n < 2; ++n) acc[a][b][m][n] = (f32x4){0.f, 0.f, 0.f, 0.f};
        cur = nxt; cA = nA; cB = nB; ++ui;
        if (wr == 1) PG8_BAR;
    }
    PG8_WAIT_V(0);
    PG8_BAR;
#undef PG8_OFF
#undef PG8_GATHP
#undef PG8_EXPAND
#undef PG8_SA
#undef PG8_SB
#undef PG8_STAGE
#undef PG8_LDA
#undef PG8_LDB
#undef PG8_MMA
#undef PG8_WAIT_V
#undef PG8_WAIT_L
#undef PG8_BAR
#undef PG8_SCHED
}
}

struct Args { const float* in[33]; float* out; unsigned char* ws; int ph_lo, ph_hi; };
enum { I_XP = 0, I_XS, I_MP, I_MS, I_EWIN, I_ELB, I_ENA, I_ENB, I_EWOUT, I_OMU, I_ORKV, I_OW0, I_OW1, I_OW2, I_OA0, I_OA1, I_OA2, I_OG1, I_OG2, I_OKK, I_OKA, I_ORK, I_OLNW, I_OLNB, I_OWOUT,
       I_CWQ, I_CWKV, I_CWO, I_MR, I_MWIN, I_MWOUT, I_LNW, I_LNB };

constexpr int GPH_PRO = 36, GPH_PRO2 = 37;

__device__ __forceinline__ void transpose_load(f32x4 (&rg)[8], const float* W, int ldw, int k0, int n0, int lane) {
#pragma unroll
    for (int i = 0; i < 8; ++i) rg[i] = *(const f32x4*)(W + (size_t)(k0 + 8 * i + (lane >> 3)) * ldw + n0 + 4 * (lane & 7));
}
__device__ __forceinline__ void transpose_finish(const f32x4 (&rg)[8], bf16* dst, int ldd, float fp8scale, LAS float* scr, int lane) {
#pragma unroll
    for (int i = 0; i < 8; ++i) { LAS float* p = scr + (8 * i + (lane >> 3)) * 33 + 4 * (lane & 7); p[0] = rg[i].x; p[1] = rg[i].y; p[2] = rg[i].z; p[3] = rg[i].w; }
    LDS_WAIT(); asm volatile("" ::: "memory");
    const int c = lane & 7;
#pragma unroll
    for (int j = 0; j < 4; ++j) { const int n = (lane >> 3) + 8 * j; const LAS float* sp = scr + (8 * c) * 33 + n;
        if (fp8scale != 0.f) {
            u32x2 o; o.x = pk4_fp8(sp[0 * 33] * fp8scale, sp[1 * 33] * fp8scale, sp[2 * 33] * fp8scale, sp[3 * 33] * fp8scale); o.y = pk4_fp8(sp[4 * 33] * fp8scale, sp[5 * 33] * fp8scale, sp[6 * 33] * fp8scale, sp[7 * 33] * fp8scale);
            *(u32x2*)((uchar*)dst + (size_t)n * ldd + 8 * c) = o;
        } else {
            u32x4 o; o.x = pk2(sp[0 * 33], sp[1 * 33]); o.y = pk2(sp[2 * 33], sp[3 * 33]); o.z = pk2(sp[4 * 33], sp[5 * 33]); o.w = pk2(sp[6 * 33], sp[7 * 33]);
            *(u32x4*)(dst + (size_t)n * ldd + 8 * c) = o; } }
    LDS_WAIT(); asm volatile("" ::: "memory");
}
__device__ __forceinline__ void transpose_batch(const float* src, size_t sstride, int nb, int K, int ldw, int ncols, bf16* dst, size_t dstride, int ldd, int dk0, int mode, LAS float* scr, int gw, int NGW, int lane, float fp8scale = 0.f) {
    const int kb_n = K / 64, nb_n = ncols / 32, per = kb_n * nb_n, total = nb * per;
    f32x4 nxt[8];
#pragma unroll
    for (int i = 0; i < 8; ++i) nxt[i] = (f32x4){0.f, 0.f, 0.f, 0.f};
#define TB_DECODE(it_) const int b = (it_) / per, r = (it_) % per, kb = r / nb_n, nbk = r % nb_n, n0 = nbk * 32, k0 = kb * 64
    if (gw < total) { TB_DECODE(gw); transpose_load(nxt, src + (size_t)b * sstride, ldw, k0, n0, lane); }
    for (int it = gw; it < total; it += NGW) {
        f32x4 cur[8];
#pragma unroll
        for (int i = 0; i < 8; ++i) cur[i] = nxt[i];
        if (it + NGW < total) { TB_DECODE(it + NGW); transpose_load(nxt, src + (size_t)b * sstride, ldw, k0, n0, lane); }
        TB_DECODE(it);
        int drow = n0;
        if (mode == 1) drow = (n0 < 2048) ? ((n0 >> 7) * 256 + (n0 & 127)) : ((((n0 - 2048) >> 7) * 256) + 128 + ((n0 - 2048) & 127));
        if (fp8scale != 0.f) transpose_finish(cur, (bf16*)((uchar*)dst + (size_t)b * dstride + (size_t)drow * ldd + dk0 + k0), ldd, fp8scale, scr, lane);
        else transpose_finish(cur, dst + (size_t)b * dstride + (size_t)drow * ldd + dk0 + k0, ldd, 0.f, scr, lane);
    }
#undef TB_DECODE
}
__device__ __forceinline__ void transpose_batch_r(const float* src, size_t sstride, int nb, int K, int ldw, int ncols, bf16* dst, size_t dstride, int ldd, int dk0, int mode, LAS float* scr, int gw, int NGW, int lane, int& rot) {
    const int total = nb * (K / 64) * (ncols / 32);
    transpose_batch(src, sstride, nb, K, ldw, ncols, dst, dstride, ldd, dk0, mode, scr, (gw + NGW - rot % NGW) % NGW, NGW, lane);
    rot += total;
}
__device__ __forceinline__ void sincos_acc(float angf, float& c, float& s) {
    const double a = (double)angf;
    const double q = __builtin_rint(a * 0.63661977236758134308);
    const double r = (a - q * 1.57079632679489655800) - q * 6.123233995736766036e-17;
    const double r2 = r * r;
    double sp = r * (1.0 + r2 * (-1.0 / 6 + r2 * (1.0 / 120 + r2 * (-1.0 / 5040 + r2 * (1.0 / 362880 + r2 * (-1.0 / 39916800 + r2 * (1.0 / 6227020800.0)))))));
    double cp = 1.0 + r2 * (-0.5 + r2 * (1.0 / 24 + r2 * (-1.0 / 720 + r2 * (1.0 / 40320 + r2 * (-1.0 / 3628800 + r2 * (1.0 / 479001600.0 + r2 * (-1.0 / 87178291200.0)))))));
    const int qi = ((int)q) & 3;
    double ss = (qi == 0) ? sp : (qi == 1) ? cp : (qi == 2) ? -sp : -cp;
    double cc = (qi == 0) ? cp : (qi == 1) ? -sp : (qi == 2) ? -cp : sp;
    c = (float)cc; s = (float)ss;
}

__device__ __forceinline__ void build_tables(const Args& args, int who) {
    unsigned char* ws = opaque_ptr(args.ws);
    GPhase* gph = (GPhase*)(ws + WS_GPH); GP* gpt = (GP*)(ws + WS_GPT);
    auto put = [&](int idx, const void* A, const void* B, void* C, const void* aux, int mt, int nt, int ustart, int ldc, int epi, float scale) {
        GP g; g.A = (const bf16*)A; g.B = (const bf16*)B; g.C = C; g.aux = aux; g.mt = mt; g.nt = nt; g.ustart = ustart; g.ldc = ldc; g.epi = epi; g.scale = scale; g.pad0 = 0; g.pad1 = 0; gpt[idx] = g; };
    auto phase = [&](int id, int first, int count, int K, int lda, int ldb, int total, int cntA, int szA, int szB) { GPhase p; p.first = first; p.count = count; p.K = K; p.lda = lda; p.ldb = ldb; p.total = total; p.cntA = cntA; p.szA = szA; p.szB = szB;
        p.pad0 = p.pad1 = p.pad2 = p.pad3 = p.pad4 = p.pad5 = p.pad6 = 0; gph[id] = p; };
    bf16* XB = (bf16*)(ws + WS_XB); float* X32 = (float*)(ws + WS_X32); float* Z32 = (float*)(ws + WS_Z32);
    if (who < 4) {
        const int L = who, j = L >> 1; int e = 256 * L;
        if ((L & 1) == 0) {
            phase(L * 9 + 0, e, 1, 2 * 1024, 2 * 1024, 2 * 1024, 192 * 18, 1, 192 * 18, 1);
            put(e, XB, ws + WS_W_EIN + (size_t)j * DIN * D * 2, ws + AR_PROJ, nullptr, 192, 18, 0, DIN, EPI_BF16, 0.f); e += 1;
            phase(L * 9 + 1, e, 0, 2 * 256, 2 * 256, 2 * 256, 0, 0, 1, 1);
            phase(L * 9 + 2, e, 1, 2 * 1024, 2 * 1024, 2 * 1024, 192 * 4, 1, 768, 1);
            put(e, ws + AR_OME, ws + WS_W_EOUT + (size_t)j * D * D * 2, Z32, RESID_BF16 ? (void*)XB : (void*)X32, 192, 4, 0, D, EPI_RESID, 0.f); e += 1;
        } else {
            phase(L * 9 + 0, e, 6, 2 * 1024, 2 * 1024, 2 * 1024, 3 * 192 * 4 + 3 * 192, 3, 768, 192);
            int us = 0;
            for (int p = 0; p < 3; ++p) { put(e + p, ws + AR_XM + (size_t)p * NTOK * D * 2, ws + WS_W_RKV + (size_t)(j * 3 + p) * D * D * 2, ws + (p == 2 ? AR_V : AR_RKV + (size_t)p * NTOK * D * 2), nullptr, 192, 4, us, D, EPI_BF16, 0.f); us += 768; }
            for (int p = 0; p < 3; ++p) { put(e + 3 + p, ws + AR_XM + (size_t)(3 + p) * NTOK * D * 2, ws + WS_W_L1 + (size_t)(j * 3 + p) * 256 * D * 2, ws + AR_H1 + (size_t)p * 256 * 2, nullptr, 192, 1, us, 768, EPI_BF16 | ((p == 0 ? 1 : p == 2 ? 2 : 0) << 8), 0.f); us += 192; }
            e += 6;
            phase(L * 9 + 1, e, 3, 2 * 256, 2 * 768, 2 * 256, 192 * 8 + 192 * 8 + 192 * 4, 2, 1536, 768);
            put(e + 0, ws + AR_H1 + 0, ws + WS_W_L2W + (size_t)j * 2048 * 256 * 2, ws + AR_LW, nullptr, 192, 8, 0, 2048, EPI_BF16, 0.f);
            put(e + 1, ws + AR_H1 + 256 * 2, ws + WS_W_L2A + (size_t)j * 2048 * 256 * 2, ws + AR_LA, nullptr, 192, 8, 192 * 8, 2048, EPI_BF16, 0.f);
            put(e + 2, ws + AR_H1 + 512 * 2, ws + WS_W_L2G + (size_t)j * 1024 * 256 * 2, ws + AR_GG, nullptr, 192, 4, 192 * 16, D, EPI_BF16, 0.f);
            e += 3;
            phase(L * 9 + 2, e, 1, 2 * 1024, 2 * 1024, 2 * 1024, 192 * 4, 1, 768, 1);
            put(e, ws + AR_OMO, ws + WS_W_OOUT + (size_t)j * D * D * 2, Z32, RESID_BF16 ? (void*)XB : (void*)X32, 192, 4, 0, D, EPI_RESID, 0.f); e += 1;
        }
        phase(L * 9 + 3, e, 80, 2 * 1024, 2 * 1024, 2 * 1024, 768, 16, 16, 8);
        { int us = 0; for (int s = 0; s < NSEQ; ++s) for (int h = 0; h < 4; ++h) { const int r0 = s < 4 ? s * 4096 : NP + (s - 4) * 2048, mt = (s < 4 ? 4096 : 2048) / 256;
            put(e, XB + (size_t)r0 * D, ws + WS_MQ + ((((size_t)L * 20 + s) * 4 + h) * 256 * 1024) * 2, ws + AR_P + ((size_t)r0 * D + h * 256) * 2, nullptr, mt, 1, us, D, EPI_SOFTMAX, 0.0625f); us += mt; ++e; } }
        phase(L * 9 + 4, e, 0, 2 * 256, 2 * 256, 2 * 256, 0, 0, 1, 1);
        phase(L * 9 + 5, e, 0, 2 * 256, 2 * 256, 2 * 256, 0, 0, 1, 1);
        phase(L * 9 + 6, e, 20, 2 * 1024, 2 * 1024, 2 * 1024, 768, 4, 64, 32);
        { int us = 0; for (int s = 0; s < NSEQ; ++s) { const int r0 = s < 4 ? s * 4096 : NP + (s - 4) * 2048, mt = (s < 4 ? 4096 : 2048) / 256;
            put(e, ws + AR_P + (size_t)r0 * D * 2, ws + WS_VW + (((size_t)L * 20 + s) * 1024 * 1024) * 2, (unsigned char*)Z32 + (size_t)r0 * D * (Z_BF16 ? 2 : 4), XB + (size_t)r0 * D, mt, 4, us, D, EPI_RESID, 0.f); us += mt * 4; ++e; } }
        phase(L * 9 + 7, e, 32, MOE_FP8 ? 1024 : 2048, MOE_FP8 ? 1024 : 2048, MOE_FP8 ? 1024 : 2048, 384 * 16, 16, 128, 256);
        { int us = 0; for (int g = 0; g < 2; ++g) for (int x = 0; x < 16; ++x) { const int sb = g ? NP * 2 + x * 4096 : x * 2048, mt = g ? 16 : 8;
            put(e, ws + AR_XE + (MOE_GATHER_FUSED ? 0 : (size_t)sb * D * (MOE_FP8 ? 1 : 2)), ws + WS_W_MIN + ((size_t)(L * 16 + x) * 4096 * D) * (MOE_FP8 ? 1 : 2), ws + AR_HACT + (size_t)sb * 2048 * (MOE_FP8 ? 1 : 2), MOE_GATHER_FUSED ? (const void*)(ws + WS_IDX + (size_t)sb * 4) : nullptr, mt, 16, us, 2048, EPI_SWIGLU, 0.f); us += mt * 16; ++e; } }
        phase(L * 9 + 8, e, 32, MOE_FP8 ? 2048 : 4096, MOE_FP8 ? 2048 : 4096, MOE_FP8 ? 2048 : 4096, 384 * 4, 16, 32, 64);
        { int us = 0; for (int g = 0; g < 2; ++g) for (int x = 0; x < 16; ++x) { const int sb = g ? NP * 2 + x * 4096 : x * 2048, mt = g ? 16 : 8;
            put(e, ws + AR_HACT + (size_t)sb * 2048 * (MOE_FP8 ? 1 : 2), ws + WS_W_MOUT + ((size_t)(L * 16 + x) * D * 2048) * (MOE_FP8 ? 1 : 2), ws + AR_YE + (size_t)sb * D * 2, ws + WS_GATE + (size_t)sb * 4, mt, 4, us, D, EPI_ROWSCALE, 0.f); us += mt * 4; ++e; } }
    } else {
        int e = 1024; int us = 0;
        for (int L = 0; L < 4; ++L) { put(e, ws + WS_MEMB, ws + WS_W_CKV + (size_t)L * 2048 * D * 2, ws + WS_KMEM + (size_t)L * 5120 * D * 2, nullptr, 20, 4, us, D, EPI_BF16, 0.f); us += 80; ++e; }
        for (int L = 0; L < 4; ++L) { put(e, ws + WS_MEMB, ws + WS_W_CKV + ((size_t)L * 2048 + 1024) * D * 2, ws + WS_VMEM + (size_t)L * 5120 * D * 2, nullptr, 20, 4, us, D, EPI_BF16, 0.f); us += 80; ++e; }
        phase(GPH_PRO, 1024, 8, 2 * 1024, 2 * 1024, 2 * 1024, us, 8, 80, 1);
        const int e2 = e; us = 0;
        for (int L = 0; L < 4; ++L) for (int s = 0; s < NSEQ; ++s) for (int h = 0; h < 4; ++h) {
            put(e, ws + WS_KMEM + (((size_t)L * 5120 + s * 256) * D + h * 256) * 2, ws + WS_WQN + ((size_t)L * D * D + h * 256) * 2, ws + WS_MQ + ((((size_t)L * 20 + s) * 4 + h) * 256 * 1024) * 2, nullptr, 1, 4, us, D, EPI_BF16, 0.f); us += 4; ++e; }
        for (int L = 0; L < 4; ++L) for (int s = 0; s < NSEQ; ++s) for (int h = 0; h < 4; ++h) {
            put(e, ws + WS_W_CO + ((size_t)L * D * D + h * 256) * 2, ws + WS_VMEM + (((size_t)L * 5120 + s * 256) * D + h * 256) * 2, ws + WS_VW + ((((size_t)L * 20 + s) * 1024) * 1024 + h * 256) * 2, nullptr, 4, 1, us, D, EPI_BF16, 0.f); us += 4; ++e; }
        phase(GPH_PRO2, e2, 640, 2 * 256, 2 * 1024, 2 * 1024, us, 640, 4, 1);
    }
}

__device__ __forceinline__ void moe_weights(const Args& args, int L, LAS float* scr, int gw, int NGW, int lane) {
    unsigned char* ws = opaque_ptr(args.ws);
    constexpr size_t ESZ = MOE_FP8 ? 1 : 2;
    transpose_batch(args.in[I_MWIN] + (size_t)L * 16 * D * 4096, (size_t)D * 4096, 16, D, 4096, 4096, (bf16*)(ws + WS_W_MIN + (size_t)L * 16 * 4096 * D * ESZ), (size_t)4096 * D, D, 0, 1, scr, gw, NGW, lane, MOE_FP8 ? 32.f : 0.f);
    transpose_batch(args.in[I_MWOUT] + (size_t)L * 16 * 2048 * D, (size_t)2048 * D, 16, 2048, D, D, (bf16*)(ws + WS_W_MOUT + (size_t)L * 16 * D * 2048 * ESZ), (size_t)D * 2048, 2048, 0, 0, scr, gw, NGW, lane, MOE_FP8 ? 128.f : 0.f);
}
__device__ __forceinline__ void prologue(const Args& args, LAS uchar* lds, int gw, int NGW, int wave, int lane) {
    unsigned char* ws = opaque_ptr(args.ws);
    LAS float* scr = (LAS float*)(lds + wave * 16384);
    if (opaque_bx() == 0 && lane == 0 && wave < 5) build_tables(args, wave);
    int rot = 0;
    transpose_batch_r(args.in[I_EWIN], (size_t)D * DIN, 2, D, DIN, DIN, (bf16*)(ws + WS_W_EIN), (size_t)DIN * D, D, 0, 0, scr, gw, NGW, lane, rot);
    transpose_batch_r(args.in[I_EWOUT], (size_t)D * D, 2, D, D, D, (bf16*)(ws + WS_W_EOUT), (size_t)D * D, D, 0, 0, scr, gw, NGW, lane, rot);
    transpose_batch_r(args.in[I_ORKV], (size_t)D * D, 6, D, D, D, (bf16*)(ws + WS_W_RKV), (size_t)D * D, D, 0, 0, scr, gw, NGW, lane, rot);
    for (int j = 0; j < 2; ++j) {
        bf16* l1 = (bf16*)(ws + WS_W_L1) + (size_t)j * 3 * 256 * D;
        transpose_batch_r(args.in[I_OW1] + (size_t)j * 2 * D * 64, (size_t)D * 64, 2, D, 64, 64, l1, (size_t)64 * D, D, 0, 0, scr, gw, NGW, lane, rot);
        transpose_batch_r(args.in[I_OA1] + (size_t)j * 2 * D * 64, (size_t)D * 64, 2, D, 64, 64, l1 + (size_t)256 * D, (size_t)64 * D, D, 0, 0, scr, gw, NGW, lane, rot);
        transpose_batch_r(args.in[I_OG1] + (size_t)j * D * 128, 0, 1, D, 128, 128, l1 + (size_t)512 * D, 0, D, 0, 0, scr, gw, NGW, lane, rot);
        for (int dir = 0; dir < 2; ++dir) {
            transpose_batch_r(args.in[I_OW2] + ((size_t)j * 2 + dir) * 64 * D, 0, 1, 64, D, D, (bf16*)(ws + WS_W_L2W) + ((size_t)j * 2048 + dir * 1024) * 256, 0, 256, dir * 64, 0, scr, gw, NGW, lane, rot);
            transpose_batch_r(args.in[I_OA2] + ((size_t)j * 2 + dir) * 64 * D, 0, 1, 64, D, D, (bf16*)(ws + WS_W_L2A) + ((size_t)j * 2048 + dir * 1024) * 256, 0, 256, dir * 64, 0, scr, gw, NGW, lane, rot);
        }
        transpose_batch_r(args.in[I_OG2] + (size_t)j * 128 * D, 0, 1, 128, D, D, (bf16*)(ws + WS_W_L2G) + (size_t)j * 1024 * 256, 0, 256, 0, 0, scr, gw, NGW, lane, rot);
    }
    transpose_batch_r(args.in[I_OWOUT], (size_t)D * D, 2, D, D, D, (bf16*)(ws + WS_W_OOUT), (size_t)D * D, D, 0, 0, scr, gw, NGW, lane, rot);
    { const float* wq = args.in[I_CWQ]; bf16* wqn = (bf16*)(ws + WS_WQN);
      for (int r = gw; r < 4 * D; r += NGW) { const f32x4* p = (const f32x4*)(wq + (size_t)r * D + 16 * lane); const f32x4 a = p[0], b = p[1], c = p[2], d = p[3];
          u32x4 o0, o1; o0.x = pk2(a.x, a.y); o0.y = pk2(a.z, a.w); o0.z = pk2(b.x, b.y); o0.w = pk2(b.z, b.w); o1.x = pk2(c.x, c.y); o1.y = pk2(c.z, c.w); o1.z = pk2(d.x, d.y); o1.w = pk2(d.z, d.w);
          u32x4* q = (u32x4*)(wqn + (size_t)r * D + 16 * lane); q[0] = o0; q[1] = o1; } }
    transpose_batch_r(args.in[I_CWKV], (size_t)D * 2048, 4, D, 2048, 2048, (bf16*)(ws + WS_W_CKV), (size_t)2048 * D, D, 0, 0, scr, gw, NGW, lane, rot);
    transpose_batch_r(args.in[I_CWO], (size_t)D * D, 4, D, D, D, (bf16*)(ws + WS_W_CO), (size_t)D * D, D, 0, 0, scr, gw, NGW, lane, rot);
    {
        const int gt = gw * 64 + lane, NT = NGW * 64; const u32x4 z = (u32x4){0u, 0u, 0u, 0u};
        for (int i = gt; i < 6 * 128 * 128; i += NT) { const int blk = i / (128 * 128), r = i % (128 * 128); *(u32x4*)((bf16*)(ws + WS_W_L1) + ((size_t)blk * 256 + 128 + r / 128) * D + (r % 128) * 8) = z; }
        for (int i = gt; i < 2 * 2 * 2048 * 32; i += NT) { const int t = i / (2 * 2048 * 32), r = i % (2 * 2048 * 32), n = (r / 32) % 2048, k8 = r % 32, lo = (n >= 1024) ? 8 : 0;
            if (k8 < lo || k8 >= lo + 8) *(u32x4*)((bf16*)(ws + (t ? WS_W_L2A : WS_W_L2W)) + (size_t)(r / 32) * 256 + k8 * 8) = z; }
        for (int i = gt; i < 2 * 1024 * 16; i += NT) { *(u32x4*)((bf16*)(ws + WS_W_L2G) + (size_t)(i / 16) * 256 + 128 + (i % 16) * 8) = z; }
        float2* rot = (float2*)(ws + WS_ROT);
        for (int i = gt; i < 4096 * 64; i += NT) { const int t = i >> 6, k = i & 63; const float xf = (float)k / 63.0f; const float th = (float)(1.0 / exp((double)xf * 9.210340371976184)); const float ang = (float)t * th;
            float c, s; sincos_acc(ang, c, s); rot[i] = make_float2(c, s); }
    }
    {
        float* X32 = (float*)(ws + WS_X32); bf16* XB = (bf16*)(ws + WS_XB); bf16* MB = (bf16*)(ws + WS_MEMB);
        for (int r = gw; r < NTOK; r += NGW) { const float* src = r < NP ? args.in[I_XP] + (size_t)r * D : args.in[I_XS] + (size_t)(r - NP) * D;
#pragma unroll
            for (int jj = 0; jj < 4; ++jj) { const f32x4 v = *((const f32x4*)src + lane + 64 * jj); if (!RESID_BF16) *((f32x4*)(X32 + (size_t)r * D) + lane + 64 * jj) = v;
                u32x2 o; o.x = pk2(v.x, v.y); o.y = pk2(v.z, v.w); *((u32x2*)(XB + (size_t)r * D) + lane + 64 * jj) = o; } }
        for (int r = gw; r < 5120; r += NGW) { const float* src = r < 1024 ? args.in[I_MP] + (size_t)r * D : args.in[I_MS] + (size_t)(r - 1024) * D;
#pragma unroll
            for (int jj = 0; jj < 4; ++jj) { const f32x4 v = *((const f32x4*)src + lane + 64 * jj); u32x2 o; o.x = pk2(v.x, v.y); o.y = pk2(v.z, v.w); *((u32x2*)(MB + (size_t)r * D) + lane + 64 * jj) = o; } }
    }
}

#define LN_COL(jj) ((((jj) >> 1) * 512) + lane * 8 + (((jj) & 1) * 4))
#define LN_UNPK(dst, q_, hh) do { dst[2 * (hh)] = (f32x4){bflo((q_).x), bfhi((q_).x), bflo((q_).y), bfhi((q_).y)}; dst[2 * (hh) + 1] = (f32x4){bflo((q_).z), bfhi((q_).z), bflo((q_).w), bfhi((q_).w)}; } while (0)
#define LN_ACC(dst, q_, hh) do { dst[2 * (hh)].x += bflo((q_).x); dst[2 * (hh)].y += bfhi((q_).x); dst[2 * (hh)].z += bflo((q_).y); dst[2 * (hh)].w += bfhi((q_).y); dst[2 * (hh) + 1].x += bflo((q_).z); dst[2 * (hh) + 1].y += bfhi((q_).z); dst[2 * (hh) + 1].z += bflo((q_).w); dst[2 * (hh) + 1].w += bfhi((q_).w); } while (0)
__device__ __forceinline__ void ln_phase(const Args& args, LAS uchar* lds, int layer, int which, int mode, bool final_out, int gw, int NGW, int wave, int lane) {
    const int wave_sgpr_ = wave;
    unsigned char* ws = opaque_ptr(args.ws);
    float* X32 = (float*)(ws + WS_X32); const float* Z32 = (const float*)(ws + WS_Z32); bf16* XB = (bf16*)(ws + WS_XB);
    const float* lw = args.in[I_LNW] + (size_t)(layer * 3 + which) * D; const float* lb = args.in[I_LNB] + (size_t)(layer * 3 + which) * D;
    LAS float* wrT = (LAS float*)lds;
    if (mode == 1) {
        const float* wr = args.in[I_MR] + (size_t)layer * D * 16;
        for (int i = opaque_tid(); i < D * 16; i += 512) { const int col = i >> 4, jj = ((col >> 9) << 1) + ((col >> 2) & 1), ln_ = (col & 511) >> 3;
            wrT[(i & 15) * 1024 + (jj * 64 + ln_) * 4 + (col & 3)] = wr[i]; }
        __syncthreads();
    }
    f32x4 gw4[4], gb4[4];
#pragma unroll
    for (int j = 0; j < 4; ++j) { gw4[j] = *(const f32x4*)(lw + LN_COL(j)); gb4[j] = *(const f32x4*)(lb + LN_COL(j)); }
    f32x4 nx[4]; int ninv = -1;
#define LN_LOADROW(r_) do { if (mode == 2 && RESID_BF16) { _Pragma("unroll") for (int hh = 0; hh < 2; ++hh) { const u32x4 w_ = *(const u32x4*)(XB + (size_t)(r_) * D + hh * 512 + lane * 8); LN_UNPK(nx, w_, hh); } } \
        else if (Z_BF16 && mode != 2) { _Pragma("unroll") for (int hh = 0; hh < 2; ++hh) { const u32x4 w_ = *(const u32x4*)((const bf16*)Z32 + (size_t)(r_) * D + hh * 512 + lane * 8); LN_UNPK(nx, w_, hh); } } \
        else { const float* src_ = (mode == 2 ? (const float*)X32 : Z32) + (size_t)(r_) * D; _Pragma("unroll") for (int j = 0; j < 4; ++j) nx[j] = *(const f32x4*)(src_ + LN_COL(j)); } \
        if (mode == 2) ninv = ((const int*)(ws + WS_INV))[(size_t)(r_) * 16 + (lane & 15)]; } while (0)
    static_assert(RESID_BF16 == 1, "mode 2 below reads the residual row from XB");
    u32x4 pre[4][2]; unsigned prest = 0u;
#define YE_PREF(rr_, inv_) do { unsigned long long m_ = __builtin_amdgcn_ballot_w64(lane < 16 && (inv_) >= 0); const int g_ = (rr_) >= NP; \
        _Pragma("unroll") for (int p = 0; p < 4; ++p) { \
            if (m_ != 0ull) { const int e_ = __builtin_ctzll(m_); m_ &= m_ - 1ull; const int sl_ = __builtin_amdgcn_readlane((inv_), e_); \
                const bf16* ye_ = (const bf16*)(ws + AR_YE) + (size_t)((g_ ? NP * 2 + e_ * 4096 : e_ * 2048) + sl_) * D; \
                _Pragma("unroll") for (int hh = 0; hh < 2; ++hh) pre[p][hh] = *(const u32x4*)(ye_ + hh * 512 + lane * 8); } \
            else { _Pragma("unroll") for (int hh = 0; hh < 2; ++hh) pre[p][hh] = (u32x4){0u, 0u, 0u, 0u}; } } \
        prest = (unsigned)m_; } while (0)
    int inv1 = -1;
    static_assert(Z_BF16 == 1, "modes 0/1 below prefetch the bf16 pre-LayerNorm rows two iterations ahead");
    u32x4 zq2[2] = {(u32x4){0u, 0u, 0u, 0u}, (u32x4){0u, 0u, 0u, 0u}};
#define LN_LOADQ2(r_) do { _Pragma("unroll") for (int hh = 0; hh < 2; ++hh) zq2[hh] = *(const u32x4*)((const bf16*)Z32 + (size_t)(r_) * D + hh * 512 + lane * 8); } while (0)
    if (gw < NTOK && mode != 2) { const int rn = gw + NGW < NTOK ? gw + NGW : gw; LN_LOADQ2(rn); }
    if (gw < NTOK) { LN_LOADROW(gw);
        if (mode == 2) { if (gw + NGW < NTOK) inv1 = ((const int*)(ws + WS_INV))[(size_t)(gw + NGW) * 16 + (lane & 15)]; YE_PREF(gw, ninv); } }
    for (int r = gw; r < NTOK; r += NGW) {
        f32x4 v[4];
#pragma unroll
        for (int j = 0; j < 4; ++j) v[j] = nx[j];
        if (mode == 2) {
            const int myinv = ninv; const unsigned myrest = prest;
            u32x4 cur[4][2];
#pragma unroll
            for (int p = 0; p < 4; ++p)
#pragma unroll
                for (int hh = 0; hh < 2; ++hh) cur[p][hh] = pre[p][hh];
            if (r + NGW < NTOK) {
#pragma unroll
                for (int hh = 0; hh < 2; ++hh) { const u32x4 w_ = *(const u32x4*)(XB + (size_t)(r + NGW) * D + hh * 512 + lane * 8); LN_UNPK(nx, w_, hh); }
                ninv = inv1; YE_PREF(r + NGW, ninv);
                if (r + 2 * NGW < NTOK) inv1 = ((const int*)(ws + WS_INV))[(size_t)(r + 2 * NGW) * 16 + (lane & 15)];
            }
#pragma unroll
            for (int j = 0; j < 4; ++j) v[j] = v[j] * DN_ALPHA;
#pragma unroll
            for (int p = 0; p < 4; ++p)
#pragma unroll
                for (int hh = 0; hh < 2; ++hh) { const u32x4 w = cur[p][hh]; LN_ACC(v, w, hh); }
            const int g = r >= NP;
            for (unsigned mr = myrest; mr != 0u; mr &= mr - 1u) {
                const int e = __builtin_ctz(mr); const int sl = __builtin_amdgcn_readlane(myinv, e);
                const bf16* ye = (const bf16*)(ws + AR_YE) + (size_t)((g ? NP * 2 + e * 4096 : e * 2048) + sl) * D;
#pragma unroll
                for (int hh = 0; hh < 2; ++hh) { const u32x4 w = *(const u32x4*)(ye + hh * 512 + lane * 8); LN_ACC(v, w, hh); }
            }
        } else {
            LN_UNPK(nx, zq2[0], 0); LN_UNPK(nx, zq2[1], 1);
            { const int rn = r + 2 * NGW < NTOK ? r + 2 * NGW : r; LN_LOADQ2(rn); }
        }
        float s = 0.f, s2 = 0.f;
#pragma unroll
        for (int j = 0; j < 4; ++j) { s += (v[j].x + v[j].y) + (v[j].z + v[j].w); s2 += (v[j].x * v[j].x + v[j].y * v[j].y) + (v[j].z * v[j].z + v[j].w * v[j].w); }
        s = wave_sum(s); s2 = wave_sum(s2);
        const float mean = s * (1.f / D);
        const float rstd = 1.f / sqrtf(fmaxf(s2 * (1.f / D) - mean * mean, 0.f) + LN_EPS);
#pragma unroll
        for (int j = 0; j < 4; ++j) v[j] = v[j] - mean;
#pragma unroll
        for (int j = 0; j < 4; ++j) v[j] = v[j] * rstd * gw4[j] + gb4[j];
        if (final_out) {
#pragma unroll
            for (int j = 0; j < 4; ++j) *(f32x4*)(args.out + (size_t)r * D + LN_COL(j)) = v[j];
        } else {
#pragma unroll
            for (int hh = 0; hh < 2; ++hh) { if (!RESID_BF16) { *(f32x4*)(X32 + (size_t)r * D + LN_COL(2 * hh)) = v[2 * hh]; *(f32x4*)(X32 + (size_t)r * D + LN_COL(2 * hh + 1)) = v[2 * hh + 1]; }
                u32x4 o; o.x = pk2(v[2 * hh].x, v[2 * hh].y); o.y = pk2(v[2 * hh].z, v[2 * hh].w); o.z = pk2(v[2 * hh + 1].x, v[2 * hh + 1].y); o.w = pk2(v[2 * hh + 1].z, v[2 * hh + 1].w);
                *(u32x4*)(XB + (size_t)r * D + hh * 512 + lane * 8) = o;
                if (MOE_GATHER_FUSED && mode == 1) { u32x2 q; q.x = pk4_fp8(v[2 * hh].x, v[2 * hh].y, v[2 * hh].z, v[2 * hh].w); q.y = pk4_fp8(v[2 * hh + 1].x, v[2 * hh + 1].y, v[2 * hh + 1].z, v[2 * hh + 1].w);
                    *(u32x2*)(ws + AR_XE + (size_t)r * D + hh * 512 + lane * 8) = q; } }
        }
        if (mode == 1) {
            asm volatile("" ::: "memory");
            float pa[16];
#pragma unroll
            for (int e = 0; e < 16; ++e) { float a = 0.f;
#pragma unroll
                for (int j = 0; j < 4; ++j) { const f32x4 w = *((const LAS f32x4*)(wrT + e * 1024) + lane + 64 * j); a += (v[j].x * w.x + v[j].y * w.y) + (v[j].z * w.z + v[j].w * w.w); }
                pa[e] = a; }
            const bool b5 = (lane & 32) != 0, b4 = (lane & 16) != 0, b3 = (lane & 8) != 0, b2 = (lane & 4) != 0;
            float p8[8], p4[4], p2[2];
#pragma unroll
            for (int k = 0; k < 8; ++k) p8[k] = (b5 ? pa[8 + k] : pa[k]) + shx(b5 ? pa[k] : pa[8 + k], 32, lane);
#pragma unroll
            for (int k = 0; k < 4; ++k) p4[k] = (b4 ? p8[4 + k] : p8[k]) + shx(b4 ? p8[k] : p8[4 + k], 16, lane);
#pragma unroll
            for (int k = 0; k < 2; ++k) p2[k] = (b3 ? p4[2 + k] : p4[k]) + shx(b3 ? p4[k] : p4[2 + k], 8, lane);
            float lgv = (b2 ? p2[1] : p2[0]) + shx(b2 ? p2[0] : p2[1], 4, lane);
            lgv += shx(lgv, 2, lane); lgv += shx(lgv, 1, lane);
            float mx = lgv; mx = fmaxf(mx, shx(mx, 4, lane)); mx = fmaxf(mx, shx(mx, 8, lane)); mx = fmaxf(mx, shx(mx, 16, lane)); mx = fmaxf(mx, shx(mx, 32, lane));
            const float ex = exp_(lgv - mx);
            float tot = ex; tot += shx(tot, 4, lane); tot += shx(tot, 8, lane); tot += shx(tot, 16, lane); tot += shx(tot, 32, lane);
            if ((lane & 3) == 0) ((float*)(ws + WS_AFF))[(size_t)(lane >> 2) * NTOK + r] = ex * (1.f / tot);
        }
    }
}

struct CV { float q, k, lf; };
__device__ __forceinline__ CV chanvals(int type, const bf16* prow, int h, int k, int dir, float lbv, float lg, const float2* rot) {
    CV o;
    if (type == 0) {
        const float aq = bf2f(prow[h * 128 + k]); o.q = siluf_(aq);
        const float z = bf2f(prow[1024 + dir * 512 + h * 128 + k]);
        const float f = lbv + (1.f - lbv) * sigmoidf_(z);
        o.k = 1.f - f; o.lf = log_(f);
    } else {
        const int c0 = h * 128 + k, c1 = h * 128 + (k ^ 1);
        const float2 cs = rot[k >> 1];
        const float xq = bf2f(prow[2560 + c0]), xq2 = bf2f(prow[2560 + c1]), xk = bf2f(prow[3072 + c0]), xk2 = bf2f(prow[3072 + c1]);
        if (k & 1) { o.q = xq * cs.x + xq2 * cs.y; o.k = xk * cs.x + xk2 * cs.y; } else { o.q = xq * cs.x - xq2 * cs.y; o.k = xk * cs.x - xk2 * cs.y; }
        o.k *= 0.08838834764831845f; o.lf = lg;
    }
    return o;
}
__device__ __forceinline__ void even_setup(const Args& args, int j, int type, int h, int k, int dir, float& lbv, float& lg) {
    lbv = 0.f; lg = 0.f;
    if (type == 0) { if (j == 1) { const float* l = args.in[I_ELB] + (size_t)dir * 2 * 512; lbv = sigmoidf_(l[512 + h * 128 + k] - l[h * 128 + k]); } }
    else lg = logf(1.f - exp2f(-5.f - (float)h));
}
__device__ __forceinline__ bf16x8 load_vfrag(const bf16* base, int ld) {
    bf16x8 r;
#pragma unroll
    for (int e = 0; e < 8; ++e) r[e] = (short)base[(size_t)e * ld];
    return r;
}
__device__ __forceinline__ void even_stage_load(u32x4 (&rg)[4][2], const bf16* PROJ, int type, int h, int row0, int tid) {
#pragma unroll
    for (int i = 0; i < 4; ++i) {
        if (i == 2 && type != 0) continue;
        const int col0 = (i == 3 ? (type == 0 ? 512 : 3584) : type == 0 ? (i == 0 ? 0 : i == 1 ? 1024 : 1536) : (i == 0 ? 2560 : 3072)) + h * 128;
#pragma unroll
        for (int c2 = 0; c2 < 2; ++c2) { const int c = tid + 512 * c2, row = c >> 4, c16 = c & 15; rg[i][c2] = *(const u32x4*)(PROJ + (size_t)(row0 + row) * DIN + col0 + c16 * 8); }
    }
}
__device__ __forceinline__ void even_stage_commit(const u32x4 (&rg)[4][2], LAS uchar* raw, LAS uchar* vtile, int type, int tid) {
#pragma unroll
    for (int i = 0; i < 4; ++i) {
        if (i == 2 && type != 0) continue;
#pragma unroll
        for (int c2 = 0; c2 < 2; ++c2) { const int c = tid + 512 * c2, row = c >> 4, c16 = c & 15; *(LAS u32x4*)((i == 3 ? vtile : raw + i * 17408) + row * 272 + c16 * 16) = rg[i][c2]; }
    }
}
__device__ __forceinline__ bf16x8 lds_vfrag(const LAS uchar* vtile, int tok0, int ch) {
    bf16x8 r;
#pragma unroll
    for (int e = 0; e < 8; ++e) r[e] = (short)*(const LAS bf16*)(vtile + (tok0 + e) * 272 + ch * 2);
    return r;
}
__device__ __forceinline__ void even_elem(const Args& args, int j, int type, int h, int row0, int pos0, const bf16* PROJ, const float2* ROT, LAS uchar* raw, LAS float* HS, int tid,
                                          float (&qv)[32], float (&kv)[32], float (&lf)[32], float& start, float& ref, float& total) {
    const int k = tid & 127, dir = (tid >> 7) & 1, half = tid >> 8;
    float lbv, lg; even_setup(args, j, type, h, k, dir, lbv, lg);
    __syncthreads();
    float sum = 0.f;
    if (type == 0) {
        const LAS bf16* R0 = (const LAS bf16*)raw; const LAS bf16* RZ = (const LAS bf16*)(raw + (1 + dir) * 17408);
#pragma unroll
        for (int i = 0; i < 32; ++i) { const int t = 32 * half + i;
            const float aq = bf2f(R0[t * 136 + k]), z = bf2f(RZ[t * 136 + k]);
            const float f = lbv + (1.f - lbv) * sigmoidf_(z);
            qv[i] = siluf_(aq); kv[i] = 1.f - f; lf[i] = log_(f); sum += lf[i]; }
    } else {
        const LAS bf16* R0 = (const LAS bf16*)raw; const LAS bf16* R1 = (const LAS bf16*)(raw + 17408);
        const float2 dcs = ROT[64 + (k >> 1)];
        float2 cs = ROT[(size_t)(pos0 + 32 * half) * 64 + (k >> 1)]; const float2 cs16 = ROT[(size_t)(pos0 + 32 * half + 16) * 64 + (k >> 1)];
#pragma unroll
        for (int i = 0; i < 32; ++i) { const int t = 32 * half + i;
            if (i == 16) cs = cs16; else if (i > 0) { const float c_ = cs.x * dcs.x - cs.y * dcs.y, s_ = cs.y * dcs.x + cs.x * dcs.y; cs.x = c_; cs.y = s_; }
            const float xq = bf2f(R0[t * 136 + k]), xq2 = bf2f(R0[t * 136 + (k ^ 1)]), xk = bf2f(R1[t * 136 + k]), xk2 = bf2f(R1[t * 136 + (k ^ 1)]);
            float q_, k_;
            if (k & 1) { q_ = xq * cs.x + xq2 * cs.y; k_ = xk * cs.x + xk2 * cs.y; } else { q_ = xq * cs.x - xq2 * cs.y; k_ = xk * cs.x - xk2 * cs.y; }
            qv[i] = q_; kv[i] = k_ * 0.08838834764831845f; lf[i] = lg; sum += lg; }
    }
    HS[(dir * 2 + half) * 128 + k] = sum;
    __syncthreads();
    const float other = HS[(dir * 2 + (half ^ 1)) * 128 + k];
    const bool first = dir ? (half == 1) : (half == 0);
    start = first ? 0.f : other; ref = first ? sum : other; total = sum + other;
}
__device__ __forceinline__ void even_elem_c(const Args& args, int j, int type, int h, int row0, int pos0, const bf16* PROJ, const float2* ROT, LAS uchar* raw, LAS float* HS, int tid,
                                            LAS bf16* qx, LAS bf16* kx, float (&lf)[32], float& start, float& ref, float& total) {
    const int k = tid & 127, dir = (tid >> 7) & 1, half = tid >> 8;
    float lbv, lg; even_setup(args, j, type, h, k, dir, lbv, lg);
    __syncthreads();
    float sum = 0.f;
    if (type == 0) {
        const LAS bf16* R0 = (const LAS bf16*)raw + (32 * half) * 136 + k; const LAS bf16* RZ = (const LAS bf16*)(raw + (1 + dir) * 17408) + (32 * half) * 136 + k;
#pragma unroll
        for (int i = 0; i < 32; ++i) {
            const float aq = bf2f(R0[i * 136]), z = bf2f(RZ[i * 136]);
            const float f = lbv + (1.f - lbv) * sigmoidf_(z);
            qx[i * 136] = f2bf_hw(siluf_(aq)); kx[i * 136] = f2bf_hw(1.f - f); lf[i] = log_(f); sum += lf[i]; }
    } else {
        const LAS bf16* R0 = (const LAS bf16*)raw + (32 * half) * 136; const LAS bf16* R1 = (const LAS bf16*)(raw + 17408) + (32 * half) * 136;
        const float2* rot = ROT + (size_t)(pos0 + 32 * half) * 64 + (k >> 1);
        const float2 dcs = ROT[64 + (k >> 1)]; float2 cs = rot[0]; const float2 cs16 = rot[16 * 64];
#pragma unroll
        for (int i = 0; i < 32; ++i) {
            if (i == 16) cs = cs16; else if (i > 0) { const float c_ = cs.x * dcs.x - cs.y * dcs.y, s_ = cs.y * dcs.x + cs.x * dcs.y; cs.x = c_; cs.y = s_; }
            const float xq = bf2f(R0[i * 136 + k]), xq2 = bf2f(R0[i * 136 + (k ^ 1)]), xk = bf2f(R1[i * 136 + k]), xk2 = bf2f(R1[i * 136 + (k ^ 1)]);
            float q_, k_;
            if (k & 1) { q_ = xq * cs.x + xq2 * cs.y; k_ = xk * cs.x + xk2 * cs.y; } else { q_ = xq * cs.x - xq2 * cs.y; k_ = xk * cs.x - xk2 * cs.y; }
            qx[i * 136] = f2bf_hw(q_); kx[i * 136] = f2bf_hw(k_ * 0.08838834764831845f); lf[i] = lg; sum += lg; }
    }
    HS[(dir * 2 + half) * 128 + k] = sum;
    __syncthreads();
    const float other = HS[(dir * 2 + (half ^ 1)) * 128 + k];
    const bool first = dir ? (half == 1) : (half == 0);
    start = first ? 0.f : other; ref = first ? sum : other; total = sum + other;
}
__device__ __forceinline__ void even_cumul(int dir, float start, float (&lf)[32]) {
    float run = start;
    if (dir == 0) {
#pragma unroll
        for (int i = 0; i < 32; ++i) { run += lf[i]; lf[i] = run; }
    } else {
#pragma unroll
        for (int i = 31; i >= 0; --i) { run += lf[i]; lf[i] = run; }
    }
}
__device__ __forceinline__ void even_phase_a(const Args& args, LAS uchar* lds, int j, int G, int wave_sgpr_) {
    unsigned char* ws = opaque_ptr(args.ws);
    const bf16* PROJ = (const bf16*)(ws + AR_PROJ); bf16* ST = (bf16*)(ws + AR_ST); float* DEC = (float*)(ws + AR_DEC); const float2* ROT = (const float2*)(ws + WS_ROT);
    const int tid = opaque_tid(), wave = uni(tid >> 6), lane = tid & 63, fr = lane & 15, fq = lane >> 4;
    LAS bf16* KT = (LAS bf16*)lds;
    LAS uchar* RAW = lds + 36864;
    LAS float* HS = (LAS float*)(lds + 36864 + 3 * 17408);
    LAS uchar* VTL = lds + 36864 + 3 * 17408 + 2048;
    u32x4 rg[4][2];
#pragma unroll
    for (int i = 0; i < 4; ++i) { rg[i][0] = (u32x4){0u, 0u, 0u, 0u}; rg[i][1] = rg[i][0]; }
    { const int u = opaque_bx(); if (u < 2 * NCHUNK * 4) even_stage_load(rg, PROJ, u / (NCHUNK * 4), u & 3, ((u % (NCHUNK * 4)) >> 2) * 64, tid); }
    for (int u = opaque_bx(); u < 2 * NCHUNK * 4; u += G) {
        const int type = u / (NCHUNK * 4), rem = u % (NCHUNK * 4), cg = rem >> 2, h = rem & 3, row0 = cg * 64, pos0 = row_pos(row0);
        __syncthreads();
        even_stage_commit(rg, RAW, VTL, type, tid);
        { const int un = u + G; if (un < 2 * NCHUNK * 4) even_stage_load(rg, PROJ, un / (NCHUNK * 4), un & 3, ((un % (NCHUNK * 4)) >> 2) * 64, tid); }
        {
            float qv[32], kv[32], lf[32], start, ref, total;
            even_elem(args, j, type, h, row0, pos0, PROJ, ROT, RAW, HS, tid, qv, kv, lf, start, ref, total);
            const int k = tid & 127, dir = (tid >> 7) & 1, half = tid >> 8;
            if (half == 0) DEC[((size_t)((type * 2 + dir) * NCHUNK + cg) * 4 + h) * 128 + k] = exp_(total);
            even_cumul(uni(dir), start, lf);
            float val[32];
#pragma unroll
            for (int i = 0; i < 32; ++i) val[i] = kv[i] * exp_(total - lf[i]);
            LAS bf16* kt = KT + ((size_t)dir * 128 + k) * 72 + 32 * half;
#pragma unroll
            for (int g8 = 0; g8 < 4; ++g8) { u32x4 o; o.x = pk2(val[8 * g8 + 0], val[8 * g8 + 1]); o.y = pk2(val[8 * g8 + 2], val[8 * g8 + 3]); o.z = pk2(val[8 * g8 + 4], val[8 * g8 + 5]); o.w = pk2(val[8 * g8 + 6], val[8 * g8 + 7]);
                *(LAS u32x4*)(kt + 8 * g8) = o; }
        }
        __syncthreads();
        bf16x8 vf[2];
#pragma unroll
        for (int ks = 0; ks < 2; ++ks) vf[ks] = lds_vfrag(VTL, 32 * ks + 8 * fq, 16 * wave + fr);
#pragma unroll
        for (int dir = 0; dir < 2; ++dir) {
            bf16* st = ST + ((size_t)((type * 2 + dir) * NCHUNK + cg) * 4 + h) * 16384 + (size_t)(16 * wave + fr) * 128;
#pragma unroll
            for (int nb = 0; nb < 8; ++nb) {
                f32x4 acc = (f32x4){0.f, 0.f, 0.f, 0.f};
#pragma unroll
                for (int ks = 0; ks < 2; ++ks) { const bf16x8 kf = *(const LAS bf16x8*)(KT + ((size_t)dir * 128 + 16 * nb + fr) * 72 + 32 * ks + 8 * fq);
                    acc = __builtin_amdgcn_mfma_f32_16x16x32_bf16(kf, vf[ks], acc, 0, 0, 0); }
                { u32x2 o_; o_.x = pk2(acc[0], acc[1]); o_.y = pk2(acc[2], acc[3]); *(u32x2*)(st + 16 * nb + 4 * fq) = o_; }
            }
        }
    }
}
__device__ __forceinline__ void even_phase_b(const Args& args, int G, int wave_sgpr_) {
    unsigned char* ws = opaque_ptr(args.ws); bf16* ST = (bf16*)(ws + AR_ST); const float* DEC = (const float*)(ws + AR_DEC);
    const int gt = opaque_bx() * 512 + opaque_tid(), NT = G * 512;
    for (int it = gt; it < 4 * NSEQ * 4 * 2048; it += NT) {
        const int e8 = it & 2047, h = (it >> 11) & 3, rest = it >> 13, s = rest % NSEQ, td = rest / NSEQ, dir = td & 1;
        const int nc = s < 4 ? 64 : 32, cg0 = s < 4 ? s * 64 : 256 + (s - 4) * 32;
        float run[8];
#pragma unroll
        for (int i = 0; i < 8; ++i) run[i] = 0.f;
        for (int c0 = 0; c0 < nc; c0 += 8) {
            u32x4 uu[8]; f32x4 d0[8], d1[8];
#pragma unroll
            for (int e = 0; e < 8; ++e) { const int c = c0 + e, cg = dir ? cg0 + nc - 1 - c : cg0 + c;
                uu[e] = *((const u32x4*)(ST + ((size_t)(td * NCHUNK + cg) * 4 + h) * 16384) + e8);
                const f32x4* dp = (const f32x4*)(DEC + ((size_t)(td * NCHUNK + cg) * 4 + h) * 128) + 2 * (e8 & 15); d0[e] = dp[0]; d1[e] = dp[1]; }
#pragma unroll
            for (int e = 0; e < 8; ++e) { const int c = c0 + e, cg = dir ? cg0 + nc - 1 - c : cg0 + c;
                u32x4 o; o.x = pk2(run[0], run[1]); o.y = pk2(run[2], run[3]); o.z = pk2(run[4], run[5]); o.w = pk2(run[6], run[7]);
                *((u32x4*)(ST + ((size_t)(td * NCHUNK + cg) * 4 + h) * 16384) + e8) = o;
                run[0] = d0[e].x * run[0] + bflo(uu[e].x); run[1] = d0[e].y * run[1] + bfhi(uu[e].x); run[2] = d0[e].z * run[2] + bflo(uu[e].y); run[3] = d0[e].w * run[3] + bfhi(uu[e].y);
                run[4] = d1[e].x * run[4] + bflo(uu[e].z); run[5] = d1[e].y * run[5] + bfhi(uu[e].z); run[6] = d1[e].z * run[6] + bflo(uu[e].w); run[7] = d1[e].w * run[7] + bfhi(uu[e].w); }
        }
    }
}
__device__ __forceinline__ void even_phase_c(const Args& args, LAS uchar* lds, int j, int G, int wave_sgpr_) {
    unsigned char* ws = opaque_ptr(args.ws);
    const bf16* PROJ = (const bf16*)(ws + AR_PROJ); const bf16* ST = (const bf16*)(ws + AR_ST); const float2* ROT = (const float2*)(ws + WS_ROT); bf16* OM = (bf16*)(ws + AR_OME);
    const int tid = opaque_tid(), wave = uni(tid >> 6), lane = tid & 63, fr = lane & 15, fq = lane >> 4;
    constexpr int TP = 136;
    LAS bf16* QX = (LAS bf16*)lds;
    LAS bf16* KX = QX + 2 * 64 * TP;
    LAS bf16* QI = KX + 2 * 64 * TP;
    LAS bf16* PT = QI + 2 * 64 * TP;
    LAS f32x2* STAT = (LAS f32x2*)(PT + 64 * 72);
    LAS uchar* RAW = lds + 69632;
    LAS float* HS = (LAS float*)(lds + 69632 + 3 * 17408);
    LAS uchar* VTL = lds + MISC_OFF + 64;
    static_assert(69632 + 3 * 17408 + 2048 <= XLDS_OFF && MISC_OFF + 64 + 17408 <= LDS_BYTES, "even_phase_c LDS map");
    u32x4 rg[4][2];
#pragma unroll
    for (int i = 0; i < 4; ++i) { rg[i][0] = (u32x4){0u, 0u, 0u, 0u}; rg[i][1] = rg[i][0]; }
    { const int u = opaque_bx(); if (u < 2 * NCHUNK * 4) even_stage_load(rg, PROJ, u / (NCHUNK * 4), u & 3, ((u % (NCHUNK * 4)) >> 2) * 64, tid); }
    for (int u = opaque_bx(); u < 2 * NCHUNK * 4; u += G) {
        const int type = u / (NCHUNK * 4), rem = u % (NCHUNK * 4), cg = rem >> 2, h = rem & 3, row0 = cg * 64, pos0 = row_pos(row0);
        bf16x8 sfq[2][4]; u32x2 gwq[4];
        {
#pragma unroll
            for (int dir = 0; dir < 2; ++dir) { const bf16* st = ST + ((size_t)((type * 2 + dir) * NCHUNK + cg) * 4 + h) * 16384 + (size_t)(16 * wave + fr) * 128;
#pragma unroll
                for (int ks = 0; ks < 4; ++ks) sfq[dir][ks] = *(const bf16x8*)(st + 32 * ks + 8 * fq); }
            const int gcol = (type == 0 ? 2048 : 4096) + h * 128 + 16 * wave + 4 * fq;
#pragma unroll
            for (int mb = 0; mb < 4; ++mb) gwq[mb] = *(const u32x2*)(PROJ + (size_t)(row0 + 16 * mb + fr) * DIN + gcol);
        }
        __syncthreads();
        even_stage_commit(rg, RAW, VTL, type, tid);
        { const int un = u + G; if (un < 2 * NCHUNK * 4) even_stage_load(rg, PROJ, un / (NCHUNK * 4), un & 3, ((un % (NCHUNK * 4)) >> 2) * 64, tid); }
        {
            float lf[32], start, ref, total;
            const int k = tid & 127, dir = (tid >> 7) & 1, half = tid >> 8;
            LAS bf16* qx = QX + ((size_t)dir * 64 + 32 * half) * TP + k; LAS bf16* kx = KX + ((size_t)dir * 64 + 32 * half) * TP + k; LAS bf16* qi = QI + ((size_t)dir * 64 + 32 * half) * TP + k;
            even_elem_c(args, j, type, h, row0, pos0, PROJ, ROT, RAW, HS, tid, qx, kx, lf, start, ref, total);
            even_cumul(uni(dir), start, lf);
            const float eref = exp_(ref);
#pragma unroll
            for (int i = 0; i < 32; ++i) {
                const float e1 = exp_(lf[i] - ref), q_ = bf2f(qx[i * TP]), k_ = bf2f(kx[i * TP]);
                qx[i * TP] = f2bf_hw(q_ * e1);
                kx[i * TP] = f2bf_hw(k_ * __builtin_amdgcn_rcpf(e1));
                qi[i * TP] = f2bf_hw(q_ * e1 * eref); }
        }
        __syncthreads();
        {
            const int mb = wave >> 1;
#pragma unroll
            for (int nn = 0; nn < 2; ++nn) {
                const int nbk = 2 * (wave & 1) + nn;
                f32x4 af = (f32x4){0.f, 0.f, 0.f, 0.f}, ab = af;
#pragma unroll
                for (int ks = 0; ks < 4; ++ks) {
                    const bf16x8 kf = *(const LAS bf16x8*)(KX + ((size_t)0 * 64 + 16 * nbk + fr) * TP + 32 * ks + 8 * fq), qf = *(const LAS bf16x8*)(QX + ((size_t)0 * 64 + 16 * mb + fr) * TP + 32 * ks + 8 * fq);
                    af = __builtin_amdgcn_mfma_f32_16x16x32_bf16(kf, qf, af, 0, 0, 0);
                    const bf16x8 kb = *(const LAS bf16x8*)(KX + ((size_t)1 * 64 + 16 * nbk + fr) * TP + 32 * ks + 8 * fq), qb = *(const LAS bf16x8*)(QX + ((size_t)1 * 64 + 16 * mb + fr) * TP + 32 * ks + 8 * fq);
                    ab = __builtin_amdgcn_mfma_f32_16x16x32_bf16(kb, qb, ab, 0, 0, 0);
                }
                const int t = 16 * mb + fr; float p[4];
#pragma unroll
                for (int r = 0; r < 4; ++r) { const int s = 16 * nbk + 4 * fq + r; const float vf_ = (s <= t) ? af[r] : 0.f; const float vb_ = (type == 0 ? (s >= t) : (s > t)) ? ab[r] : 0.f; p[r] = vf_ + vb_; }
                u32x2 o; o.x = pk2(p[0], p[1]); o.y = pk2(p[2], p[3]);
                *(LAS u32x2*)(PT + (size_t)t * 72 + 16 * nbk + 4 * fq) = o;
            }
        }
        __syncthreads();
#ifndef E2C_DBG
#define E2C_DBG 0
#endif
        f32x4 acc[4];
#pragma unroll
        for (int mb = 0; mb < 4; ++mb) acc[mb] = (f32x4){0.f, 0.f, 0.f, 0.f};
        {
            bf16x8 vfq[2];
#pragma unroll
            for (int ks = 0; ks < 2; ++ks) vfq[ks] = lds_vfrag(VTL, 32 * ks + 8 * fq, 16 * wave + fr);
#pragma unroll
            for (int ks = 0; ks < 2; ++ks) {
#pragma unroll
                for (int mb = 0; mb < 4; ++mb) { const bf16x8 pf = *(const LAS bf16x8*)(PT + (size_t)(16 * mb + fr) * 72 + 32 * ks + 8 * fq); acc[mb] = __builtin_amdgcn_mfma_f32_16x16x32_bf16(vfq[ks], pf, acc[mb], 0, 0, 0); } }
#pragma unroll
            for (int dir = 0; dir < 2; ++dir) {
#pragma unroll
                for (int ks = 0; ks < 4; ++ks) {
#pragma unroll
                    for (int mb = 0; mb < 4; ++mb) { const bf16x8 qf = *(const LAS bf16x8*)(QI + ((size_t)dir * 64 + 16 * mb + fr) * TP + 32 * ks + 8 * fq); acc[mb] = __builtin_amdgcn_mfma_f32_16x16x32_bf16(sfq[dir][ks], qf, acc[mb], 0, 0, 0); } }
            }
        }
#pragma unroll
        for (int mb = 0; mb < 4; ++mb) { float s1 = (acc[mb][0] + acc[mb][1]) + (acc[mb][2] + acc[mb][3]); float s2 = (acc[mb][0] * acc[mb][0] + acc[mb][1] * acc[mb][1]) + (acc[mb][2] * acc[mb][2] + acc[mb][3] * acc[mb][3]);
            s1 = xor32_sum(xor16_sum(s1)); s2 = xor32_sum(xor16_sum(s2));
            if (fq == 0) STAT[(16 * mb + fr) * 8 + wave] = (f32x2){s1, s2}; }
        __syncthreads();
        {
            const float* gain = (type == 0 ? args.in[I_ENA] : args.in[I_ENB]) + (size_t)j * 512 + h * 128 + 16 * wave + 4 * fq;
            const f32x4 gn = *(const f32x4*)gain;
#pragma unroll
            for (int mb = 0; mb < 4; ++mb) {
                const int t = 16 * mb + fr; float S1 = 0.f, S2 = 0.f;
#pragma unroll
                for (int w = 0; w < 8; ++w) { const f32x2 a = STAT[t * 8 + w]; S1 += a.x; S2 += a.y; }
                const float mean = (type == 0) ? 0.f : ldexpf(S1, -7);
                const float var = ldexpf(S2, -7) - mean * mean;
                const float rstd = 1.f / sqrtf(fmaxf(var, 0.f) + 1e-6f);
                const u32x2 gw = gwq[mb];
                const float g0 = siluf_(bflo(gw.x)), g1 = siluf_(bfhi(gw.x)), g2 = siluf_(bflo(gw.y)), g3 = siluf_(bfhi(gw.y));
                const float o0 = (acc[mb][0] - mean) * rstd * gn.x * g0, o1 = (acc[mb][1] - mean) * rstd * gn.y * g1, o2 = (acc[mb][2] - mean) * rstd * gn.z * g2, o3 = (acc[mb][3] - mean) * rstd * gn.w * g3;
                u32x2 o; o.x = pk2(o0, o1); o.y = pk2(o2, o3);
                if (E2C_DBG) { o.x = pk2(acc[mb][0], acc[mb][1]); o.y = pk2(acc[mb][2], acc[mb][3]); }
                *(u32x2*)(OM + (size_t)(row0 + t) * D + type * 512 + h * 128 + 16 * wave + 4 * fq) = o;
            }
        }
    }
}

__device__ __forceinline__ void unpack8(const u32x4 a, float (&o)[8]) {
    o[0] = bflo(a.x); o[1] = bfhi(a.x); o[2] = bflo(a.y); o[3] = bfhi(a.y); o[4] = bflo(a.z); o[5] = bfhi(a.z); o[6] = bflo(a.w); o[7] = bfhi(a.w);
}
__device__ __forceinline__ u32x4 pack8(const float (&v)[8]) { u32x4 a; a.x = pk2(v[0], v[1]); a.y = pk2(v[2], v[3]); a.z = pk2(v[4], v[5]); a.w = pk2(v[6], v[7]); return a; }
__device__ __forceinline__ void load8f(const float* p, float (&o)[8]) { const f32x4 a = *(const f32x4*)p, b = *((const f32x4*)p + 1); o[0] = a.x; o[1] = a.y; o[2] = a.z; o[3] = a.w; o[4] = b.x; o[5] = b.y; o[6] = b.z; o[7] = b.w; }
__device__ __forceinline__ float oct_sum(float v) {
    v = quad_sum(v);
    v += __builtin_bit_cast(float, __builtin_amdgcn_mov_dpp(__builtin_bit_cast(int, v), 0x141, 0xF, 0xF, true));
    return v;
}
__device__ __forceinline__ void odd_shiftmix(const Args& args, int j, int gw, int NGW, int lane) {
    unsigned char* ws = opaque_ptr(args.ws); const bf16* XBr = (const bf16*)(ws + WS_XB); bf16* XM = (bf16*)(ws + AR_XM);
    const float* mu = args.in[I_OMU] + (size_t)j * 6 * D + 16 * lane;
    const int per = (NTOK + NGW - 1) / NGW, rb = gw * per, re = rb + per < NTOK ? rb + per : NTOK;
    if (rb >= re) return;
    float m[6][2][8];
#pragma unroll
    for (int p = 0; p < 6; ++p) { load8f(mu + (size_t)p * D, m[p][0]); load8f(mu + (size_t)p * D + 8, m[p][1]); }
    const u32x4 z4 = (u32x4){0u, 0u, 0u, 0u};
    u32x4 pv[2] = {z4, z4}, cu[2], nx[2] = {z4, z4};
#define SM_LD(dst_, rr_) do { const u32x4* p_ = (const u32x4*)(XBr + (size_t)(rr_) * D + 16 * lane); dst_[0] = p_[0]; dst_[1] = p_[1]; } while (0)
    if (rb > 0) SM_LD(pv, rb - 1);
    SM_LD(cu, rb);
    if (rb + 1 < NTOK) SM_LD(nx, rb + 1);
    for (int r = rb; r < re; ++r) {
        u32x4 n2[2] = {z4, z4};
        if (r + 1 < re && r + 2 < NTOK) SM_LD(n2, r + 2);
        const int pos = row_pos(r), T = row_T(r);
        const bool hp = pos > 0, hn = pos < T - 1;
#pragma unroll
        for (int hh = 0; hh < 2; ++hh) {
            float x[8], xp[8], xn[8], xx[8];
            unpack8(cu[hh], x); unpack8(pv[hh], xp); unpack8(nx[hh], xn);
#pragma unroll
            for (int i = 0; i < 8; ++i) xx[i] = ((hp ? xp[i] : 0.f) + (hn ? xn[i] : 0.f)) * 0.5f - x[i];
#pragma unroll
            for (int p = 0; p < 6; ++p) { float v[8];
#pragma unroll
                for (int i = 0; i < 8; ++i) v[i] = x[i] + xx[i] * m[p][hh][i];
                *((u32x4*)(XM + ((size_t)p * NTOK + r) * D + 16 * lane) + hh) = pack8(v); }
        }
        pv[0] = cu[0]; pv[1] = cu[1]; cu[0] = nx[0]; cu[1] = nx[1]; nx[0] = n2[0]; nx[1] = n2[1];
    }
#undef SM_LD
}
__device__ __forceinline__ void unpack16(const bf16* p, float (&o)[16]) {
    const u32x4 a = *(const u32x4*)p, b = *((const u32x4*)p + 1);
    o[0] = bflo(a.x); o[1] = bfhi(a.x); o[2] = bflo(a.y); o[3] = bfhi(a.y); o[4] = bflo(a.z); o[5] = bfhi(a.z); o[6] = bflo(a.w); o[7] = bfhi(a.w);
    o[8] = bflo(b.x); o[9] = bfhi(b.x); o[10] = bflo(b.y); o[11] = bfhi(b.y); o[12] = bflo(b.z); o[13] = bfhi(b.z); o[14] = bflo(b.w); o[15] = bfhi(b.w);
}
__device__ __forceinline__ void load16f(const float* p, float (&o)[16]) {
#pragma unroll
    for (int i = 0; i < 4; ++i) { const f32x4 v = *((const f32x4*)p + i); o[4 * i] = v.x; o[4 * i + 1] = v.y; o[4 * i + 2] = v.z; o[4 * i + 3] = v.w; }
}
__device__ __forceinline__ void store16bf(void* p, const float (&v)[16]) {
    u32x4 a, b; a.x = pk2(v[0], v[1]); a.y = pk2(v[2], v[3]); a.z = pk2(v[4], v[5]); a.w = pk2(v[6], v[7]); b.x = pk2(v[8], v[9]); b.y = pk2(v[10], v[11]); b.z = pk2(v[12], v[13]); b.w = pk2(v[14], v[15]);
    *(u32x4*)p = a; *((u32x4*)p + 1) = b;
}
__device__ __forceinline__ void odd_prep(const Args& args, int j, int gw, int NGW, int lane) {
    unsigned char* ws = opaque_ptr(args.ws);
    const bf16* R = (const bf16*)(ws + AR_RKV); const bf16* Kk = R + (size_t)NTOK * D; const bf16* LW = (const bf16*)(ws + AR_LW); const bf16* LA = (const bf16*)(ws + AR_LA);
    unsigned char* SCN = ws + AR_SCN; float* CB = (float*)(ws + AR_CB);
    const int hf = gw & 1, c0 = hf * 512 + 8 * lane, h = hf * 8 + (lane >> 3), sub = lane & 7;
    float k_k[8], k_a[8], r_k[8], w0v[2][8], a0v[2][8];
    load8f(args.in[I_OKK] + (size_t)j * D + c0, k_k); load8f(args.in[I_OKA] + (size_t)j * D + c0, k_a); load8f(args.in[I_ORK] + (size_t)j * D + c0, r_k);
#pragma unroll
    for (int dir = 0; dir < 2; ++dir) { load8f(args.in[I_OW0] + (size_t)j * 2 * D + dir * D + c0, w0v[dir]); load8f(args.in[I_OA0] + (size_t)j * 2 * D + dir * D + c0, a0v[dir]); }
    const int rstep = NGW >> 1;
    u32x4 nxt[6];
#define PREP_LD(rr_) do { const size_t r_ = (size_t)(rr_); nxt[0] = *(const u32x4*)(R + r_ * D + c0); nxt[1] = *(const u32x4*)(Kk + r_ * D + c0); \
        nxt[2] = *(const u32x4*)(LW + r_ * 2048 + c0); nxt[3] = *(const u32x4*)(LW + r_ * 2048 + 1024 + c0); nxt[4] = *(const u32x4*)(LA + r_ * 2048 + c0); nxt[5] = *(const u32x4*)(LA + r_ * 2048 + 1024 + c0); } while (0)
    if ((gw >> 1) < NTOK) PREP_LD(gw >> 1);
    for (int r = gw >> 1; r < NTOK; r += rstep) {
        u32x4 cur[6];
#pragma unroll
        for (int i = 0; i < 6; ++i) cur[i] = nxt[i];
        if (r + rstep < NTOK) PREP_LD(r + rstep);
        float rv[8], kv[8], kk[8];
        unpack8(cur[0], rv); unpack8(cur[1], kv);
        float ss = 0.f;
#pragma unroll
        for (int i = 0; i < 8; ++i) { kk[i] = kv[i] * k_k[i]; ss += kk[i] * kk[i]; }
        ss = oct_sum(ss);
        const float inv = 1.f / fmaxf(sqrtf(ss), 1e-12f);
#pragma unroll
        for (int i = 0; i < 8; ++i) kk[i] *= inv;
        unsigned char* row = SCN + ((size_t)r * 16 + h) * 1280;
        *(u32x4*)(row + sub * 16) = cur[0]; *(u32x4*)(row + 128 + sub * 16) = pack8(kk);
        float cbp = 0.f;
#pragma unroll
        for (int dir = 0; dir < 2; ++dir) {
            float lw[8], la[8], kd[8], bb[8], dec[8];
            unpack8(cur[2 + dir], lw); unpack8(cur[4 + dir], la);
#pragma unroll
            for (int i = 0; i < 8; ++i) {
                const float nx = -(w0v[dir][i] + lw[i]); const float sp = fmaxf(nx, 0.f) + log_(1.f + exp_(-fabsf(nx)));
                dec[i] = exp_(-exp_(-sp - 0.5f));
                const float a = sigmoidf_(a0v[dir][i] + la[i]);
                kd[i] = kv[i] * (1.f + (a - 1.f) * k_a[i]); bb[i] = kk[i] * a;
                cbp += rv[i] * r_k[i] * kd[i];
            }
            *(u32x4*)(row + 256 + dir * 512 + sub * 16) = pack8(kd); *(u32x4*)(row + 384 + dir * 512 + sub * 16) = pack8(bb);
            *(f32x4*)(row + 512 + dir * 512 + sub * 32) = (f32x4){dec[0], dec[1], dec[2], dec[3]}; *(f32x4*)(row + 512 + dir * 512 + sub * 32 + 16) = (f32x4){dec[4], dec[5], dec[6], dec[7]};
        }
        cbp = oct_sum(cbp);
        if (sub == 0) CB[(size_t)r * 16 + h] = cbp;
    }
#undef PREP_LD
}
__device__ __forceinline__ f32x2 oct_sum2(f32x2 v) { f32x2 r; r.x = oct_sum(v.x); r.y = oct_sum(v.y); return r; }
__device__ __forceinline__ void odd_scan_unit(const Args& args, LAS uchar* wl  , int s_, int h_, int dir_, int q16_, int lane) {
    const int s = uni(s_), h = uni(h_), dir = uni(dir_), q16 = uni(q16_);
    unsigned char* ws = opaque_ptr(args.ws); const unsigned char* SCN = ws + AR_SCN; const bf16* V = (const bf16*)(ws + AR_V); bf16* Y = (bf16*)(ws + (dir ? AR_YB : AR_YF));
    const int T = seq_T(s), r0 = seq_row0(s), rp = lane >> 3, c8 = lane & 7, i0 = q16 * 16 + 2 * rp;
    constexpr int TS = 8;
    f32x2 S[2][4];
#pragma unroll
    for (int r = 0; r < 2; ++r)
#pragma unroll
        for (int c = 0; c < 4; ++c) S[r][c] = (f32x2){0.f, 0.f};
    const int soff = lane < 32 ? 8 * lane : (256 + dir * 512) + 8 * (lane - 32);
    const int soffw = lane < 16 ? (512 + dir * 512) + 16 * lane : (int)0xfffffff0u;
    u32x2 pre[2][TS]; u32x4 prew[2][TS]; unsigned vpre[2][TS];
    const int nblk = T / TS;
    const __amdgpu_buffer_rsrc_t rsrc = __builtin_amdgcn_make_buffer_rsrc((void*)ws, 0, 0xffffffff, 0x00020000);
    const unsigned sstep = dir ? 0u - 20480u : 20480u, vstep = dir ? 0u - 2048u : 2048u;
    const unsigned scn_base = (unsigned)AR_SCN + (unsigned)h * 1280u, v_base = (unsigned)AR_V + (unsigned)h * 128u;
    const int voff_v = i0 * 2, voff_y = c8 == 0 ? i0 * 2 : (int)0xfffffff0u;
    const unsigned y_base = (unsigned)(dir ? AR_YB : AR_YF) + (unsigned)h * 128u;
    unsigned ysoff = y_base + (unsigned)(r0 + (dir ? T - 1 : 0)) * 2048u; const unsigned ystep = dir ? 0u - 2048u : 2048u;
#define SCAN_ISSUE(set_, blk_) do { const int t0_ = dir ? T - 1 - (blk_) * TS : (blk_) * TS; const unsigned row0_ = (unsigned)(r0 + t0_); \
        unsigned so_ = scn_base + row0_ * 20480u, vo_ = v_base + row0_ * 2048u;     \
        _Pragma("unroll") for (int e = 0; e < TS; ++e) { \
            pre[set_][e] = __builtin_bit_cast(u32x2, __builtin_amdgcn_raw_buffer_load_b64(rsrc, soff, (int)so_, 0)); prew[set_][e] = __builtin_amdgcn_raw_buffer_load_b128(rsrc, soffw, (int)so_, 0); \
            vpre[set_][e] = __builtin_amdgcn_raw_buffer_load_b32(rsrc, voff_v, (int)vo_, 0); so_ += sstep; vo_ += vstep; } } while (0)
    const int cvec = lane >> 4, cdst = (cvec == 0 ? 256 : cvec == 1 ? 0 : cvec == 2 ? 512 : 768) + (lane & 15) * 16;
#define SCAN_COMMIT(set_, buf_) do { LAS uchar* base_ = wl + (buf_) * (TS * 1280); \
        _Pragma("unroll") for (int e = 0; e < TS; ++e) { const u32x2 w_ = pre[set_][e]; *(LAS f32x4*)(base_ + e * 1280 + cdst) = (f32x4){bflo(w_.x), bfhi(w_.x), bflo(w_.y), bfhi(w_.y)}; } \
        if (lane < 16) { _Pragma("unroll") for (int e = 0; e < TS; ++e) *(LAS u32x4*)(base_ + e * 1280 + 1024 + lane * 16) = prew[set_][e]; } } while (0)
    f32x4 okk[2][2], orr[2], okd[2], obb[2], oww[2];
#define SCAN_LOADKK(buf_, stp_) do { const LAS uchar* sp_ = (stp_); okk[buf_][0] = *(const LAS f32x4*)(sp_); okk[buf_][1] = *(const LAS f32x4*)(sp_ + 16); } while (0)
#define SCAN_LOADREST(stp_) do { const LAS uchar* sp_ = (stp_); _Pragma("unroll") for (int c4 = 0; c4 < 2; ++c4) { \
        okd[c4] = *(const LAS f32x4*)(sp_ + 512 + c4 * 16); obb[c4] = *(const LAS f32x4*)(sp_ + 768 + c4 * 16); oww[c4] = *(const LAS f32x4*)(sp_ + 1024 + c4 * 16); orr[c4] = *(const LAS f32x4*)(sp_ + 256 + c4 * 16); } } while (0)
    unsigned vcur[TS];
    SCAN_ISSUE(0, 0); SCAN_COMMIT(0, 0);
#pragma unroll
    for (int e = 0; e < TS; ++e) vcur[e] = vpre[0][e];
    SCAN_ISSUE(1, 1);
    SCAN_LOADKK(0, wl + c8 * 32);
    for (int blk2 = 0; blk2 < nblk; blk2 += 2) {
#pragma unroll
        for (int par = 0; par < 2; ++par) {
            const int blk = blk2 + par;
            if (blk + 2 < nblk) SCAN_ISSUE(par, blk + 2);
            LAS uchar* base = wl + par * (TS * 1280);
#pragma unroll
            for (int e = 0; e < TS; ++e) {
                const int cb = e & 1;
                SCAN_LOADREST(base + e * 1280 + c8 * 32);
                if (e + 1 < TS) SCAN_LOADKK(cb ^ 1, base + (e + 1) * 1280 + c8 * 32);
                const float vr[2] = {bflo(vcur[e]), bfhi(vcur[e])};
                const f32x2 kkp[4] = {(f32x2){okk[cb][0].x, okk[cb][0].y}, (f32x2){okk[cb][0].z, okk[cb][0].w}, (f32x2){okk[cb][1].x, okk[cb][1].y}, (f32x2){okk[cb][1].z, okk[cb][1].w}};
                float sa[2];
#pragma unroll
                for (int r = 0; r < 2; ++r) { f32x2 a = S[r][0] * kkp[0]; a = __builtin_elementwise_fma(S[r][1], kkp[1], a); a = __builtin_elementwise_fma(S[r][2], kkp[2], a); a = __builtin_elementwise_fma(S[r][3], kkp[3], a);
                    sa[r] = oct_sum(a.x + a.y); }
                const f32x2 kdp[4] = {(f32x2){okd[0].x, okd[0].y}, (f32x2){okd[0].z, okd[0].w}, (f32x2){okd[1].x, okd[1].y}, (f32x2){okd[1].z, okd[1].w}};
                const f32x2 bbp[4] = {(f32x2){obb[0].x, obb[0].y}, (f32x2){obb[0].z, obb[0].w}, (f32x2){obb[1].x, obb[1].y}, (f32x2){obb[1].z, obb[1].w}};
                const f32x2 wwp[4] = {(f32x2){oww[0].x, oww[0].y}, (f32x2){oww[0].z, oww[0].w}, (f32x2){oww[1].x, oww[1].y}, (f32x2){oww[1].z, oww[1].w}};
                const f32x2 rrp[4] = {(f32x2){orr[0].x, orr[0].y}, (f32x2){orr[0].z, orr[0].w}, (f32x2){orr[1].x, orr[1].y}, (f32x2){orr[1].z, orr[1].w}};
                float yy[2];
#pragma unroll
                for (int r = 0; r < 2; ++r) {
                    const f32x2 nsa = (f32x2){-sa[r], -sa[r]}, vv = (f32x2){vr[r], vr[r]};
                    f32x2 y = (f32x2){0.f, 0.f};
#pragma unroll
                    for (int c = 0; c < 4; ++c) { const f32x2 t = __builtin_elementwise_fma(nsa, bbp[c], vv * kdp[c]); S[r][c] = __builtin_elementwise_fma(S[r][c], wwp[c], t); y = __builtin_elementwise_fma(S[r][c], rrp[c], y); }
                    yy[r] = oct_sum(y.x + y.y);
                }
                asm volatile("" : "+v"(yy[0]), "+v"(yy[1]));
                __builtin_amdgcn_raw_buffer_store_b32(pk2(yy[0], yy[1]), rsrc, voff_y, (int)ysoff, 0);
                ysoff += ystep;
            }
            if (blk + 1 < nblk) {
                SCAN_COMMIT(par ^ 1, par ^ 1);
#pragma unroll
                for (int e = 0; e < TS; ++e) vcur[e] = vpre[par ^ 1][e];
                SCAN_LOADKK(0, wl + (par ^ 1) * (TS * 1280) + c8 * 32);
            }
        }
    }
}
__device__ __forceinline__ void odd_scan(const Args& args, LAS uchar* lds, int G, int wave, int lane, bool only0 = false) {
    const int c = blockIdx.x;
    volatile LAS unsigned* st = (volatile LAS unsigned*)(lds + MISC_OFF) + 8;
    unsigned st0 = 0u, st1 = 0u;
    if (wave == 0 && lane == 0) { st0 = st[0]; st1 = st[1]; }
    __syncthreads();
    if (c < 256 && !(only0 && wave != 0)) {
        LAS uchar* wl = lds + wave * 20480;
        if (wave < 2) { const int unit = 2 * c + wave;
            odd_scan_unit(args, wl, unit >> 7, (unit >> 3) & 15, (unit >> 2) & 1, unit & 3, lane);
        } else { const int k0 = wave < 4 ? 2 * (wave - 2) : wave, nk = wave < 4 ? 2 : 1;
            for (int uu = 0; uu < nk; ++uu) { const int u = 8 * c + k0 + uu; odd_scan_unit(args, wl, 4 + (u >> 7), (u >> 3) & 15, (u >> 2) & 1, u & 3, lane); }
        }
    }
    __syncthreads();
    if (wave == 0 && lane == 0) { st[0] = st0; st[1] = st1; }
}
__device__ __forceinline__ void unpack16r(const u32x4 a, const u32x4 b, float (&o)[16]) {
    o[0] = bflo(a.x); o[1] = bfhi(a.x); o[2] = bflo(a.y); o[3] = bfhi(a.y); o[4] = bflo(a.z); o[5] = bfhi(a.z); o[6] = bflo(a.w); o[7] = bfhi(a.w);
    o[8] = bflo(b.x); o[9] = bfhi(b.x); o[10] = bflo(b.y); o[11] = bfhi(b.y); o[12] = bflo(b.z); o[13] = bfhi(b.z); o[14] = bflo(b.w); o[15] = bfhi(b.w);
}
__device__ __forceinline__ void odd_post(const Args& args, int j, int gw, int NGW, int lane) {
    unsigned char* ws = opaque_ptr(args.ws);
    const bf16* YF = (const bf16*)(ws + AR_YF); const bf16* YB = (const bf16*)(ws + AR_YB); const bf16* V = (const bf16*)(ws + AR_V); const bf16* GG = (const bf16*)(ws + AR_GG);
    const float* CB = (const float*)(ws + AR_CB); bf16* OM = (bf16*)(ws + AR_OMO);
    const int c0 = 16 * lane, h = lane >> 2;
    float lw[16], lb[16];
    load16f(args.in[I_OLNW] + (size_t)j * D + c0, lw); load16f(args.in[I_OLNB] + (size_t)j * D + c0, lb);
    u32x4 nxt[8]; float ncb = 0.f;
#define POST_LD(rr_) do { const size_t o_ = (size_t)(rr_) * D + c0; nxt[0] = *(const u32x4*)(YF + o_); nxt[1] = *((const u32x4*)(YF + o_) + 1); nxt[2] = *(const u32x4*)(YB + o_); nxt[3] = *((const u32x4*)(YB + o_) + 1); \
        nxt[4] = *(const u32x4*)(V + o_); nxt[5] = *((const u32x4*)(V + o_) + 1); nxt[6] = *(const u32x4*)(GG + o_); nxt[7] = *((const u32x4*)(GG + o_) + 1); ncb = CB[(size_t)(rr_) * 16 + h]; } while (0)
    if (gw < NTOK) POST_LD(gw);
    for (int r = gw; r < NTOK; r += NGW) {
        const size_t o = (size_t)r * D + c0;
        float yf[16], yb[16], vv[16], gg[16], y[16], on[16];
        unpack16r(nxt[0], nxt[1], yf); unpack16r(nxt[2], nxt[3], yb); unpack16r(nxt[4], nxt[5], vv); unpack16r(nxt[6], nxt[7], gg);
        const float cb = ncb;
        if (r + NGW < NTOK) POST_LD(r + NGW);
        float s1 = 0.f;
#pragma unroll
        for (int i = 0; i < 16; ++i) { y[i] = yf[i] + yb[i]; s1 += y[i]; }
        const float mean = quad_sum(s1) * (1.f / 64.f);
        float s2 = 0.f;
#pragma unroll
        for (int i = 0; i < 16; ++i) { y[i] -= mean; s2 += y[i] * y[i]; }
        const float rstd = 1.f / sqrtf(quad_sum(s2) * (1.f / 64.f) + 64e-5f);
#pragma unroll
        for (int i = 0; i < 16; ++i) on[i] = ((y[i] * rstd) * lw[i] + lb[i] + cb * vv[i]) * gg[i];
        store16bf(OM + o, on);
    }
#undef POST_LD
}

typedef short bf16x4 __attribute__((ext_vector_type(4)));
__device__ __forceinline__ u32x2 pk4bf(float a, float b, float c, float d) { u32x2 w; w.x = pk2(a, b); w.y = pk2(c, d); return w; }
#define ROW_SHR_ADD(x_, n_) ((x_) + __builtin_bit_cast(float, __builtin_amdgcn_update_dpp(0, __builtin_bit_cast(int, (x_)), 0x110 + (n_), 0xF, 0xF, true)))
__device__ __forceinline__ void odd_prepc(const Args& args, LAS uchar* lds, int gw, int NGW, int wave, int lane) {
    unsigned char* ws = opaque_ptr(args.ws); const unsigned char* SCN = ws + AR_SCN;
    LAS float* KKs = (LAS float*)(lds + (wave < 7 ? wave * 19456 : MISC_OFF + 64));
    static_assert(7 * 19456 <= MISC_OFF && MISC_OFF + 64 + 18944 <= LDS_BYTES, "odd_prepc LDS areas");
    LAS float* RRs = KKs + 16 * 68; LAS float* BIs = RRs + 16 * 68; LAS float* KIs = BIs + 16 * 68;
    LAS float* Gs = KIs + 16 * 68;
    LAS float* As = Gs + 64;
    const int tau = lane & 15, jq = lane >> 4;
    for (int it = gw; it < (NTOK / 16) * 32; it += NGW) {
        const int dir = it & 1, h = (it >> 1) & 15, cg = it >> 5;
        const int tok = cg * 16 + (dir ? 15 - tau : tau);
        const unsigned char* row = SCN + ((size_t)tok * 16 + h) * 1280;
        const u32x4 r0 = *(const u32x4*)(row + jq * 32), r1 = *(const u32x4*)(row + jq * 32 + 16);
        const u32x4 k0 = *(const u32x4*)(row + 128 + jq * 32), k1 = *(const u32x4*)(row + 128 + jq * 32 + 16);
        const u32x4 d0 = *(const u32x4*)(row + 256 + dir * 512 + jq * 32), d1 = *(const u32x4*)(row + 256 + dir * 512 + jq * 32 + 16);
        const u32x4 b0 = *(const u32x4*)(row + 384 + dir * 512 + jq * 32), b1 = *(const u32x4*)(row + 384 + dir * 512 + jq * 32 + 16);
        f32x4 wv[4];
#pragma unroll
        for (int i = 0; i < 4; ++i) wv[i] = *(const f32x4*)(row + 512 + dir * 512 + jq * 64 + 16 * i);
        float rv[16], kkv[16], kdv[16], bv[16];
        unpack16r(r0, r1, rv); unpack16r(k0, k1, kkv); unpack16r(d0, d1, kdv); unpack16r(b0, b1, bv);
        LDS_WAIT(); asm volatile("" ::: "memory");
#pragma unroll
        for (int i = 0; i < 4; ++i) { f32x4 okk, orr, obi, oki, og;
#pragma unroll
            for (int e = 0; e < 4; ++e) { const int c = 4 * i + e;
                const float lw = log_(wv[i][e]);
                float cum = lw; cum = ROW_SHR_ADD(cum, 1); cum = ROW_SHR_ADD(cum, 2); cum = ROW_SHR_ADD(cum, 4); cum = ROW_SHR_ADD(cum, 8);
                const float ecum = exp_(cum), eexc = exp_(cum - lw), inv = __builtin_amdgcn_rcpf(ecum);
                okk[e] = kkv[c] * eexc; orr[e] = rv[c] * ecum; obi[e] = bv[c] * inv; oki[e] = kdv[c] * inv; og[e] = ecum; }
            *(LAS f32x4*)(KKs + tau * 68 + 16 * jq + 4 * i) = okk; *(LAS f32x4*)(RRs + tau * 68 + 16 * jq + 4 * i) = orr;
            *(LAS f32x4*)(BIs + tau * 68 + 16 * jq + 4 * i) = obi; *(LAS f32x4*)(KIs + tau * 68 + 16 * jq + 4 * i) = oki;
            if (tau == 15) *(LAS f32x4*)(Gs + 16 * jq + 4 * i) = og; }
        LDS_WAIT(); asm volatile("" ::: "memory");
        unsigned char* rec = ws + (dir ? AR_CH1 : AR_CH0) + ((size_t)cg * 16 + h) * CH_REC;
        f32x4 aab = (f32x4){0.f, 0.f, 0.f, 0.f}, aak = aab, arb = aab, ark = aab;
#pragma unroll
        for (int jt = 0; jt < 4; ++jt) {
            const f32x4 kf = *(const LAS f32x4*)(KKs + tau * 68 + 16 * jt + 4 * jq), rf = *(const LAS f32x4*)(RRs + tau * 68 + 16 * jt + 4 * jq);
            const f32x4 bf_ = *(const LAS f32x4*)(BIs + tau * 68 + 16 * jt + 4 * jq), kif = *(const LAS f32x4*)(KIs + tau * 68 + 16 * jt + 4 * jq);
            const u32x2 kkp = pk4bf(kf.x, kf.y, kf.z, kf.w), rrp = pk4bf(rf.x, rf.y, rf.z, rf.w), bip = pk4bf(bf_.x, bf_.y, bf_.z, bf_.w), kip = pk4bf(kif.x, kif.y, kif.z, kif.w);
            aab = __builtin_amdgcn_mfma_f32_16x16x16bf16_1k(__builtin_bit_cast(bf16x4, bip), __builtin_bit_cast(bf16x4, kkp), aab, 0, 0, 0);
            aak = __builtin_amdgcn_mfma_f32_16x16x16bf16_1k(__builtin_bit_cast(bf16x4, kip), __builtin_bit_cast(bf16x4, kkp), aak, 0, 0, 0);
            arb = __builtin_amdgcn_mfma_f32_16x16x16bf16_1k(__builtin_bit_cast(bf16x4, bip), __builtin_bit_cast(bf16x4, rrp), arb, 0, 0, 0);
            ark = __builtin_amdgcn_mfma_f32_16x16x16bf16_1k(__builtin_bit_cast(bf16x4, kip), __builtin_bit_cast(bf16x4, rrp), ark, 0, 0, 0);
            *(u32x2*)(rec + CH_KK + (jt * 64 + lane) * 8) = kkp; *(u32x2*)(rec + CH_RR + (jt * 64 + lane) * 8) = rrp;
        }
#pragma unroll
        for (int e = 0; e < 4; ++e) { const int sg = 4 * jq + e; if (!(sg < tau)) { aab[e] = 0.f; aak[e] = 0.f; } if (!(sg <= tau)) { arb[e] = 0.f; ark[e] = 0.f; } }
        *(LAS f32x4*)(As + tau * 20 + 4 * jq) = (f32x4){aab[0], aab[1], aab[2], aab[3]};
        *(u32x2*)(rec + CH_MAT + (0 * 64 + lane) * 8) = pk4bf(aak[0], aak[1], aak[2], aak[3]);
        *(u32x2*)(rec + CH_MAT + (2 * 64 + lane) * 8) = pk4bf(-arb[0], -arb[1], -arb[2], -arb[3]);
        *(u32x2*)(rec + CH_MAT + (3 * 64 + lane) * 8) = pk4bf(ark[0], ark[1], ark[2], ark[3]);
#pragma unroll
        for (int jt = 0; jt < 4; ++jt) {
            const int j = 16 * jt + tau; const float g = Gs[j]; float nb[4], kt[4];
#pragma unroll
            for (int e = 0; e < 4; ++e) { nb[e] = -BIs[(4 * jq + e) * 68 + j] * g; kt[e] = KIs[(4 * jq + e) * 68 + j] * g; }
            *(u32x2*)(rec + CH_NBT + (jt * 64 + lane) * 8) = pk4bf(nb[0], nb[1], nb[2], nb[3]); *(u32x2*)(rec + CH_KT + (jt * 64 + lane) * 8) = pk4bf(kt[0], kt[1], kt[2], kt[3]);
        }
        if (lane < 16) *(f32x4*)(rec + CH_G + lane * 16) = *(const LAS f32x4*)(Gs + 4 * lane);
        LDS_WAIT(); asm volatile("" ::: "memory");
        float X[16];
#pragma unroll
        for (int t = 0; t < 16; ++t) { float x = (t == tau) ? 1.f : 0.f;
#pragma unroll
            for (int s4 = 0; s4 < (t + 3) / 4; ++s4) { const f32x4 l4 = *(const LAS f32x4*)(As + t * 20 + 4 * s4);
#pragma unroll
                for (int e = 0; e < 4; ++e) if (4 * s4 + e < t) x -= l4[e] * X[4 * s4 + e]; }
            X[t] = x; }
        LDS_WAIT(); asm volatile("" ::: "memory");
#pragma unroll
        for (int t = 0; t < 16; ++t) As[t * 20 + tau] = X[t];
        LDS_WAIT(); asm volatile("" ::: "memory");
        { const f32x4 ti = *(const LAS f32x4*)(As + tau * 20 + 4 * jq); *(u32x2*)(rec + CH_MAT + (1 * 64 + lane) * 8) = pk4bf(ti.x, ti.y, ti.z, ti.w); }
    }
}
#define ROW_SHL_ADD(x_, n_) ((x_) + __builtin_bit_cast(float, __builtin_amdgcn_update_dpp(0, __builtin_bit_cast(int, (x_)), 0x100 + (n_), 0xF, 0xF, true)))
__device__ __forceinline__ void odd_prepm(const Args& args, LAS uchar* lds, int j, int gw, int NGW, int wave, int lane) {
    unsigned char* ws = opaque_ptr(args.ws);
    const bf16* R = (const bf16*)(ws + AR_RKV); const bf16* Kk = R + (size_t)NTOK * D; const bf16* LW = (const bf16*)(ws + AR_LW); const bf16* LA = (const bf16*)(ws + AR_LA); float* CB = (float*)(ws + AR_CB);
    LAS float* KKs = (LAS float*)(lds + wave * 20480);
    LAS float* RRs = KKs + 16 * 68; LAS float* BIs = RRs + 16 * 68; LAS float* KIs = BIs + 16 * 68;
    LAS float* As = KIs + 16 * 68;
    LAS float* Gs = As;
    LAS float* W0s = As + 16 * 20;
    LAS float* A0s = W0s + 128; LAS float* PKs = A0s + 128;
    const int tau = lane & 15, jq = lane >> 4;
    const int h = gw & 15, ch0 = h * 64 + 16 * jq;
    { const int dd = lane >> 5, cc = (lane & 31) * 2;
      const float* w0 = args.in[I_OW0] + (size_t)j * 2 * D + dd * D + h * 64 + cc; const float* a0 = args.in[I_OA0] + (size_t)j * 2 * D + dd * D + h * 64 + cc;
      W0s[dd * 64 + cc] = w0[0]; W0s[dd * 64 + cc + 1] = w0[1]; A0s[dd * 64 + cc] = a0[0]; A0s[dd * 64 + cc + 1] = a0[1];
      PKs[lane] = args.in[I_OKK][(size_t)j * D + h * 64 + lane]; PKs[64 + lane] = args.in[I_OKA][(size_t)j * D + h * 64 + lane]; PKs[128 + lane] = args.in[I_ORK][(size_t)j * D + h * 64 + lane]; }
    LDS_WAIT(); asm volatile("" ::: "memory");
    const int cgs = NGW >> 4, np = ((NTOK / 16 - (gw >> 4) + cgs - 1) / cgs) * 2;
    u32x4 nr0, nr1, nk0, nk1, nlw0, nlw1, nla0, nla1;
#define PM_LOAD(p_) do { const int pc_ = (p_) < np ? (p_) : np - 1; const int cg_ = (gw >> 4) + (pc_ >> 1) * cgs, d_ = pc_ & 1; const size_t tk_ = (size_t)(cg_ * 16 + tau); \
        const u32x4* pr_ = (const u32x4*)(R + tk_ * D + ch0); const u32x4* pk_ = (const u32x4*)(Kk + tk_ * D + ch0); nr0 = pr_[0]; nr1 = pr_[1]; nk0 = pk_[0]; nk1 = pk_[1]; \
        const u32x4* pw_ = (const u32x4*)(LW + tk_ * 2048 + d_ * 1024 + ch0); const u32x4* pa_ = (const u32x4*)(LA + tk_ * 2048 + d_ * 1024 + ch0); nlw0 = pw_[0]; nlw1 = pw_[1]; nla0 = pa_[0]; nla1 = pa_[1]; } while (0)
    if (np > 0) PM_LOAD(0);
    float cbp = 0.f;
#pragma unroll 1
    for (int p = 0; p < np; ++p) {
        const int cg = (gw >> 4) + (p >> 1) * cgs, dir = p & 1;
        const int tok = cg * 16 + tau;
        {
            const u32x4 r0 = nr0, r1 = nr1, k0 = nk0, k1 = nk1, lw0 = nlw0, lw1 = nlw1, la0 = nla0, la1 = nla1;
            PM_LOAD(p + 1);
            if (dir == 0) cbp = 0.f;
            float rv[16], kv[16], kkv[16];
            unpack16r(r0, r1, rv); unpack16r(k0, k1, kv);
            float ss = 0.f;
#pragma unroll
            for (int i = 0; i < 4; ++i) { const f32x4 kk4 = *(const LAS f32x4*)(PKs + 16 * jq + 4 * i);
#pragma unroll
                for (int e = 0; e < 4; ++e) { const int c = 4 * i + e; kkv[c] = kv[c] * kk4[e]; ss += kkv[c] * kkv[c]; } }
            ss = xor32_sum(xor16_sum(ss));
            { const float inv = 1.f / fmaxf(sqrtf(ss), 1e-12f);
#pragma unroll
              for (int c = 0; c < 16; ++c) kkv[c] *= inv; }
            float lwv[16], lav[16];
            unpack16r(lw0, lw1, lwv); unpack16r(la0, la1, lav);
            const int prow = dir ? 15 - tau : tau;
            LDS_WAIT(); asm volatile("" ::: "memory");
#pragma unroll
            for (int i = 0; i < 4; ++i) { f32x4 okk, orr, obi, oki, og;
                const f32x4 w04 = *(const LAS f32x4*)(W0s + dir * 64 + 16 * jq + 4 * i), a04 = *(const LAS f32x4*)(A0s + dir * 64 + 16 * jq + 4 * i);
                const f32x4 ka4 = *(const LAS f32x4*)(PKs + 64 + 16 * jq + 4 * i), rk4 = *(const LAS f32x4*)(PKs + 128 + 16 * jq + 4 * i);
#pragma unroll
                for (int e = 0; e < 4; ++e) { const int c = 4 * i + e;
                    const float nx = -(w04[e] + lwv[c]); const float tq = exp_(-fabsf(nx));
                    const float lw = -0.6065306597126334f * ((nx >= 0.f ? tq : 1.f) * __builtin_amdgcn_rcpf(1.f + tq));
                    const float a = sigmoidf_(a04[e] + lav[c]);
                    const float kd = kv[c] * (1.f + (a - 1.f) * ka4[e]), b = kkv[c] * a;
                    cbp += rv[c] * rk4[e] * kd;
                    float cum = lw;
                    if (dir == 0) { cum = ROW_SHR_ADD(cum, 1); cum = ROW_SHR_ADD(cum, 2); cum = ROW_SHR_ADD(cum, 4); cum = ROW_SHR_ADD(cum, 8); }
                    else { cum = ROW_SHL_ADD(cum, 1); cum = ROW_SHL_ADD(cum, 2); cum = ROW_SHL_ADD(cum, 4); cum = ROW_SHL_ADD(cum, 8); }
                    const float ecum = exp_(cum), eexc = exp_(cum - lw), inv = __builtin_amdgcn_rcpf(ecum);
                    okk[e] = kkv[c] * eexc; orr[e] = rv[c] * ecum; obi[e] = b * inv; oki[e] = kd * inv; og[e] = ecum; }
                *(LAS f32x4*)(KKs + prow * 68 + 16 * jq + 4 * i) = okk; *(LAS f32x4*)(RRs + prow * 68 + 16 * jq + 4 * i) = orr;
                *(LAS f32x4*)(BIs + prow * 68 + 16 * jq + 4 * i) = obi; *(LAS f32x4*)(KIs + prow * 68 + 16 * jq + 4 * i) = oki;
                if (prow == 15) *(LAS f32x4*)(Gs + 16 * jq + 4 * i) = og; }
            LDS_WAIT(); asm volatile("" ::: "memory");
            unsigned char* rec = ws + (dir ? AR_CH1 : AR_CH0) + ((size_t)cg * 16 + h) * CH_REC;
            f32x4 aab = (f32x4){0.f, 0.f, 0.f, 0.f}, aak = aab, arb = aab, ark = aab;
#pragma unroll
            for (int jt = 0; jt < 4; ++jt) {
                const f32x4 kf = *(const LAS f32x4*)(KKs + tau * 68 + 16 * jt + 4 * jq), rf = *(const LAS f32x4*)(RRs + tau * 68 + 16 * jt + 4 * jq);
                const f32x4 bf_ = *(const LAS f32x4*)(BIs + tau * 68 + 16 * jt + 4 * jq), kif = *(const LAS f32x4*)(KIs + tau * 68 + 16 * jt + 4 * jq);
                const u32x2 kkp = pk4bf(kf.x, kf.y, kf.z, kf.w), rrp = pk4bf(rf.x, rf.y, rf.z, rf.w), bip = pk4bf(bf_.x, bf_.y, bf_.z, bf_.w), kip = pk4bf(kif.x, kif.y, kif.z, kif.w);
                aab = __builtin_amdgcn_mfma_f32_16x16x16bf16_1k(__builtin_bit_cast(bf16x4, bip), __builtin_bit_cast(bf16x4, kkp), aab, 0, 0, 0);
                aak = __builtin_amdgcn_mfma_f32_16x16x16bf16_1k(__builtin_bit_cast(bf16x4, kip), __builtin_bit_cast(bf16x4, kkp), aak, 0, 0, 0);
                arb = __builtin_amdgcn_mfma_f32_16x16x16bf16_1k(__builtin_bit_cast(bf16x4, bip), __builtin_bit_cast(bf16x4, rrp), arb, 0, 0, 0);
                ark = __builtin_amdgcn_mfma_f32_16x16x16bf16_1k(__builtin_bit_cast(bf16x4, kip), __builtin_bit_cast(bf16x4, rrp), ark, 0, 0, 0);
                *(u32x2*)(rec + CH_KK + (jt * 64 + lane) * 8) = kkp; *(u32x2*)(rec + CH_RR + (jt * 64 + lane) * 8) = rrp;
                const int jj = 16 * jt + tau; const float g = Gs[jj]; float nb[4], kt[4];
#pragma unroll
                for (int e = 0; e < 4; ++e) { nb[e] = -BIs[(4 * jq + e) * 68 + jj] * g; kt[e] = KIs[(4 * jq + e) * 68 + jj] * g; }
                *(u32x2*)(rec + CH_NBT + (jt * 64 + lane) * 8) = pk4bf(nb[0], nb[1], nb[2], nb[3]); *(u32x2*)(rec + CH_KT + (jt * 64 + lane) * 8) = pk4bf(kt[0], kt[1], kt[2], kt[3]);
            }
            if (lane < 16) *(f32x4*)(rec + CH_G + lane * 16) = *(const LAS f32x4*)(Gs + 4 * lane);
#pragma unroll
            for (int e = 0; e < 4; ++e) { const int sg = 4 * jq + e; if (!(sg < tau)) { aab[e] = 0.f; aak[e] = 0.f; } if (!(sg <= tau)) { arb[e] = 0.f; ark[e] = 0.f; } }
            *(u32x2*)(rec + CH_MAT + (0 * 64 + lane) * 8) = pk4bf(aak[0], aak[1], aak[2], aak[3]);
            *(u32x2*)(rec + CH_MAT + (2 * 64 + lane) * 8) = pk4bf(-arb[0], -arb[1], -arb[2], -arb[3]);
            *(u32x2*)(rec + CH_MAT + (3 * 64 + lane) * 8) = pk4bf(ark[0], ark[1], ark[2], ark[3]);
            LDS_WAIT(); asm volatile("" ::: "memory");
            *(LAS f32x4*)(As + tau * 20 + 4 * jq) = aab;
            LDS_WAIT(); asm volatile("" ::: "memory");
            float X[16];
#pragma unroll
            for (int t = 0; t < 16; ++t) { float x = (t == tau) ? 1.f : 0.f;
#pragma unroll
                for (int s4 = 0; s4 < (t + 3) / 4; ++s4) { const f32x4 l4 = *(const LAS f32x4*)(As + t * 20 + 4 * s4);
#pragma unroll
                    for (int e = 0; e < 4; ++e) if (4 * s4 + e < t) x -= l4[e] * X[4 * s4 + e]; }
                X[t] = x; }
            LDS_WAIT(); asm volatile("" ::: "memory");
#pragma unroll
            for (int t = 0; t < 16; ++t) As[t * 20 + tau] = X[t];
            LDS_WAIT(); asm volatile("" ::: "memory");
            { const f32x4 ti = *(const LAS f32x4*)(As + tau * 20 + 4 * jq); *(u32x2*)(rec + CH_MAT + (1 * 64 + lane) * 8) = pk4bf(ti.x, ti.y, ti.z, ti.w); }
        }
        if (dir == 1) { const float cbt = xor32_sum(xor16_sum(cbp)); if (jq == 0) CB[(size_t)tok * 16 + h] = cbt; }
    }
#undef PM_LOAD
}
constexpr int SC_SLOT = 11264 + 2048;
template <int NQ, int DEPTH> __device__ __forceinline__ void odd_scanc_unit(const Args& args, LAS uchar* ring, int s_, int h_, int dir_, int q0_, int lane) {
    const int s = uni(s_), h = uni(h_), dir = uni(dir_), q0 = uni(q0_);
    unsigned char* ws = opaque_ptr(args.ws);
    const int T = seq_T(s), r0 = seq_row0(s), nch = T / 16, cg0 = r0 / 16, fr = lane & 15, fq = lane >> 4;
    const __amdgpu_buffer_rsrc_t rsrc = __builtin_amdgcn_make_buffer_rsrc((void*)ws, 0, 0xffffffff, 0x00020000);
    const unsigned ch_base = (unsigned)(dir ? AR_CH1 : AR_CH0) + (unsigned)h * (unsigned)CH_REC, v_base = (unsigned)AR_V + (unsigned)h * 128u;
    const int voff_rec = lane * 16, voff_v = (lane >> 3) * 2048 + (lane & 7) * 16, voff_last = lane < 16 ? lane * 16 : (int)0xfffffff0u;
    bf16* Y = (bf16*)(ws + (dir ? AR_YB : AR_YF));
    f32x4 ST[NQ][4];
#pragma unroll
    for (int qi = 0; qi < NQ; ++qi)
#pragma unroll
        for (int jt = 0; jt < 4; ++jt) ST[qi][jt] = (f32x4){0.f, 0.f, 0.f, 0.f};
#define SC_DMA(c_) do { const int cl_ = (c_) < nch ? (c_) : nch - 1; const int cc_ = dir ? nch - 1 - cl_ : cl_; LAS uchar* slot_ = ring + ((c_) % DEPTH) * SC_SLOT; \
        const unsigned so_ = ch_base + (unsigned)(cg0 + cc_) * (unsigned)(16 * CH_REC); \
        _Pragma("unroll") for (int i = 0; i < 11; ++i) __builtin_amdgcn_raw_ptr_buffer_load_lds(rsrc, (LAS void*)(slot_ + i * 1024), 16, i < 10 ? voff_rec : voff_last, (int)(so_ + (unsigned)i * 1024u), 0, 0); \
        const unsigned sv_ = v_base + (unsigned)(r0 + 16 * cc_) * 2048u; \
        _Pragma("unroll") for (int k = 0; k < 2; ++k) __builtin_amdgcn_raw_ptr_buffer_load_lds(rsrc, (LAS void*)(slot_ + 11264 + k * 1024), 16, voff_v, (int)(sv_ + (unsigned)k * 16384u), 0, 0); } while (0)
#define SC_MFMA(a_, b_, c_) __builtin_amdgcn_mfma_f32_16x16x16bf16_1k(__builtin_bit_cast(bf16x4, (a_)), __builtin_bit_cast(bf16x4, (b_)), (c_), 0, 0, 0)
    static_assert(DEPTH >= 3 && (DEPTH - 1) * 13 <= 63, "ring depth: the counted wait must fit the 6-bit vmcnt");
#pragma unroll
    for (int c = 0; c < DEPTH - 1; ++c) SC_DMA(c);
    for (int c = 0; c < nch; ++c) {
        SC_DMA(c + DEPTH - 1);
        if constexpr (DEPTH == 5) asm volatile("s_waitcnt vmcnt(52)" ::: "memory");
        else if constexpr (DEPTH == 4) asm volatile("s_waitcnt vmcnt(39)" ::: "memory");
        else asm volatile("s_waitcnt vmcnt(26)" ::: "memory");
        const LAS uchar* slot = ring + (c % DEPTH) * SC_SLOT;
        u32x2 okk[4], orr[4], onb[4], okt[4], omat[4]; f32x4 og[4];
#pragma unroll
        for (int jt = 0; jt < 4; ++jt) { okk[jt] = *(const LAS u32x2*)(slot + CH_KK + jt * 512 + lane * 8); orr[jt] = *(const LAS u32x2*)(slot + CH_RR + jt * 512 + lane * 8); onb[jt] = *(const LAS u32x2*)(slot + CH_NBT + jt * 512 + lane * 8);
            okt[jt] = *(const LAS u32x2*)(slot + CH_KT + jt * 512 + lane * 8); omat[jt] = *(const LAS u32x2*)(slot + CH_MAT + jt * 512 + lane * 8); og[jt] = *(const LAS f32x4*)(slot + CH_G + (16 * jt + 4 * fq) * 4); }
        u32x2 vb[NQ];
#pragma unroll
        for (int qi = 0; qi < NQ; ++qi) { unsigned v_[4];
#pragma unroll
            for (int e = 0; e < 4; ++e) { const int t_ = 4 * fq + e; v_[e] = *(const LAS bf16*)(slot + 11264 + (dir ? 15 - t_ : t_) * 128 + (16 * (q0 + qi) + fr) * 2); }
            vb[qi].x = v_[0] | (v_[1] << 16); vb[qi].y = v_[2] | (v_[3] << 16); }
        LDS_WAIT(); asm volatile("" ::: "memory");
        LAS uchar* yst = (LAS uchar*)slot + 11264;
#pragma unroll
        for (int qi = 0; qi < NQ; ++qi) {
            u32x2 sb[4];
#pragma unroll
            for (int jt = 0; jt < 4; ++jt) sb[jt] = pk4bf(ST[qi][jt][0], ST[qi][jt][1], ST[qi][jt][2], ST[qi][jt][3]);
            f32x4 pa = (f32x4){0.f, 0.f, 0.f, 0.f}, pr = pa;
#pragma unroll
            for (int jt = 0; jt < 4; ++jt) { pa = SC_MFMA(okk[jt], sb[jt], pa); pr = SC_MFMA(orr[jt], sb[jt], pr); }
            const f32x4 x = SC_MFMA(omat[0], vb[qi], pa);
            const u32x2 xb = pk4bf(x[0], x[1], x[2], x[3]);
            const f32x4 u = SC_MFMA(omat[1], xb, ((f32x4){0.f, 0.f, 0.f, 0.f}));
            const u32x2 ub = pk4bf(u[0], u[1], u[2], u[3]);
            f32x4 y = SC_MFMA(omat[2], ub, pr); y = SC_MFMA(omat[3], vb[qi], y);
#pragma unroll
            for (int jt = 0; jt < 4; ++jt) { f32x4 t = ST[qi][jt] * og[jt]; t = SC_MFMA(onb[jt], ub, t); ST[qi][jt] = SC_MFMA(okt[jt], vb[qi], t); }
#pragma unroll
            for (int e = 0; e < 4; ++e) { const int t_ = 4 * fq + e; *(LAS bf16*)(yst + (dir ? 15 - t_ : t_) * 128 + (16 * (q0 + qi) + fr) * 2) = (bf16)(pk2(y[e], 0.f) & 0xffffu); }
        }
        LDS_WAIT(); asm volatile("" ::: "memory");
        { const int cc = dir ? nch - 1 - c : c;
          if (NQ == 4) { const u32x4 a = *(const LAS u32x4*)(yst + (lane >> 2) * 128 + (lane & 3) * 32), b = *(const LAS u32x4*)(yst + (lane >> 2) * 128 + (lane & 3) * 32 + 16);
              u32x4* dst = (u32x4*)(Y + (size_t)(r0 + 16 * cc + (lane >> 2)) * D + h * 64 + (lane & 3) * 16); dst[0] = a; dst[1] = b; }
          else { const u32x4 a = *(const LAS u32x4*)(yst + (lane >> 2) * 128 + q0 * 32 + (lane & 3) * 16);
              *(u32x4*)(Y + (size_t)(r0 + 16 * cc + (lane >> 2)) * D + h * 64 + q0 * 16 + (lane & 3) * 8) = a; } }
    }
    asm volatile("s_waitcnt vmcnt(0)" ::: "memory");
#undef SC_DMA
#undef SC_MFMA
}
__device__ __forceinline__ void odd_scanc(const Args& args, LAS uchar* lds, int wave, int lane) {
    const int bx = blockIdx.x;
    volatile LAS unsigned* st = (volatile LAS unsigned*)(lds + MISC_OFF) + 8;
    unsigned st0 = 0u, st1 = 0u;
    if (wave == 0 && lane == 0) { st0 = st[0]; st1 = st[1]; }
    __syncthreads();
    if (bx < 256 && wave < 3) {
        if (wave == 0) { const int sidp = (bx >> 4) * 8 + (bx & 7), half = (bx >> 3) & 1;
            odd_scanc_unit<2, 5>(args, lds, sidp >> 5, (sidp >> 1) & 15, sidp & 1, 2 * half, lane); }
        else { const int sid = 2 * bx + (wave - 1); odd_scanc_unit<4, 3>(args, lds + 5 * SC_SLOT + (wave - 1) * (3 * SC_SLOT), 4 + (sid >> 5), (sid >> 1) & 15, sid & 1, 0, lane); }
    }
    __syncthreads();
    if (wave == 0 && lane == 0) { st[0] = st0; st[1] = st1; }
}
static_assert(11 * SC_SLOT <= LDS_BYTES, "scan rings");

__device__ __forceinline__ void moe_topk(const Args& args, LAS uchar* lds, int layer, int G, int wave_sgpr_) {
    if (opaque_bx() >= 32) {
        { const int tz = opaque_tid(), wv = uni(tz >> 6); moe_weights(args, layer, (LAS float*)(lds + wv * 16384), (opaque_bx() - 32) * NWAVES + wv, (G - 32) * NWAVES, tz & 63); }
        return;
    }
    unsigned char* ws = opaque_ptr(args.ws);
    const int g = opaque_bx() >> 4, e = opaque_bx() & 15, n = g ? NS : NP, cap = n / 8, base = g ? NP : 0, slotbase = g ? NP * 2 + e * 4096 : e * 2048;
    const float* aff = (const float*)(ws + WS_AFF) + (size_t)e * NTOK + base;
    int* IDX = (int*)(ws + WS_IDX) + slotbase; float* GATE = (float*)(ws + WS_GATE) + slotbase; int* INV = (int*)(ws + WS_INV);
    LAS unsigned* keys = (LAS unsigned*)lds;
    LAS unsigned* hist = (LAS unsigned*)(lds + XLDS_OFF);
    LAS unsigned* sh = hist + 256;
    const int tid = opaque_tid(), wave = tid >> 6, lane = tid & 63;
    for (int i = tid; i < n / 4; i += 512) ((LAS u32x4*)keys)[i] = ((const u32x4*)aff)[i];
    unsigned prefix = 0u, mask = 0u; int need = cap;
    for (int pass = 0; pass < 4; ++pass) {
        const int shift = 24 - 8 * pass;
        if (tid < 256) hist[tid] = 0u;
        __syncthreads();
        for (int i = tid; i < n; i += 512) { const unsigned k = keys[i]; if ((k & mask) == prefix) __hip_atomic_fetch_add(&hist[(k >> shift) & 255u], 1u, __ATOMIC_RELAXED, __HIP_MEMORY_SCOPE_WORKGROUP); }
        __syncthreads();
        if (wave == 0) {
            const int b0 = 255 - 4 * lane;
            const int h0 = (int)hist[b0], h1 = (int)hist[b0 - 1], h2 = (int)hist[b0 - 2], h3 = (int)hist[b0 - 3];
            const int tot = h0 + h1 + h2 + h3; int inc = tot;
#pragma unroll
            for (int d = 1; d < 64; d <<= 1) { const int t = __builtin_amdgcn_ds_bpermute(((lane - d) & 63) << 2, inc); if (lane >= d) inc += t; }
            const unsigned long long hitm = __ballot(inc >= need);
            const int Lh = hitm ? (int)__builtin_ctzll(hitm) : 63;
            if (lane == Lh) { int cum = inc - tot, b = b0;
                if (cum + h0 < need) { cum += h0; b = b0 - 1; if (cum + h1 < need) { cum += h1; b = b0 - 2; if (cum + h2 < need) { cum += h2; b = b0 - 3; } } }
                sh[0] = prefix | ((unsigned)b << shift); sh[1] = (unsigned)(need - cum); }
        }
        __syncthreads();
        prefix = sh[0]; need = (int)sh[1]; mask |= 255u << shift;
        __syncthreads();
    }
    const unsigned T = prefix;
    const int seg = n / 8, s0 = wave * seg;
    int cgt = 0, ceq = 0;
    for (int i = s0 + lane; i < s0 + seg; i += 64) { const unsigned k = keys[i]; cgt += (k > T); ceq += (k == T); }
    cgt = (int)wave_sum((float)cgt); ceq = (int)wave_sum((float)ceq);
    if (lane == 0) { sh[8 + wave] = (unsigned)cgt; sh[24 + wave] = (unsigned)ceq; }
    __syncthreads();
    int gtb = 0, eqb = 0;
    for (int w = 0; w < wave; ++w) { gtb += (int)sh[8 + w]; eqb += (int)sh[24 + w]; }
    for (int i0 = s0; i0 < s0 + seg; i0 += 64) {
        const int i = i0 + lane; const unsigned k = keys[i];
        const bool isgt = k > T, iseq = k == T;
        const unsigned long long mg = __ballot(isgt), me = __ballot(iseq);
        const unsigned long long lt = (lane == 0) ? 0ull : (~0ull >> (64 - lane));
        const int gbef = gtb + __popcll(mg & lt), ebef = eqb + __popcll(me & lt);
        const bool sel = isgt || (iseq && ebef < need);
        const int slot = gbef + (ebef < need ? ebef : need);
        if (sel) { IDX[slot] = base + i; GATE[slot] = __uint_as_float(k); }
        INV[(size_t)(base + i) * 16 + e] = sel ? slot : -1;
        gtb += __popcll(mg); eqb += __popcll(me);
    }
}
__device__ __forceinline__ void moe_gather(const Args& args, int gw, int NGW, int lane) {
    unsigned char* ws = opaque_ptr(args.ws); const int* IDX = (const int*)(ws + WS_IDX); const bf16* XB = (const bf16*)(ws + WS_XB); uchar* XE = ws + AR_XE;
    if (!MOE_FP8) { for (int sl = gw; sl < NSLOT; sl += NGW) { const int r = IDX[sl];
        const u32x4 a = *((const u32x4*)(XB + (size_t)r * D) + lane), b = *((const u32x4*)(XB + (size_t)r * D) + 64 + lane);
        *((u32x4*)((bf16*)XE + (size_t)sl * D) + lane) = a; *((u32x4*)((bf16*)XE + (size_t)sl * D) + 64 + lane) = b; } return; }
    constexpr int NG4 = NSLOT / 4;
    i32x4 nid = (i32x4){0, 0, 0, 0};
    if (gw < NG4) nid = *((const i32x4*)IDX + gw);
    for (int gi = gw; gi < NG4; gi += NGW) {
        const i32x4 id = nid;
        u32x4 a[4][2];
#pragma unroll
        for (int k = 0; k < 4; ++k) { const u32x4* p = (const u32x4*)(XB + (size_t)id[k] * D + 16 * lane); a[k][0] = p[0]; a[k][1] = p[1]; }
        if (gi + NGW < NG4) nid = *((const i32x4*)IDX + gi + NGW);
#pragma unroll
        for (int k = 0; k < 4; ++k) { float v[16]; unpack16r(a[k][0], a[k][1], v);
            u32x4 o; o.x = pk4_fp8(v[0], v[1], v[2], v[3]); o.y = pk4_fp8(v[4], v[5], v[6], v[7]); o.z = pk4_fp8(v[8], v[9], v[10], v[11]); o.w = pk4_fp8(v[12], v[13], v[14], v[15]);
            *((u32x4*)(XE + (size_t)(4 * gi + k) * D) + lane) = o; }
    }
}

constexpr int N_PHASES = 3 + 2 * (6 + 8) + 2 * (8 + 8) - 4 * MOE_GATHER_FUSED;
#ifndef MK_STOP
#define MK_STOP 0
#endif
__global__ void __launch_bounds__(NWAVES * 64, 2) enc_fwd(Args args) {
    extern __shared__ __attribute__((aligned(16))) unsigned char lds_raw[];
    LAS uchar* lds = (LAS uchar*)lds_raw;
    volatile LAS unsigned* MISC = (volatile LAS unsigned*)(lds + MISC_OFF);
    const int tid = threadIdx.x, lane = tid & 63, wave = uni(tid >> 6);
    const int wave_sgpr_ = wave;
    const int G = gridDim.x; const int bx = blockIdx.x; const int vcu = (G % 8 == 0) ? (bx % 8) * (G / 8) + bx / 8 : bx;
    const int gw = vcu * NWAVES + wave, NGW = G * NWAVES;
    unsigned char* ws = opaque_ptr(args.ws);
    if (tid < 16) MISC[tid] = 0u;
    __syncthreads();
    XcdBarrier bar; bar.bar = (unsigned*)(ws + WS_CTL) + CW_BAR; bar.x = 0; bar.st = nullptr;
    const int lo = args.ph_lo, hi = args.ph_hi;
    if (hi - lo > 1) bar = xcd_barrier_post((unsigned*)(ws + WS_CTL) + CW_BAR, MISC + 8);
    const GPhase* gph = (const GPhase*)(ws + WS_GPH); const GP* gpt = (const GP*)(ws + WS_GPT);
    int ph = 0;
#ifndef ONLY
#define ONLY 0
#endif
#ifndef REP_MASK
#define REP_MASK 0
#endif
#define REPS(K) (((REP_MASK >> (K)) & 1) ? 2 : 1)
#define PHASE_BEGIN if (lo <= ph && ph < hi) { const int tz_ = opaque_tid(); const int lane = tz_ & 63, wave = uni(tz_ >> 6), gw = vcu * NWAVES + wave; (void)lane; (void)gw;
#define PHASE_END   if (ph + 1 < hi) xcd_barrier(bar, opaque_tid() == 0); } ++ph;
#define GEMM(kind, id) pg8::gemm_phase<kind, false>(lds, lds + XLDS_OFF, gph + (id), gpt, G, opaque_bx(), ws, wave_sgpr_)
#define GEMM8(kind, id) pg8::gemm_phase<kind, true>(lds, lds + XLDS_OFF, gph + (id), gpt, G, opaque_bx(), ws, wave_sgpr_)

    PHASE_BEGIN if (ONLY == 0 || ONLY == 1) for (int rep_ = 0; rep_ < REPS(1); ++rep_) { prologue(args, lds, gw, NGW, wave, lane); } PHASE_END
    PHASE_BEGIN if (ONLY == 0 || ONLY == 2 || ONLY == 13) for (int rep_ = 0; rep_ < REPS(2); ++rep_) { GEMM(EPI_BF16, GPH_PRO); } PHASE_END
    PHASE_BEGIN if (ONLY == 0 || ONLY == 2 || ONLY == 13) for (int rep_ = 0; rep_ < REPS(2); ++rep_) { GEMM(EPI_BF16, GPH_PRO2); } PHASE_END
#pragma unroll 1
    for (int L = 0; L < 4; ++L) {
        const int j = L >> 1;
        if ((L & 1) == 0) {
            PHASE_BEGIN if (ONLY == 0 || ONLY == 2) for (int rep_ = 0; rep_ < REPS(2); ++rep_) { GEMM(EPI_BF16, L * 9 + 0); } PHASE_END
            PHASE_BEGIN if (ONLY == 0 || ONLY == 3) for (int rep_ = 0; rep_ < REPS(3); ++rep_) { even_phase_a(args, lds, j, G, wave_sgpr_); } PHASE_END
            PHASE_BEGIN if (ONLY == 0 || ONLY == 4) even_phase_b(args, G, wave_sgpr_); PHASE_END
            PHASE_BEGIN if (ONLY == 0 || ONLY == 5) for (int rep_ = 0; rep_ < REPS(5); ++rep_) { even_phase_c(args, lds, j, G, wave_sgpr_); } PHASE_END
            PHASE_BEGIN if (ONLY == 0 || ONLY == 2) for (int rep_ = 0; rep_ < REPS(16); ++rep_) { GEMM(EPI_RESID, L * 9 + 2); } PHASE_END
            PHASE_BEGIN if (ONLY == 0 || ONLY == 6) for (int rep_ = 0; rep_ < REPS(6); ++rep_) { ln_phase(args, lds, L, 0, 0, false, gw, NGW, wave, lane); } PHASE_END
        } else {
            PHASE_BEGIN if (ONLY == 0 || ONLY == 7) for (int rep_ = 0; rep_ < REPS(7); ++rep_) { odd_shiftmix(args, j, gw, NGW, lane); } PHASE_END
            PHASE_BEGIN if (ONLY == 0 || ONLY == 2) for (int rep_ = 0; rep_ < REPS(2); ++rep_) { GEMM(EPI_BF16, L * 9 + 0); } PHASE_END
            PHASE_BEGIN if (ONLY == 0 || ONLY == 2) for (int rep_ = 0; rep_ < REPS(2); ++rep_) { GEMM(EPI_BF16, L * 9 + 1); } PHASE_END
#if !SCAN_CHUNKED
            PHASE_BEGIN if (ONLY == 0 || ONLY == 8) for (int rep_ = 0; rep_ < REPS(8); ++rep_) { odd_prep(args, j, gw, NGW, lane); } PHASE_END
#endif
#if SCAN_CHUNKED
            PHASE_BEGIN if (ONLY == 0 || ONLY == 9) for (int rep_ = 0; rep_ < REPS(9); ++rep_) {
                volatile LAS unsigned* st_ = (volatile LAS unsigned*)(lds + MISC_OFF) + 8; unsigned st0_ = 0u, st1_ = 0u;
                if (tid == 0) { st0_ = st_[0]; st1_ = st_[1]; }
                __syncthreads();
                odd_prepm(args, lds, j, gw, NGW, wave, lane);
                __syncthreads();
                if (tid == 0) { st_[0] = st0_; st_[1] = st1_; } } PHASE_END
            PHASE_BEGIN if (ONLY == 0 || ONLY == 9) for (int rep_ = 0; rep_ < REPS(19); ++rep_) { odd_scanc(args, lds, wave, lane); } PHASE_END
#else
            PHASE_BEGIN if (ONLY == 0 || ONLY == 9) for (int rep_ = 0; rep_ < REPS(9); ++rep_) { odd_scan(args, lds, G, wave, lane, rep_ == 1); } PHASE_END
#endif
            PHASE_BEGIN if (ONLY == 0 || ONLY == 10) for (int rep_ = 0; rep_ < REPS(10); ++rep_) { odd_post(args, j, gw, NGW, lane); } PHASE_END
            PHASE_BEGIN if (ONLY == 0 || ONLY == 2) for (int rep_ = 0; rep_ < REPS(16); ++rep_) { GEMM(EPI_RESID, L * 9 + 2); } PHASE_END
            PHASE_BEGIN if (ONLY == 0 || ONLY == 6) for (int rep_ = 0; rep_ < REPS(6); ++rep_) { ln_phase(args, lds, L, 0, 0, false, gw, NGW, wave, lane); } PHASE_END
        }
        PHASE_BEGIN if (ONLY == 0 || ONLY == 2) for (int rep_ = 0; rep_ < REPS(17); ++rep_) { GEMM(EPI_SOFTMAX, L * 9 + 3); } PHASE_END
        PHASE_BEGIN if (ONLY == 0 || ONLY == 2) for (int rep_ = 0; rep_ < REPS(16); ++rep_) { GEMM(EPI_RESID, L * 9 + 6); } PHASE_END
        PHASE_BEGIN if (ONLY == 0 || ONLY == 6) for (int rep_ = 0; rep_ < REPS(6); ++rep_) { ln_phase(args, lds, L, 1, 1, false, gw, NGW, wave, lane); } PHASE_END
        PHASE_BEGIN if (ONLY == 0 || ONLY == 11) for (int rep_ = 0; rep_ < REPS(11); ++rep_) { moe_topk(args, lds, L, G, wave_sgpr_); } PHASE_END
#if !MOE_GATHER_FUSED
        PHASE_BEGIN if (ONLY == 0 || ONLY == 12) for (int rep_ = 0; rep_ < REPS(12); ++rep_) { moe_gather(args, gw, NGW, lane); } PHASE_END
#endif
        PHASE_BEGIN if (ONLY == 0 || ONLY == 2 || ONLY == 14) for (int rep_ = 0; rep_ < REPS(18); ++rep_) { if (MOE_FP8) GEMM8(EPI_SWIGLU, L * 9 + 7); else GEMM(EPI_SWIGLU, L * 9 + 7); } PHASE_END
        PHASE_BEGIN if (ONLY == 0 || ONLY == 2 || ONLY == 15) for (int rep_ = 0; rep_ < REPS(18); ++rep_) { if (MOE_FP8) GEMM8(EPI_ROWSCALE, L * 9 + 8); else GEMM(EPI_ROWSCALE, L * 9 + 8); } PHASE_END
        PHASE_BEGIN if (ONLY == 0 || ONLY == 6) ln_phase(args, lds, L, 2, 2, L == 3, gw, NGW, wave, lane); PHASE_END
    }
}

extern "C" void kernel_launch(void* const* d_in, const int* in_sizes, int n_in, void* d_out, int out_size, void* d_ws, size_t ws_size, hipStream_t stream) {
    static int grid = 0;
    if (grid == 0) {
        if (n_in != 33 || out_size != NTOK * D || ws_size < WS_END) { fprintf(stderr, "kernel_launch: unexpected shapes (n_in %d out %d ws %zu need %zu)\n", n_in, out_size, ws_size, (size_t)WS_END); grid = -1; return; }
        int dev = 0, cus = 0, per_cu = 0;
        if (hipGetDevice(&dev) != hipSuccess || hipDeviceGetAttribute(&cus, hipDeviceAttributeMultiprocessorCount, dev) != hipSuccess) { grid = -1; return; }
        if (hipFuncSetAttribute((const void*)enc_fwd, hipFuncAttributeMaxDynamicSharedMemorySize, LDS_BYTES) != hipSuccess) { fprintf(stderr, "kernel_launch: hipFuncSetAttribute failed\n"); grid = -1; return; }
        if (hipOccupancyMaxActiveBlocksPerMultiprocessor(&per_cu, (const void*)enc_fwd, NWAVES * 64, LDS_BYTES) != hipSuccess || per_cu < 1) fprintf(stderr, "kernel_launch: occupancy query says %d\n", per_cu);
        (void)hipGetLastError();
        grid = cus;
        if (grid != 256) fprintf(stderr, "kernel_launch: %d CUs (built for 256)\n", grid);
    }
    if (grid < 0) return;
    if (hipMemsetAsync((char*)d_ws + WS_CTL, 0, CTL_ZERO_BYTES, stream) != hipSuccess) return;
    Args a{};
    for (int i = 0; i < 33; ++i) a.in[i] = (const float*)d_in[i];
    a.out = (float*)d_out; a.ws = (unsigned char*)d_ws;
#if MK_PER_PHASE
    for (int p = 0; p < N_PHASES; ++p) { a.ph_lo = p; a.ph_hi = p + 1; hipLaunchKernelGGL(enc_fwd, dim3(grid), dim3(NWAVES * 64), LDS_BYTES, stream, a); }
#else
    a.ph_lo = 0; a.ph_hi = N_PHASES;
    hipLaunchKernelGGL(enc_fwd, dim3(grid), dim3(NWAVES * 64), LDS_BYTES, stream, a);
#endif
}
```
